# Optimizing an MI355X kernel written in HIP

```python
import jax, jax.numpy as jnp
from jax import lax
import numpy as np

D_MODEL = 1024
BATCH = 32
SEQ = 256
DEPTH = 2
DEC_BATCH = 4
DEC_SEQ = 4096
PAST_LEN = 256

GRID_W = 64
N_HEADS = 8
N_KV = 2
HEAD_DIM = 64
GROUP = N_HEADS // N_KV
ATT_W = N_HEADS * HEAD_DIM
KV_W = N_KV * HEAD_DIM
WINDOW = 128
BLOCK = 128
ROPE_BASE = 10000.0
CONV_W = D_MODEL // 4
CONV_K = 31
POOL_W = D_MODEL // 4
POOL_SIZES = (2, 4, 8, 16)
N_POOL_G = 4
POOL_G = POOL_W // N_POOL_G
SC_W = D_MODEL // 4
SC_K = 3
N_BRANCH = 4
D_FF = 4 * D_MODEL
EPS = 1e-6
NEG = -1e30
SPLIT_SIZES = (CONV_W, CONV_W, POOL_W, SC_W, SC_W, SC_W, ATT_W, KV_W, KV_W, N_BRANCH * D_MODEL)
IN_W = 2 * CONV_W + POOL_W + 3 * SC_W + ATT_W + 2 * KV_W + N_BRANCH * D_MODEL

kernel_name = "hybrid_diffusion_parallel_mixer_step"


def _rmsnorm(x, g):
    xf = x.astype(jnp.float32)
    y = xf * lax.rsqrt(jnp.mean(xf * xf, axis=-1, keepdims=True) + EPS)
    return y.astype(x.dtype) * g


def _layernorm(x, g, b):
    xf = x.astype(jnp.float32)
    mu = jnp.mean(xf, axis=-1, keepdims=True)
    var = jnp.mean(jnp.square(xf - mu), axis=-1, keepdims=True)
    y = (xf - mu) * lax.rsqrt(var + EPS)
    return y.astype(x.dtype) * g + b


def _dwconv(x, w):
    pad = w.shape[0] // 2
    return lax.conv_general_dilated(x, w[:, None, :], window_strides=(1,), padding=[(pad, pad)],
                                    dimension_numbers=('NWC', 'WIO', 'NWC'),
                                    feature_group_count=x.shape[-1])


def _multiscale_pool(u):
    bsz, n, _ = u.shape
    ug = u.astype(jnp.float32).reshape(bsz, n, N_POOL_G, POOL_G)
    cs = jnp.concatenate([jnp.zeros((bsz, 1, N_POOL_G, POOL_G), jnp.float32), lax.cumsum(ug, axis=1)], axis=1)
    t = jnp.arange(n)
    outs = []
    for gi, w in enumerate(POOL_SIZES):
        lo = jnp.clip(t - w // 2, 0, n)
        hi = jnp.clip(t + w // 2, 0, n)
        cnt = (hi - lo).astype(jnp.float32)[None, :, None]
        outs.append((cs[:, hi, gi] - cs[:, lo, gi]) / cnt - ug[:, :, gi])
    return jnp.stack(outs, axis=2).astype(u.dtype)


def _rope_1d(x, pos):
    half = x.shape[-1] // 2
    freq = ROPE_BASE ** (-jnp.arange(half, dtype=jnp.float32) / half)
    ang = pos.astype(jnp.float32)[:, None] * freq[None, :]
    cos = jnp.cos(ang)[None, :, None, :]
    sin = jnp.sin(ang)[None, :, None, :]
    xf = x.astype(jnp.float32)
    x1, x2 = xf[..., :half], xf[..., half:]
    return jnp.concatenate([x1 * cos - x2 * sin, x2 * cos + x1 * sin], axis=-1).astype(x.dtype)


def _rope_2d(x):
    n = x.shape[1]
    rows = n // GRID_W
    row = jnp.repeat(jnp.arange(rows), GRID_W)
    col = jnp.tile(jnp.arange(GRID_W), rows)
    r = x.shape[-1] // 2
    return jnp.concatenate([_rope_1d(x[..., :r], row), _rope_1d(x[..., r:], col)], axis=-1)


def _context_attention(q, k, v, sink):
    bsz, n = q.shape[:2]
    nbq = n // BLOCK
    scale = HEAD_DIM ** -0.5
    qb = q.reshape(bsz, nbq, BLOCK, N_KV, GROUP, HEAD_DIM).transpose(1, 0, 2, 3, 4, 5)
    sink_f = sink.astype(jnp.float32).reshape(1, N_KV, GROUP, 1, 1)

    def one_block(qblk):
        s = jnp.einsum('bqhgd,bchd->bhgqc', qblk, k).astype(jnp.float32) * scale
        sk = jnp.broadcast_to(sink_f, s.shape[:-1] + (1,))
        p = jax.nn.softmax(jnp.concatenate([s, sk], axis=-1), axis=-1)[..., :-1]
        return jnp.einsum('bhgqc,bchd->bqhgd', p.astype(v.dtype), v)

    o = lax.map(one_block, qb)
    return o.transpose(1, 0, 2, 3, 4, 5).reshape(bsz, n, ATT_W)


def _latent_attention(q, k, v, kc, vc, sink):
    bsz, n = q.shape[:2]
    nb = n // BLOCK
    scale = HEAD_DIM ** -0.5
    qb = q.reshape(bsz, nb, BLOCK, N_KV, GROUP, HEAD_DIM)
    pad = ((0, 0), (BLOCK, BLOCK), (0, 0), (0, 0))
    kp = jnp.pad(k, pad)
    vp = jnp.pad(v, pad)
    idx = jnp.arange(nb)[:, None] * BLOCK + jnp.arange(3 * BLOCK)[None, :]
    kl = kp[:, idx]
    vl = vp[:, idx]
    kpos = idx - BLOCK
    qpos = jnp.arange(nb)[:, None] * BLOCK + jnp.arange(BLOCK)[None, :]
    valid = ((jnp.abs(qpos[:, :, None] - kpos[:, None, :]) <= WINDOW)
             & (kpos[:, None, :] >= 0) & (kpos[:, None, :] < n))
    s_loc = jnp.einsum('bnqhgd,bnshd->bnhgqs', qb, kl).astype(jnp.float32) * scale
    s_loc = jnp.where(valid[None, :, None, None], s_loc, NEG)
    s_ctx = jnp.einsum('bnqhgd,bchd->bnhgqc', qb, kc).astype(jnp.float32) * scale
    sk = jnp.broadcast_to(sink.astype(jnp.float32).reshape(1, 1, N_KV, GROUP, 1, 1), s_loc.shape[:-1] + (1,))
    p = jax.nn.softmax(jnp.concatenate([s_loc, s_ctx, sk], axis=-1), axis=-1)
    p_loc = p[..., :3 * BLOCK].astype(v.dtype)
    p_ctx = p[..., 3 * BLOCK:-1].astype(vc.dtype)
    o = (jnp.einsum('bnhgqs,bnshd->bnqhgd', p_loc, vl)
         + jnp.einsum('bnhgqc,bchd->bnqhgd', p_ctx, vc))
    return o.reshape(bsz, n, ATT_W)


def _mixer(h, w_in, w_conv_a, b_conv_a, ln_g_a, ln_b_a, w_a_out, w_pool, pool_scale, w_b_out,
           w_sc, w_c_out, sink, w_d_out, w_o, ctx_k, ctx_v):
    bsz, n, _ = h.shape
    offs = np.cumsum(SPLIT_SIZES)[:-1].tolist()
    a_val, a_gate, u_pool, s_b, s_c, s_h, q, k, v, g_br = jnp.split(h @ w_in, offs, axis=-1)
    ua = _dwconv(a_val * jax.nn.sigmoid(a_gate), w_conv_a) + b_conv_a
    br_a = jax.nn.silu(_layernorm(ua, ln_g_a, ln_b_a)) @ w_a_out
    pooled = _multiscale_pool(u_pool)
    ub = jnp.einsum('bngc,gcd->bngd', pooled, w_pool).reshape(bsz, n, POOL_W) * pool_scale
    br_b = ub @ w_b_out
    br_c = (s_b * _dwconv(s_c * s_h, w_sc)) @ w_c_out
    q = q.reshape(bsz, n, N_HEADS, HEAD_DIM)
    k = k.reshape(bsz, n, N_KV, HEAD_DIM)
    v = v.reshape(bsz, n, N_KV, HEAD_DIM)
    if ctx_k is None:
        o = _context_attention(q, k, v, sink)
    else:
        o = _latent_attention(_rope_2d(q), _rope_2d(k), v, ctx_k, ctx_v, sink)
    br_d = o @ w_d_out
    g = jax.nn.sigmoid(g_br).reshape(bsz, n, N_BRANCH, D_MODEL)
    merged = g[:, :, 0] * br_a + g[:, :, 1] * br_b + g[:, :, 2] * br_c + g[:, :, 3] * br_d
    return merged @ w_o, k, v


def _layer(x, cond, w_ada, b_ada, g_pre_mix, g_post_mix, g_pre_ffn, g_post_ffn, w_in, w_conv_a, b_conv_a,
           ln_g_a, ln_b_a, w_a_out, w_pool, pool_scale, w_b_out, w_sc, w_c_out, sink, w_d_out, w_o,
           w_ff1, w_ff2, ctx_k, ctx_v):
    mod = jax.nn.silu(cond) @ w_ada + b_ada
    sh1, sc1, gt1, sh2, sc2, gt2 = jnp.split(mod[:, None, :], 6, axis=-1)
    h = _rmsnorm(x, g_pre_mix) * (1 + sc1) + sh1
    m, k, v = _mixer(h, w_in, w_conv_a, b_conv_a, ln_g_a, ln_b_a, w_a_out, w_pool, pool_scale, w_b_out,
                     w_sc, w_c_out, sink, w_d_out, w_o, ctx_k, ctx_v)
    x = x + gt1 * _rmsnorm(m, g_post_mix)
    h = _rmsnorm(x, g_pre_ffn) * (1 + sc2) + sh2
    f = jnp.square(jax.nn.relu(h @ w_ff1)) @ w_ff2
    x = x + gt2 * _rmsnorm(f, g_post_ffn)
    return x, k, v


def setup_inputs(seed: int = 0) -> dict:
    key = jax.random.key(seed)
    ks = jax.random.split(key, 32)
    f32 = jnp.float32

    def nrm(i, shape, scale=1.0):
        return jax.random.normal(ks[i], shape, f32) * scale

    L = DEPTH
    return {
        'x_prompt': nrm(0, (BATCH, SEQ, D_MODEL)),
        'x_sample': nrm(1, (DEC_BATCH, DEC_SEQ, D_MODEL)),
        'cache_k': nrm(2, (DEC_BATCH, DEPTH, PAST_LEN, N_KV, HEAD_DIM)),
        'cache_v': nrm(3, (DEC_BATCH, DEPTH, PAST_LEN, N_KV, HEAD_DIM)),
        'c': nrm(4, (DEC_BATCH, D_MODEL)),
        'c_ctx': nrm(5, (D_MODEL,)),
        'w_ada': nrm(6, (L, D_MODEL, 6 * D_MODEL), 0.5 * D_MODEL ** -0.5),
        'b_ada': nrm(7, (L, 6 * D_MODEL), 0.02),
        'g_pre_mix': 1.0 + nrm(8, (L, D_MODEL), 0.05),
        'g_post_mix': 1.0 + nrm(9, (L, D_MODEL), 0.05),
        'g_pre_ffn': 1.0 + nrm(10, (L, D_MODEL), 0.05),
        'g_post_ffn': 1.0 + nrm(11, (L, D_MODEL), 0.05),
        'w_in': nrm(12, (L, D_MODEL, IN_W), D_MODEL ** -0.5),
        'w_conv_a': nrm(13, (L, CONV_K, CONV_W), CONV_K ** -0.5),
        'b_conv_a': nrm(14, (L, CONV_W), 0.02),
        'ln_g_a': 1.0 + nrm(15, (L, CONV_W), 0.05),
        'ln_b_a': nrm(16, (L, CONV_W), 0.02),
        'w_a_out': nrm(17, (L, CONV_W, D_MODEL), CONV_W ** -0.5),
        'w_pool': nrm(18, (L, N_POOL_G, POOL_G, POOL_G), POOL_G ** -0.5),
        'pool_scale': 1.0 + nrm(19, (L, POOL_W), 0.1),
        'w_b_out': nrm(20, (L, POOL_W, D_MODEL), POOL_W ** -0.5),
        'w_sc': nrm(21, (L, SC_K, SC_W), SC_K ** -0.5),
        'w_c_out': nrm(22, (L, SC_W, D_MODEL), SC_W ** -0.5),
        'sink': nrm(23, (L, N_HEADS), 0.5),
        'w_d_out': nrm(24, (L, ATT_W, D_MODEL), ATT_W ** -0.5),
        'w_o': nrm(25, (L, D_MODEL, D_MODEL), D_MODEL ** -0.5),
        'w_ff1': nrm(26, (L, D_MODEL, D_FF), D_MODEL ** -0.5),
        'w_ff2': nrm(27, (L, D_FF, D_MODEL), D_FF ** -0.5),
    }


def reference(x_prompt, x_sample, cache_k, cache_v, c, c_ctx, w_ada, b_ada, g_pre_mix, g_post_mix,
              g_pre_ffn, g_post_ffn, w_in, w_conv_a, b_conv_a, ln_g_a, ln_b_a, w_a_out, w_pool,
              pool_scale, w_b_out, w_sc, w_c_out, sink, w_d_out, w_o, w_ff1, w_ff2):
    def lw(l):
        return (w_ada[l], b_ada[l], g_pre_mix[l], g_post_mix[l], g_pre_ffn[l], g_post_ffn[l], w_in[l],
                w_conv_a[l], b_conv_a[l], ln_g_a[l], ln_b_a[l], w_a_out[l], w_pool[l], pool_scale[l],
                w_b_out[l], w_sc[l], w_c_out[l], sink[l], w_d_out[l], w_o[l], w_ff1[l], w_ff2[l])

    xp = x_prompt
    cond_ctx = c_ctx[None, :]
    ks, vs = [], []
    for l in range(DEPTH):
        xp, k, v = _layer(xp, cond_ctx, *lw(l), None, None)
        ks.append(k)
        vs.append(v)
    new_k = jnp.stack(ks, axis=1)
    new_v = jnp.stack(vs, axis=1)

    xs = x_sample
    for l in range(DEPTH):
        xs, _, _ = _layer(xs, c, *lw(l), cache_k[:, l], cache_v[:, l])

    return (xp, xs, new_k, new_v)
```

```cpp
#include <hip/hip_runtime.h>
#include <hip/hip_cooperative_groups.h>
#include <stdint.h>
#include <cstdio>
namespace cg = cooperative_groups;

typedef unsigned short bf16_t;
typedef short bf16x8 __attribute__((ext_vector_type(8)));
typedef short bf16x4 __attribute__((ext_vector_type(4)));
typedef float f32x4 __attribute__((ext_vector_type(4)));
typedef unsigned u32x4 __attribute__((ext_vector_type(4)));
#define DEVINL __device__ __forceinline__

constexpr int D = 1024, INW = 6400, CH = 8192  , ACTW = 1344  , DFF = 4096;
constexpr int LDH = 1088, LDHID = 4160, LW1 = 1088, LWM = 1344, LW4 = 4160;
constexpr int Z_AVAL = 0, Z_AGATE = 256, Z_POOL = 512, Z_SB = 768, Z_SC = 1024, Z_SH = 1280, Z_Q = 1536, Z_K = 2048, Z_V = 2176, Z_G = 2304;
constexpr float EPS = 1e-6f;
#ifndef NSTEPS
#define NSTEPS 50
#endif
constexpr size_t WO_IN = 0, WO_A = WO_IN + (size_t)6400 * LW1, WO_O = WO_A + (size_t)1024 * LWM, WO_F1 = WO_O + (size_t)1024 * LW1, WO_F2 = WO_F1 + (size_t)4096 * LW1,
                 W_LAYER = WO_F2 + (size_t)1024 * LW4;
constexpr size_t OFF_WT = 0, OFF_MOD = OFF_WT + 2 * W_LAYER * 2, OFF_CKV = OFF_MOD + 2 * 5 * 6144 * 4, OFF_TAB = OFF_CKV + 2 * 262144 * 2,
                 OFF_H = OFF_TAB + 8192, OFF_ACT = OFF_H + (size_t)CH * LDH * 2, OFF_Z = OFF_ACT + (size_t)CH * ACTW * 2,
                 OFF_MF = OFF_Z, OFF_HID = OFF_Z + (size_t)CH * D * 4, OFF_BAR = OFF_Z + (size_t)CH * INW * 2;
constexpr size_t OUT_K = 25165824, OUT_V = 27262976;

struct Params {
    const float *x_prompt, *x_sample, *cache_k, *cache_v, *c, *c_ctx, *w_ada, *b_ada, *g_pre_mix, *g_post_mix, *g_pre_ffn, *g_post_ffn, *w_in,
        *w_conv_a, *b_conv_a, *ln_g_a, *ln_b_a, *w_a_out, *w_pool, *pool_scale, *w_b_out, *w_sc, *w_c_out, *sink, *w_d_out, *w_o, *w_ff1, *w_ff2;
    float* out;
    char* ws;
};

DEVINL int tid() { int t = threadIdx.x; asm volatile("" : "+v"(t)); return t; }
DEVINL float bf_lo(uint32_t u) { return __uint_as_float(u << 16); }
DEVINL float bf_hi(uint32_t u) { return __uint_as_float(u & 0xffff0000u); }
typedef __bf16 bf16x2_t __attribute__((ext_vector_type(2)));
typedef float f32x2_t __attribute__((ext_vector_type(2)));
DEVINL uint32_t pack_bf16(float lo, float hi) { const f32x2_t v = {lo, hi}; const bf16x2_t b = __builtin_convertvector(v, bf16x2_t); return __builtin_bit_cast(uint32_t, b); }
DEVINL void unpack8(const uint4& u, float (&f)[8]) {
    f[0] = bf_lo(u.x); f[1] = bf_hi(u.x); f[2] = bf_lo(u.y); f[3] = bf_hi(u.y); f[4] = bf_lo(u.z); f[5] = bf_hi(u.z); f[6] = bf_lo(u.w); f[7] = bf_hi(u.w);
}
DEVINL uint4 pack8(const float (&f)[8]) { uint4 u; u.x = pack_bf16(f[0], f[1]); u.y = pack_bf16(f[2], f[3]); u.z = pack_bf16(f[4], f[5]); u.w = pack_bf16(f[6], f[7]); return u; }
DEVINL float sigmoidf_(float x) { return 1.f / (1.f + __expf(-x)); }
DEVINL float wave_sum(float v) {
#pragma unroll
    for (int o = 32; o > 0; o >>= 1) v += __shfl_xor(v, o);
    return v;
}
DEVINL bf16x8 as_bf16x8(const uint4& u) { union { uint4 a; bf16x8 b; } x; x.a = u; return x.b; }

#define SCHED_FENCE() __builtin_amdgcn_sched_barrier(0)
template <bool FKK>
DEVINL void gemm_compute(const char* cur, int aoff, int boff, int fq, int sw, f32x4 (&acc)[4][4]) {
#pragma unroll
    for (int kk = 0; kk < 2; ++kk) {
        if (FKK) SCHED_FENCE();
        bf16x8 af[4], bfr[4];
        const int co = ((kk * 4 + fq) ^ sw) << 4;
#pragma unroll
        for (int i = 0; i < 4; ++i) { af[i] = *(const bf16x8*)(cur + aoff + i * 2048 + co); bfr[i] = *(const bf16x8*)(cur + boff + i * 2048 + co); }
        __builtin_amdgcn_s_setprio(1);
#pragma unroll
        for (int mi = 0; mi < 4; ++mi)
#pragma unroll
            for (int ni = 0; ni < 4; ++ni) acc[mi][ni] = __builtin_amdgcn_mfma_f32_16x16x32_bf16(bfr[ni], af[mi], acc[mi][ni], 0, 0, 0);
        __builtin_amdgcn_s_setprio(0);
    }
}
struct NoHook { DEVINL void operator()(int, f32x4 (&)[4][4]) const {} };
template <int DEPTH, class Hook = NoHook>
DEVINL void gemm_loop(const bf16_t* __restrict__ A, int lda, const bf16_t* __restrict__ B, int ldb, int K, char* smem, f32x4 (&acc)[4][4], const Hook& hook = Hook()) {
    const int t = tid(), lane = t & 63, w = t >> 6, wm = w >> 1, wn = w & 1, fr = lane & 15, fq = lane >> 4;
    const int sc = t & 7, sr = t >> 3;
    const bf16_t* ag = A + (size_t)sr * lda + sc * 8;
    const bf16_t* bg = B + (size_t)sr * ldb + sc * 8;
    const int soff = sr * 128 + ((sc ^ ((sr >> 1) & 7)) << 4);
    const int aoff = (wm * 64 + fr) * 128, boff = 16384 + (wn * 64 + fr) * 128, sw = (fr >> 1) & 7;
    const int nk = K >> 6;
    u32x4 r0a[4], r0b[4], r1a[4], r1b[4];
#define G_LOAD(RA, RB, KT) { _Pragma("unroll") for (int i = 0; i < 4; ++i) { RA[i] = *(const u32x4*)(ag + (size_t)i * 32 * lda + (KT) * 64); RB[i] = *(const u32x4*)(bg + (size_t)i * 32 * ldb + (KT) * 64); } }
#define G_STORE(RA, RB, BUF) { _Pragma("unroll") for (int i = 0; i < 4; ++i) { *(u32x4*)(smem + (BUF) * 32768 + soff + i * 4096) = RA[i]; *(u32x4*)(smem + (BUF) * 32768 + 16384 + soff + i * 4096) = RB[i]; } }
    G_LOAD(r0a, r0b, 0);
    G_LOAD(r1a, r1b, 1);
    SCHED_FENCE();
    __syncthreads();
    G_STORE(r0a, r0b, 0);
    __syncthreads();
    for (int kt = 0; kt < nk; kt += 2) {
        G_LOAD(r0a, r0b, min(kt + 2, nk - 1));
        SCHED_FENCE();
        gemm_compute<false>(smem, aoff, boff, fq, sw, acc);
        SCHED_FENCE();
        G_STORE(r1a, r1b, 1);
        __syncthreads();
        G_LOAD(r1a, r1b, min(kt + 3, nk - 1));
        SCHED_FENCE();
        gemm_compute<false>(smem + 32768, aoff, boff, fq, sw, acc);
        SCHED_FENCE();
        hook(kt + 1, acc);
        G_STORE(r0a, r0b, 0);
        __syncthreads();
    }
#undef G_LOAD
#undef G_STORE
}
#define LAS3 __attribute__((address_space(3)))
template <class Hook = NoHook>
DEVINL void gemm_loop_dma(const bf16_t* __restrict__ A, int lda, const bf16_t* __restrict__ B, int ldb, int K, char* smem, f32x4 (&acc)[4][4], const Hook& hook = Hook()) {
    const int t = tid(), lane = t & 63, w = t >> 6, wm = w >> 1, wn = w & 1, fr = lane & 15, fq = lane >> 4;
    const int prow = lane >> 2, pslot = lane & 3, pg = (4 - (prow >> 2)) & 3;
    const bf16_t* ag = A + (size_t)(w * 16 + prow) * lda + ((pslot ^ pg) << 3);
    const bf16_t* bg = B + (size_t)(w * 16 + prow) * ldb + ((pslot ^ pg) << 3);
    const int fg = (4 - (fr >> 2)) & 3;
    const int aoff = (wm * 64 + fr) * 64 + ((fq ^ fg) << 4), boff = 8192 + (wn * 64 + fr) * 64 + ((fq ^ fg) << 4);
    const int nks = K >> 5;
    LAS3 char* lds = (LAS3 char*)smem;
    const int pw = w * 1024;
#define D_ISSUE(KS) { const int st_ = ((KS) % 3) * 16384; _Pragma("unroll") for (int i = 0; i < 2; ++i) { \
        __builtin_amdgcn_global_load_lds((const unsigned*)(ag + (size_t)i * 64 * lda + (KS) * 32), (LAS3 unsigned*)(lds + st_ + i * 4096 + pw), 16, 0, 0); \
        __builtin_amdgcn_global_load_lds((const unsigned*)(bg + (size_t)i * 64 * ldb + (KS) * 32), (LAS3 unsigned*)(lds + st_ + 8192 + i * 4096 + pw), 16, 0, 0); } }
    __builtin_amdgcn_s_barrier();
    D_ISSUE(0); D_ISSUE(1);
    for (int ks = 0; ks < nks; ++ks) {
        if (ks + 1 < nks) asm volatile("s_waitcnt vmcnt(4)" ::: "memory"); else asm volatile("s_waitcnt vmcnt(0)" ::: "memory");
        __builtin_amdgcn_s_barrier();
        asm volatile("" ::: "memory");
        if (ks + 2 < nks) D_ISSUE(ks + 2);
        SCHED_FENCE();
        {
            const char* cur = smem + (ks % 3) * 16384;
            bf16x8 af[4], bfr[4];
#pragma unroll
            for (int i = 0; i < 4; ++i) { af[i] = *(const bf16x8*)(cur + aoff + i * 1024); bfr[i] = *(const bf16x8*)(cur + boff + i * 1024); }
            __builtin_amdgcn_s_setprio(1);
#pragma unroll
            for (int mi = 0; mi < 4; ++mi)
#pragma unroll
                for (int ni = 0; ni < 4; ++ni) acc[mi][ni] = __builtin_amdgcn_mfma_f32_16x16x32_bf16(bfr[ni], af[mi], acc[mi][ni], 0, 0, 0);
            __builtin_amdgcn_s_setprio(0);
        }
        SCHED_FENCE();
        hook(ks, acc);
    }
#undef D_ISSUE
}
DEVINL void gemm_loop1(const bf16_t* __restrict__ A, int lda, const bf16_t* __restrict__ B, int ldb, int K, char* smem, f32x4 (&acc)[4][4]) {
    const int t = tid(), lane = t & 63, w = t >> 6, wm = w >> 1, wn = w & 1, fr = lane & 15, fq = lane >> 4;
    const int sc = t & 7, sr = t >> 3;
    const bf16_t* ag = A + (size_t)sr * lda + sc * 8;
    const bf16_t* bg = B + (size_t)sr * ldb + sc * 8;
    const int soff = sr * 128 + ((sc ^ ((sr >> 1) & 7)) << 4);
    u32x4 ra[4], rb[4];
    const int nk = K >> 6;
#pragma unroll
    for (int i = 0; i < 4; ++i) { ra[i] = *(const u32x4*)(ag + (size_t)i * 32 * lda); rb[i] = *(const u32x4*)(bg + (size_t)i * 32 * ldb); }
    __syncthreads();
#pragma unroll
    for (int i = 0; i < 4; ++i) { *(u32x4*)(smem + soff + i * 4096) = ra[i]; *(u32x4*)(smem + 16384 + soff + i * 4096) = rb[i]; }
    __syncthreads();
    const int aoff = (wm * 64 + fr) * 128, boff = 16384 + (wn * 64 + fr) * 128, sw = (fr >> 1) & 7;
    for (int kt = 0; kt < nk; ++kt) {
        const char* cur = smem + (kt & 1) * 32768;
        if (kt + 1 < nk) {
#pragma unroll
            for (int i = 0; i < 4; ++i) { ra[i] = *(const u32x4*)(ag + (size_t)i * 32 * lda + (kt + 1) * 64); rb[i] = *(const u32x4*)(bg + (size_t)i * 32 * ldb + (kt + 1) * 64); }
        }
        gemm_compute<false>(cur, aoff, boff, fq, sw, acc);
        if (kt + 1 < nk) {
            char* nxt = smem + ((kt + 1) & 1) * 32768;
#pragma unroll
            for (int i = 0; i < 4; ++i) { *(u32x4*)(nxt + soff + i * 4096) = ra[i]; *(u32x4*)(nxt + 16384 + soff + i * 4096) = rb[i]; }
        }
        __syncthreads();
    }
}
DEVINL void zero_acc(f32x4 (&acc)[4][4]) {
#pragma unroll
    for (int i = 0; i < 4; ++i)
#pragma unroll
        for (int j = 0; j < 4; ++j) acc[i][j] = (f32x4){0.f, 0.f, 0.f, 0.f};
}
DEVINL void tile_order(int t, int nN, int& pm, int& pn) { const int g = t / (8 * nN), r = t % (8 * nN); pn = r >> 3; pm = g * 8 + (r & 7); }
struct TileWalk {
    int nN, i, x, j, nb; bool xcd;
    DEVINL void init(int nN_) { nN = nN_; i = 0; xcd = (gridDim.x & 7) == 0; x = blockIdx.x & 7; j = blockIdx.x >> 3; nb = gridDim.x >> 3; }
    DEVINL bool next(int& pm, int& pn) {
        if (xcd) { const int s = i * nb + j; ++i; if (s >= 8 * nN) return false; pn = s >> 3; pm = x * 8 + (s & 7); return true; }
        const int t = blockIdx.x + i * gridDim.x; ++i; if (t >= 64 * nN) return false; tile_order(t, nN, pm, pn); return true;
    }
};

DEVINL void wt_tile2(const float* __restrict__ src, int K, int N, bf16_t* __restrict__ dst, int ldd, int tile0, char* smem) {
    const int nNt = N >> 6, t = tid();
    float* tl = (float*)smem;
    const int r = t >> 4, c4 = t & 15;
    f32x4 v[2][4];
#pragma unroll
    for (int u = 0; u < 2; ++u) {
        const int tile = tile0 + u, k0 = (tile / nNt) * 64, n0 = (tile % nNt) * 64;
#pragma unroll
        for (int i = 0; i < 4; ++i) v[u][i] = *(const f32x4*)(src + (size_t)(k0 + r + 16 * i) * N + n0 + c4 * 4);
    }
    asm volatile("" : "+v"(v[0][0]), "+v"(v[0][1]), "+v"(v[0][2]), "+v"(v[0][3]), "+v"(v[1][0]), "+v"(v[1][1]), "+v"(v[1][2]), "+v"(v[1][3]));
#pragma unroll
    for (int u = 0; u < 2; ++u)
#pragma unroll
        for (int i = 0; i < 4; ++i) { float* q = tl + u * 4160 + (r + 16 * i) * 65 + c4 * 4; q[0] = v[u][i][0]; q[1] = v[u][i][1]; q[2] = v[u][i][2]; q[3] = v[u][i][3]; }
    __syncthreads();
    const int n = t >> 2, kq = t & 3;
#pragma unroll
    for (int u = 0; u < 2; ++u) {
        const int tile = tile0 + u, k0 = (tile / nNt) * 64, n0 = (tile % nNt) * 64;
        uint32_t pk[8];
#pragma unroll
        for (int e = 0; e < 8; ++e) pk[e] = pack_bf16(tl[u * 4160 + (kq * 16 + 2 * e) * 65 + n], tl[u * 4160 + (kq * 16 + 2 * e + 1) * 65 + n]);
        uint4* o = (uint4*)(dst + (size_t)(n0 + n) * ldd + k0 + kq * 16);
        o[0] = make_uint4(pk[0], pk[1], pk[2], pk[3]); o[1] = make_uint4(pk[4], pk[5], pk[6], pk[7]);
    }
    __syncthreads();
}
DEVINL void mod_tile(const Params& p, int tile, char* smem) {
    const int l = tile / 96, n0 = (tile % 96) * 64, t = tid(), kg = t >> 6, col = t & 63;
    float* sl = (float*)smem;
    float* red = sl + 5 * 1024;
    for (int i = t; i < 5 * 1024; i += 256) { const int cb = i >> 10, k = i & 1023; const float x = cb == 0 ? p.c_ctx[k] : p.c[(cb - 1) * 1024 + k]; sl[i] = x * sigmoidf_(x); }
    __syncthreads();
    float a0 = 0.f, a1 = 0.f, a2 = 0.f, a3 = 0.f, a4 = 0.f;
    const float* wp = p.w_ada + ((size_t)l * 1024 + kg * 256) * 6144 + n0 + col;
#pragma unroll 1
    for (int k0 = 0; k0 < 256; k0 += 16) {
        float wv[16];
#pragma unroll
        for (int k = 0; k < 16; ++k) wv[k] = wp[(size_t)(k0 + k) * 6144];
        SCHED_FENCE();
#pragma unroll
        for (int k = 0; k < 16; ++k) {
            const int kk = kg * 256 + k0 + k;
            a0 += sl[kk] * wv[k]; a1 += sl[1024 + kk] * wv[k]; a2 += sl[2048 + kk] * wv[k]; a3 += sl[3072 + kk] * wv[k]; a4 += sl[4096 + kk] * wv[k];
        }
    }
    red[(kg * 5 + 0) * 64 + col] = a0; red[(kg * 5 + 1) * 64 + col] = a1; red[(kg * 5 + 2) * 64 + col] = a2; red[(kg * 5 + 3) * 64 + col] = a3; red[(kg * 5 + 4) * 64 + col] = a4;
    __syncthreads();
    float* mod = (float*)(p.ws + OFF_MOD);
    for (int i = t; i < 320; i += 256) {
        const int cb = i >> 6, cc = i & 63;
        const float s = red[(0 * 5 + cb) * 64 + cc] + red[(1 * 5 + cb) * 64 + cc] + red[(2 * 5 + cb) * 64 + cc] + red[(3 * 5 + cb) * 64 + cc];
        mod[((size_t)l * 5 + cb) * 6144 + n0 + cc] = s + p.b_ada[l * 6144 + n0 + cc];
    }
    __syncthreads();
}
DEVINL void phase_prep(const Params& p, char* smem) {
    const int t = tid();
    bf16_t* WT = (bf16_t*)(p.ws + OFF_WT);
    constexpr int NMOD = 192, NW = 4224  , NC = 256, NT = NMOD + NW + NC + 1;
    for (int tile = blockIdx.x; tile < NT; tile += gridDim.x) {
        if (tile < NMOD) mod_tile(p, tile, smem);
        else if (tile < NMOD + NW) {
            int wt = (tile - NMOD) * 2; const int l = wt / 4224; wt -= l * 4224;
            const float* src; int K, N, ldd; size_t dofs;
            if (wt < 1600) { src = p.w_in + (size_t)l * 1024 * 6400; K = 1024; N = 6400; ldd = LW1; dofs = WO_IN; }
            else if (wt < 1664) { wt -= 1600; src = p.w_a_out + (size_t)l * 256 * 1024; K = 256; N = 1024; ldd = LWM; dofs = WO_A; }
            else if (wt < 1728) { wt -= 1664; src = p.w_b_out + (size_t)l * 256 * 1024; K = 256; N = 1024; ldd = LWM; dofs = WO_A + 256; }
            else if (wt < 1792) { wt -= 1728; src = p.w_c_out + (size_t)l * 256 * 1024; K = 256; N = 1024; ldd = LWM; dofs = WO_A + 512; }
            else if (wt < 1920) { wt -= 1792; src = p.w_d_out + (size_t)l * 512 * 1024; K = 512; N = 1024; ldd = LWM; dofs = WO_A + 768; }
            else if (wt < 2176) { wt -= 1920; src = p.w_o + (size_t)l * 1024 * 1024; K = 1024; N = 1024; ldd = LW1; dofs = WO_O; }
            else if (wt < 3200) { wt -= 2176; src = p.w_ff1 + (size_t)l * 1024 * 4096; K = 1024; N = 4096; ldd = LW1; dofs = WO_F1; }
            else { wt -= 3200; src = p.w_ff2 + (size_t)l * 4096 * 1024; K = 4096; N = 1024; ldd = LW4; dofs = WO_F2; }
            wt_tile2(src, K, N, WT + (size_t)l * W_LAYER + dofs, ldd, wt, smem);
        } else if (tile < NMOD + NW + NC) {
            const int i = (tile - NMOD - NW) * 256 + t;
            const float* src = (i < 32768) ? p.cache_k + (size_t)i * 8 : p.cache_v + (size_t)(i - 32768) * 8;
            const float4 a = *(const float4*)src, b = *(const float4*)(src + 4);
            uint4 o; o.x = pack_bf16(a.x, a.y); o.y = pack_bf16(a.z, a.w); o.z = pack_bf16(b.x, b.y); o.w = pack_bf16(b.z, b.w);
            *(uint4*)(p.ws + OFF_CKV + (size_t)i * 16) = o;
        } else {
            float2* tab = (float2*)(p.ws + OFF_TAB);
            for (int i = t; i < 1024; i += 256) {
                const int pos = i >> 4, fi = i & 15;
                const float freq = exp2f(-(float)fi * (13.287712379549449f / 16.f));
                const float ang = (float)pos * freq;
                tab[i] = make_float2(__cosf(ang), __sinf(ang));
            }
        }
    }
}

DEVINL void rowpass(const Params& p, int chunk, int mode, int lpost, int which_post, int hsel, int lh) {
    const int lane = tid() & 63, w = tid() >> 6;
    const float* mod = (const float*)(p.ws + OFF_MOD);
    const bf16_t* MF = (const bf16_t*)(p.ws + OFF_MF);
    bf16_t* H = (bf16_t*)(p.ws + OFF_H);
    const float* xin = chunk == 0 ? p.x_prompt : p.x_sample + (size_t)(chunk - 1) * CH * D;
    float* xres = p.out + (size_t)chunk * CH * D;
    const float* xsrc = mode == 0 ? xin : xres;
    const float* gpost = which_post == 1 ? p.g_post_mix + lpost * D : p.g_post_ffn + lpost * D;
    const float* gpre = hsel == 1 ? p.g_pre_mix + lh * D : p.g_pre_ffn + lh * D;
    for (int base = (blockIdx.x * 4 + w) * 4; base < CH; base += gridDim.x * 16) {
        const int cb = chunk == 0 ? 0 : 1 + (chunk - 1) * 2 + (base >> 12);
        float pg[16], hg[16], hs[16];
        if (mode == 1) {
            const float* gate = mod + ((size_t)lpost * 5 + cb) * 6144 + (which_post == 1 ? 2 : 5) * 1024;
            float4 gp[4], gt[4];
#pragma unroll
            for (int i = 0; i < 4; ++i) { const int c = i * 256 + lane * 4; gp[i] = *(const float4*)(gpost + c); gt[i] = *(const float4*)(gate + c); }
            SCHED_FENCE();
#pragma unroll
            for (int i = 0; i < 4; ++i) { pg[4 * i] = gp[i].x * gt[i].x; pg[4 * i + 1] = gp[i].y * gt[i].y; pg[4 * i + 2] = gp[i].z * gt[i].z; pg[4 * i + 3] = gp[i].w * gt[i].w; }
        }
        if (hsel) {
            const float* mb = mod + ((size_t)lh * 5 + cb) * 6144 + (hsel == 1 ? 0 : 3) * 1024;
            float4 g[4], sh[4], sc[4];
#pragma unroll
            for (int i = 0; i < 4; ++i) { const int c = i * 256 + lane * 4; g[i] = *(const float4*)(gpre + c); sh[i] = *(const float4*)(mb + c); sc[i] = *(const float4*)(mb + 1024 + c); }
            SCHED_FENCE();
#pragma unroll
            for (int i = 0; i < 4; ++i) {
                hg[4 * i] = g[i].x * (1.f + sc[i].x); hg[4 * i + 1] = g[i].y * (1.f + sc[i].y); hg[4 * i + 2] = g[i].z * (1.f + sc[i].z); hg[4 * i + 3] = g[i].w * (1.f + sc[i].w);
                hs[4 * i] = sh[i].x; hs[4 * i + 1] = sh[i].y; hs[4 * i + 2] = sh[i].z; hs[4 * i + 3] = sh[i].w;
            }
        }
#pragma unroll 1
        for (int pr = 0; pr < 4; ++pr) {
            const int row = base + pr;
            float x[16], m[16];
#pragma unroll
            for (int i = 0; i < 4; ++i) {
                const size_t o = (size_t)row * D + i * 256 + lane * 4;
                const float4 v = *(const float4*)(xsrc + o);
                x[4 * i] = v.x; x[4 * i + 1] = v.y; x[4 * i + 2] = v.z; x[4 * i + 3] = v.w;
                if (mode == 1) { const uint2 q = *(const uint2*)(MF + o); m[4 * i] = bf_lo(q.x); m[4 * i + 1] = bf_hi(q.x); m[4 * i + 2] = bf_lo(q.y); m[4 * i + 3] = bf_hi(q.y); }
            }
            SCHED_FENCE();
            if (mode == 1) {
                float ss = 0.f;
#pragma unroll
                for (int i = 0; i < 16; ++i) ss += m[i] * m[i];
                ss = wave_sum(ss);
                const float rs = rsqrtf(ss * (1.f / D) + EPS);
#pragma unroll
                for (int i = 0; i < 16; ++i) x[i] += (m[i] * rs) * pg[i];
            }
#pragma unroll
            for (int i = 0; i < 4; ++i) *(float4*)(xres + (size_t)row * D + i * 256 + lane * 4) = make_float4(x[4 * i], x[4 * i + 1], x[4 * i + 2], x[4 * i + 3]);
            if (hsel) {
                float ss = 0.f;
#pragma unroll
                for (int i = 0; i < 16; ++i) ss += x[i] * x[i];
                ss = wave_sum(ss);
                const float rs = rsqrtf(ss * (1.f / D) + EPS);
#pragma unroll
                for (int i = 0; i < 4; ++i) {
                    const float h0 = x[4 * i] * rs * hg[4 * i] + hs[4 * i], h1 = x[4 * i + 1] * rs * hg[4 * i + 1] + hs[4 * i + 1];
                    const float h2 = x[4 * i + 2] * rs * hg[4 * i + 2] + hs[4 * i + 2], h3 = x[4 * i + 3] * rs * hg[4 * i + 3] + hs[4 * i + 3];
                    *(uint2*)(H + (size_t)row * LDH + i * 256 + lane * 4) = make_uint2(pack_bf16(h0, h1), pack_bf16(h2, h3));
                }
            }
        }
    }
}

struct MergeHook {
    const bf16_t* zg;
    bool on;
    DEVINL void operator()(int k, f32x4 (&acc)[4][4]) const {
        if (!on || (k & 7) != 7 || k > 23) return;
        const int b = k >> 3;
        const bf16_t* z = zg + b * 1024;
#pragma unroll
        for (int hm = 0; hm < 2; ++hm) {
            uint2 ga[2][4], gb[2][4];
#pragma unroll
            for (int m2 = 0; m2 < 2; ++m2)
#pragma unroll
                for (int ni = 0; ni < 4; ++ni) { const int mi = hm * 2 + m2; ga[m2][ni] = *(const uint2*)(z + (size_t)mi * 16 * INW + ni * 16); gb[m2][ni] = *(const uint2*)(z + 1024 + (size_t)mi * 16 * INW + ni * 16); }
            SCHED_FENCE();
#pragma unroll
            for (int m2 = 0; m2 < 2; ++m2)
#pragma unroll
                for (int ni = 0; ni < 4; ++ni) {
                    const int mi = hm * 2 + m2;
                    const float a0 = bf_lo(ga[m2][ni].x), a1 = bf_hi(ga[m2][ni].x), a2 = bf_lo(ga[m2][ni].y), a3 = bf_hi(ga[m2][ni].y);
                    const float b0 = bf_lo(gb[m2][ni].x), b1 = bf_hi(gb[m2][ni].x), b2 = bf_lo(gb[m2][ni].y), b3 = bf_hi(gb[m2][ni].y);
                    acc[mi][ni][0] *= (1.f + __expf(-b0)) * __builtin_amdgcn_rcpf(1.f + __expf(-a0));
                    acc[mi][ni][1] *= (1.f + __expf(-b1)) * __builtin_amdgcn_rcpf(1.f + __expf(-a1));
                    acc[mi][ni][2] *= (1.f + __expf(-b2)) * __builtin_amdgcn_rcpf(1.f + __expf(-a2));
                    acc[mi][ni][3] *= (1.f + __expf(-b3)) * __builtin_amdgcn_rcpf(1.f + __expf(-a3));
                }
            SCHED_FENCE();
        }
    }
};
struct GemmDesc { const bf16_t* A; const bf16_t* W; int lda, ldb, K, nN, epi, l, chunk; };
DEVINL void phase_gemm_any(const Params& p, const GemmDesc& g, char* smem) {
    const int lane = tid() & 63, w = tid() >> 6, wm = w >> 1, wn = w & 1, fr = lane & 15, fq = lane >> 4;
    bf16_t* Z = (bf16_t*)(p.ws + OFF_Z);
    bf16_t* MF = (bf16_t*)(p.ws + OFF_MF);
    bf16_t* HID = (bf16_t*)(p.ws + OFF_HID);
    bf16_t* MG = (bf16_t*)(p.ws + OFF_H);
    TileWalk tw; tw.init(g.nN);
    for (int pm, pn; tw.next(pm, pn);) {
        f32x4 acc[4][4]; zero_acc(acc);
        const int row0 = pm * 128 + wm * 64 + fr, col0 = pn * 128 + wn * 64 + fq * 4;
        MergeHook hook; hook.on = (g.epi == 3); hook.zg = Z + (size_t)row0 * INW + Z_G + col0;
        gemm_loop_dma(g.A + (size_t)pm * 128 * g.lda, g.lda, g.W + (size_t)pn * 128 * g.ldb, g.ldb, g.K, smem, acc, hook);
        if (g.epi == 0) {
            const bool kv = (g.chunk == 0) && (pn == 16 || pn == 17);
            bf16_t* zo = Z + (size_t)row0 * INW + col0;
            asm volatile("" : "+v"(zo));
#pragma unroll
            for (int mi = 0; mi < 4; ++mi)
#pragma unroll
                for (int ni = 0; ni < 4; ++ni) {
                    const f32x4 v = acc[mi][ni];
                    *(uint2*)(zo + (size_t)mi * 16 * INW + ni * 16) = make_uint2(pack_bf16(v[0], v[1]), pack_bf16(v[2], v[3]));
                    if (kv) {
                        const int row = row0 + mi * 16, cl = wn * 64 + ni * 16 + fq * 4;
                        float* dst = p.out + (pn == 16 ? OUT_K : OUT_V) + ((size_t)((row >> 8) * 2 + g.l) * 256 + (row & 255)) * 128 + cl;
                        *(f32x4*)dst = v;
                    }
                }
        } else if (g.epi == 1) {
            bf16_t* mo = MF + (size_t)row0 * D + col0;
            asm volatile("" : "+v"(mo));
#pragma unroll
            for (int mi = 0; mi < 4; ++mi)
#pragma unroll
                for (int ni = 0; ni < 4; ++ni) { const f32x4 v = acc[mi][ni]; *(uint2*)(mo + (size_t)mi * 16 * D + ni * 16) = make_uint2(pack_bf16(v[0], v[1]), pack_bf16(v[2], v[3])); }
        } else if (g.epi == 2) {
            bf16_t* ho = HID + (size_t)row0 * LDHID + col0;
            asm volatile("" : "+v"(ho));
#pragma unroll
            for (int mi = 0; mi < 4; ++mi)
#pragma unroll
                for (int ni = 0; ni < 4; ++ni) {
                    const f32x4 v = acc[mi][ni];
                    const float r0 = fmaxf(v[0], 0.f), r1 = fmaxf(v[1], 0.f), r2 = fmaxf(v[2], 0.f), r3 = fmaxf(v[3], 0.f);
                    *(uint2*)(ho + (size_t)mi * 16 * LDHID + ni * 16) = make_uint2(pack_bf16(r0 * r0, r1 * r1), pack_bf16(r2 * r2, r3 * r3));
                }
        } else {
            const bf16_t* z3 = hook.zg + 3 * 1024;
            bf16_t* mg = MG + (size_t)row0 * LDH + col0;
            uint2 g3[4][4];
#pragma unroll
            for (int mi = 0; mi < 4; ++mi)
#pragma unroll
                for (int ni = 0; ni < 4; ++ni) g3[mi][ni] = *(const uint2*)(z3 + (size_t)mi * 16 * INW + ni * 16);
            SCHED_FENCE();
#pragma unroll
            for (int mi = 0; mi < 4; ++mi)
#pragma unroll
                for (int ni = 0; ni < 4; ++ni) {
                    const uint2 gg = g3[mi][ni];
                    const f32x4 v = acc[mi][ni];
                    const float r0 = v[0] * sigmoidf_(bf_lo(gg.x)), r1 = v[1] * sigmoidf_(bf_hi(gg.x)), r2 = v[2] * sigmoidf_(bf_lo(gg.y)), r3 = v[3] * sigmoidf_(bf_hi(gg.y));
                    *(uint2*)(mg + (size_t)mi * 16 * LDH + ni * 16) = make_uint2(pack_bf16(r0, r1), pack_bf16(r2, r3));
                }
        }
    }
}

struct AttTile { const bf16_t* kptr; const bf16_t* vptr; int stride, kstart; bool rope, maskf; };
DEVINL bool att_tile(int it, bool is_ctx, const bf16_t* Zs, const bf16_t* CKb, int q0, int kvh, AttTile& d) {
    d.rope = false; d.maskf = false;
    if (is_ctx) { d.kstart = it * 64; d.kptr = Zs + (size_t)d.kstart * INW + Z_K + kvh * 64; d.vptr = d.kptr + 128; d.stride = INW; return true; }
    if (it < 5) {
        d.kstart = (q0 & ~63) - 128 + it * 64; d.stride = INW; d.rope = true; d.maskf = true;
        if (d.kstart < 0 || d.kstart >= 4096) return false;
        d.kptr = Zs + (size_t)d.kstart * INW + Z_K + kvh * 64; d.vptr = d.kptr + 128; return true;
    }
    d.kstart = (it - 5) * 64; d.kptr = CKb + (size_t)d.kstart * 128 + kvh * 64; d.vptr = d.kptr + 262144; d.stride = 128; return true;
}
DEVINL void attn_unit(const Params& p, int chunk, int layer, int unit, char* smem) {
    const int t = tid(), lane = t & 63, w = t >> 6, fr = lane & 15, fq = lane >> 4;
    const bool is_ctx = (chunk == 0);
    int seq_base, q0, kvh, bseq = 0;
    if (is_ctx) { seq_base = (unit >> 4) * 256; q0 = ((unit >> 1) & 7) * 32; kvh = unit & 1; }
    else { const int sl = unit >> 8; seq_base = sl * 4096; q0 = ((unit >> 1) & 127) * 32; kvh = unit & 1; bseq = (chunk - 1) * 2 + sl; }
    const int head = kvh * 4 + w;
    const bf16_t* Zs = (const bf16_t*)(p.ws + OFF_Z) + (size_t)seq_base * INW;
    const bf16_t* CKb = (const bf16_t*)(p.ws + OFF_CKV) + (size_t)(bseq * 2 + layer) * 256 * 128;
    const float2* tab = (const float2*)(p.ws + OFF_TAB);
    bf16_t* ACT = (bf16_t*)(p.ws + OFF_ACT);
    char* Ks = smem;
    bf16_t* Vt = (bf16_t*)(smem + 8192);
    constexpr int VS = 68;

    bf16x8 qf[2][2];
#pragma unroll
    for (int qg = 0; qg < 2; ++qg)
#pragma unroll
        for (int dh = 0; dh < 2; ++dh) {
            const int pos = q0 + qg * 16 + fr;
            uint4 u = *(const uint4*)(Zs + (size_t)pos * INW + Z_Q + head * 64 + dh * 32 + fq * 8);
            if (!is_ctx) {
                uint4 pu; pu.x = __shfl_xor((int)u.x, 32); pu.y = __shfl_xor((int)u.y, 32); pu.z = __shfl_xor((int)u.z, 32); pu.w = __shfl_xor((int)u.w, 32);
                float x[8], y[8]; unpack8(u, x); unpack8(pu, y);
                const int pi = dh == 0 ? (pos >> 6) : (pos & 63);
                const float2* tp = tab + pi * 16 + (fq & 1) * 8;
                const float sgn = fq < 2 ? -1.f : 1.f;
#pragma unroll
                for (int e = 0; e < 8; ++e) { const float2 cs = tp[e]; x[e] = x[e] * cs.x + sgn * y[e] * cs.y; }
                u = pack8(x);
            }
            qf[qg][dh] = as_bf16x8(u);
        }
    f32x4 o[2][4];
#pragma unroll
    for (int i = 0; i < 2; ++i)
#pragma unroll
        for (int j = 0; j < 4; ++j) o[i][j] = (f32x4){0.f, 0.f, 0.f, 0.f};
    const float sk2 = p.sink[layer * 8 + head] * 1.4426950408889634f;
    float mrow[2], lsum[2];
#pragma unroll
    for (int i = 0; i < 2; ++i) { mrow[i] = sk2; lsum[i] = fq == 0 ? 1.f : 0.f; }
    const float sc2 = 0.125f * 1.4426950408889634f;

    const int ntiles = is_ctx ? 4 : 9;
    const int key = t >> 2, cp = t & 3, c = (cp & 1) + ((cp >> 1) << 2);
    const int vkey = t & 63, vch = t >> 6;
    AttTile cur; int it = 0;
    while (!att_tile(it, is_ctx, Zs, CKb, q0, kvh, cur)) ++it;
    u32x4 ku1, ku2, vu0, vu1;
#define ATT_LOAD(d) { const bf16_t* src = (d).kptr + (size_t)key * (d).stride + c * 8; ku1 = *(const u32x4*)src; ku2 = *(const u32x4*)(src + 16); \
        const bf16_t* vs = (d).vptr + (size_t)vkey * (d).stride + vch * 8; vu0 = *(const u32x4*)vs; vu1 = *(const u32x4*)(vs + 32); \
        }
    ATT_LOAD(cur);
    for (;;) {
        __syncthreads();
        {
            uint4 u1 = make_uint4(ku1[0], ku1[1], ku1[2], ku1[3]), u2 = make_uint4(ku2[0], ku2[1], ku2[2], ku2[3]);
            if (cur.rope) {
                const int kpos = cur.kstart + key, pi = c < 4 ? (kpos >> 6) : (kpos & 63); const float2* tp = tab + pi * 16 + (c & 1) * 8;
                float2 cs[8];
#pragma unroll
                for (int e = 0; e < 8; ++e) cs[e] = tp[e];
                float x1[8], x2[8], o1[8], o2[8]; unpack8(u1, x1); unpack8(u2, x2);
#pragma unroll
                for (int e = 0; e < 8; ++e) { o1[e] = x1[e] * cs[e].x - x2[e] * cs[e].y; o2[e] = x2[e] * cs[e].x + x1[e] * cs[e].y; }
                u1 = pack8(o1); u2 = pack8(o2);
            }
            *(uint4*)(Ks + key * 128 + ((c ^ (key & 7)) << 4)) = u1;
            *(uint4*)(Ks + key * 128 + (((c + 2) ^ (key & 7)) << 4)) = u2;
#pragma unroll
            for (int i = 0; i < 2; ++i) {
                const u32x4 u = i == 0 ? vu0 : vu1;
                bf16_t* dst = Vt + ((vch + 4 * i) * 8) * VS + vkey;
                dst[0] = (bf16_t)(u[0] & 0xffff); dst[VS] = (bf16_t)(u[0] >> 16); dst[2 * VS] = (bf16_t)(u[1] & 0xffff); dst[3 * VS] = (bf16_t)(u[1] >> 16);
                dst[4 * VS] = (bf16_t)(u[2] & 0xffff); dst[5 * VS] = (bf16_t)(u[2] >> 16); dst[6 * VS] = (bf16_t)(u[3] & 0xffff); dst[7 * VS] = (bf16_t)(u[3] >> 16);
            }
        }
        __syncthreads();
        AttTile nxt; int nit = it + 1; bool have = false;
        while (nit < ntiles) { if (att_tile(nit, is_ctx, Zs, CKb, q0, kvh, nxt)) { have = true; break; } ++nit; }
        if (have) ATT_LOAD(nxt);
        SCHED_FENCE();
        const int kstart = cur.kstart; const bool maskf = cur.maskf;
#pragma unroll 1
        for (int hk = 0; hk < 2; ++hk) {
            bf16x8 kf[2][2], vf[4];
#pragma unroll
            for (int kb = 0; kb < 2; ++kb)
#pragma unroll
                for (int dh = 0; dh < 2; ++dh) { const int row = hk * 32 + kb * 16 + fr; kf[kb][dh] = *(const bf16x8*)(Ks + row * 128 + (((dh * 4 + fq) ^ (row & 7)) << 4)); }
#pragma unroll
            for (int di = 0; di < 4; ++di) {
                const bf16_t* vp = Vt + (di * 16 + fr) * VS + hk * 32 + fq * 4;
                const bf16x4 lo = *(const bf16x4*)vp, hi = *(const bf16x4*)(vp + 16);
                vf[di] = __builtin_shufflevector(lo, hi, 0, 1, 2, 3, 4, 5, 6, 7);
            }
#pragma unroll
            for (int qg = 0; qg < 2; ++qg) {
                f32x4 s[2];
#pragma unroll
                for (int kb = 0; kb < 2; ++kb) {
                    s[kb] = __builtin_amdgcn_mfma_f32_16x16x32_bf16(kf[kb][0], qf[qg][0], (f32x4){0.f, 0.f, 0.f, 0.f}, 0, 0, 0);
                    s[kb] = __builtin_amdgcn_mfma_f32_16x16x32_bf16(kf[kb][1], qf[qg][1], s[kb], 0, 0, 0);
                }
                const int qpos = q0 + qg * 16 + fr;
                float mx = -1e30f;
#pragma unroll
                for (int kb = 0; kb < 2; ++kb)
#pragma unroll
                    for (int j = 0; j < 4; ++j) {
                        float v = s[kb][j] * sc2;
                        if (maskf) { const int d = qpos - (kstart + hk * 32 + kb * 16 + fq * 4 + j); if (d > 128 || d < -128) v = -1e30f; }
                        s[kb][j] = v; mx = fmaxf(mx, v);
                    }
                mx = fmaxf(mx, __shfl_xor(mx, 16)); mx = fmaxf(mx, __shfl_xor(mx, 32));
                const float mn = fmaxf(mrow[qg], mx), alpha = exp2f(mrow[qg] - mn);
                mrow[qg] = mn;
                float ps = 0.f;
#pragma unroll
                for (int kb = 0; kb < 2; ++kb)
#pragma unroll
                    for (int j = 0; j < 4; ++j) { const float pv = exp2f(s[kb][j] - mn); s[kb][j] = pv; ps += pv; }
                lsum[qg] = lsum[qg] * alpha + ps;
#pragma unroll
                for (int di = 0; di < 4; ++di) { o[qg][di][0] *= alpha; o[qg][di][1] *= alpha; o[qg][di][2] *= alpha; o[qg][di][3] *= alpha; }
                uint4 pu; pu.x = pack_bf16(s[0][0], s[0][1]); pu.y = pack_bf16(s[0][2], s[0][3]); pu.z = pack_bf16(s[1][0], s[1][1]); pu.w = pack_bf16(s[1][2], s[1][3]);
                const bf16x8 pf = as_bf16x8(pu);
#pragma unroll
                for (int di = 0; di < 4; ++di) o[qg][di] = __builtin_amdgcn_mfma_f32_16x16x32_bf16(vf[di], pf, o[qg][di], 0, 0, 0);
            }
        }
        if (!have) break;
        cur = nxt; it = nit;
    }
#undef ATT_LOAD
#pragma unroll
    for (int qg = 0; qg < 2; ++qg) {
        float l = lsum[qg]; l += __shfl_xor(l, 16); l += __shfl_xor(l, 32);
        const float inv = 1.f / l;
        const int tok = seq_base + q0 + qg * 16 + fr;
#pragma unroll
        for (int di = 0; di < 4; ++di) {
            const f32x4 v = o[qg][di];
            *(uint2*)(ACT + (size_t)tok * ACTW + 768 + head * 64 + di * 16 + fq * 4) = make_uint2(pack_bf16(v[0] * inv, v[1] * inv), pack_bf16(v[2] * inv, v[3] * inv));
        }
    }
}

DEVINL void conva_tile(const Params& p, int chunk, int l, int tile, char* smem) {
    const int t = tid(), lane = t & 63, w = t >> 6;
    const int S = chunk == 0 ? 256 : 4096;
    const int tok0 = tile * 16, pos0 = tok0 % S, sb = tok0 - pos0;
    const bf16_t* Z = (const bf16_t*)(p.ws + OFF_Z);
    bf16_t* ACT = (bf16_t*)(p.ws + OFF_ACT);
    float* glu = (float*)smem;
    {
        const int chk = t & 31, r0 = t >> 5;
#pragma unroll
        for (int h = 0; h < 2; ++h) {
            uint4 a[3], b[3];
#pragma unroll
            for (int i = 0; i < 3; ++i) {
                const int r = r0 + 8 * (h * 3 + i), pos = pos0 - 15 + r, pc = min(max(pos, 0), S - 1);
                const bf16_t* src = Z + (size_t)(sb + pc) * INW + chk * 8;
                a[i] = *(const uint4*)(src + Z_AVAL); b[i] = *(const uint4*)(src + Z_AGATE);
            }
            SCHED_FENCE();
#pragma unroll
            for (int i = 0; i < 3; ++i) {
                const int r = r0 + 8 * (h * 3 + i), pos = pos0 - 15 + r;
                if (r < 46) {
                    const float keep = (pos >= 0 && pos < S) ? 1.f : 0.f;
                    float av[8], bv[8], g[8]; unpack8(a[i], av); unpack8(b[i], bv);
#pragma unroll
                    for (int e = 0; e < 8; ++e) g[e] = keep * av[e] * sigmoidf_(bv[e]);
                    float4* d = (float4*)(glu + r * 256 + chk * 8);
                    d[0] = make_float4(g[0], g[1], g[2], g[3]); d[1] = make_float4(g[4], g[5], g[6], g[7]);
                }
            }
        }
    }
    __syncthreads();
    {
        float wv[31];
#pragma unroll
        for (int k = 0; k < 31; ++k) wv[k] = p.w_conv_a[((size_t)l * 31 + k) * 256 + t];
        const float bias = p.b_conv_a[l * 256 + t];
        for (int i = 0; i < 16; ++i) {
            float s = bias;
#pragma unroll
            for (int k = 0; k < 31; ++k) s += wv[k] * glu[(i + k) * 256 + t];
            glu[i * 256 + t] = s;
        }
    }
    __syncthreads();
    {
        const float4 g = *(const float4*)(p.ln_g_a + l * 256 + lane * 4), b = *(const float4*)(p.ln_b_a + l * 256 + lane * 4);
#pragma unroll
        for (int i = 0; i < 4; ++i) {
            const int r = w * 4 + i;
            const float4 v = *(const float4*)(glu + r * 256 + lane * 4);
            const float mu = wave_sum(v.x + v.y + v.z + v.w) * (1.f / 256.f);
            const float d0 = v.x - mu, d1 = v.y - mu, d2 = v.z - mu, d3 = v.w - mu;
            const float var = wave_sum(d0 * d0 + d1 * d1 + d2 * d2 + d3 * d3) * (1.f / 256.f);
            const float rs = rsqrtf(var + EPS);
            float y0 = d0 * rs * g.x + b.x, y1 = d1 * rs * g.y + b.y, y2 = d2 * rs * g.z + b.z, y3 = d3 * rs * g.w + b.w;
            y0 *= sigmoidf_(y0); y1 *= sigmoidf_(y1); y2 *= sigmoidf_(y2); y3 *= sigmoidf_(y3);
            *(uint2*)(ACT + (size_t)(tok0 + r) * ACTW + 0 + lane * 4) = make_uint2(pack_bf16(y0, y1), pack_bf16(y2, y3));
        }
    }
}
DEVINL void pool_tile(const Params& p, int chunk, int l, int tile, char* smem) {
    const int t = tid();
    const int S = chunk == 0 ? 256 : 4096;
    const int tok0 = tile * 32, pos0 = tok0 % S, sb = tok0 - pos0;
    const bf16_t* Z = (const bf16_t*)(p.ws + OFF_Z);
    bf16_t* ACT = (bf16_t*)(p.ws + OFF_ACT);
    float* u = (float*)smem;
    {
        const int chk = t & 31, r0 = t >> 5;
#pragma unroll
        for (int h = 0; h < 2; ++h) {
            uint4 av[3];
#pragma unroll
            for (int i = 0; i < 3; ++i) { const int pos = pos0 - 8 + r0 + 8 * (h * 3 + i), pc = min(max(pos, 0), S - 1); av[i] = *(const uint4*)(Z + (size_t)(sb + pc) * INW + Z_POOL + chk * 8); }
            SCHED_FENCE();
#pragma unroll
            for (int i = 0; i < 3; ++i) {
                const int r = r0 + 8 * (h * 3 + i), pos = pos0 - 8 + r;
                float g[8]; unpack8(av[i], g);
                const float keep = (pos >= 0 && pos < S) ? 1.f : 0.f;
                float4* d = (float4*)(u + r * 256 + chk * 8);
                d[0] = make_float4(g[0] * keep, g[1] * keep, g[2] * keep, g[3] * keep); d[1] = make_float4(g[4] * keep, g[5] * keep, g[6] * keep, g[7] * keep);
            }
        }
    }
    __syncthreads();
    const int gi = t >> 6, w2 = 1 << gi;
    for (int i = 0; i < 32; ++i) {
        const int pos = pos0 + i;
        float s = 0.f;
        for (int j = -w2; j < w2; ++j) s += u[(i + 8 + j) * 256 + t];
        const int lo = max(pos - w2, 0), hi = min(pos + w2, S);
        const float pooled = s / (float)(hi - lo) - u[(i + 8) * 256 + t];
        u[i * 256 + t] = pooled;
    }
    __syncthreads();
    float acc[32];
#pragma unroll
    for (int i = 0; i < 32; ++i) acc[i] = 0.f;
    const float* wp = p.w_pool + ((size_t)l * 4 + gi) * 4096 + (t & 63);
#pragma unroll 1
    for (int c0 = 0; c0 < 64; c0 += 8) {
        float wv[8];
#pragma unroll
        for (int c = 0; c < 8; ++c) wv[c] = wp[(c0 + c) * 64];
#pragma unroll
        for (int c = 0; c < 8; ++c) {
            const float* up = u + gi * 64 + c0 + c;
#pragma unroll
            for (int i = 0; i < 32; ++i) acc[i] += up[i * 256] * wv[c];
            SCHED_FENCE();
        }
    }
    const float ps = p.pool_scale[l * 256 + t];
#pragma unroll
    for (int i = 0; i < 32; ++i) {
        const float v = acc[i] * ps;
        ACT[(size_t)(tok0 + i) * ACTW + 256 + t] = (bf16_t)(pack_bf16(v, 0.f) & 0xffff);
    }
}
DEVINL void convc_tile(const Params& p, int chunk, int l, int tile) {
    const int t = tid();
    const int S = chunk == 0 ? 256 : 4096;
    const bf16_t* Z = (const bf16_t*)(p.ws + OFF_Z);
    bf16_t* ACT = (bf16_t*)(p.ws + OFF_ACT);
#pragma unroll 1
    for (int i = 0; i < 4; ++i) {
        const int item = i * 256 + t, chk = item & 31, tok = tile * 32 + (item >> 5), pos = tok % S;
        const bf16_t* zr = Z + (size_t)tok * INW + chk * 8;
        float uu[3][8];
#pragma unroll
        for (int j = 0; j < 3; ++j) {
            const int pp = pos + j - 1;
            if (pp >= 0 && pp < S) {
                const uint4 a = *(const uint4*)(zr + (j - 1) * INW + Z_SC), b = *(const uint4*)(zr + (j - 1) * INW + Z_SH);
                float av[8], bv[8]; unpack8(a, av); unpack8(b, bv);
#pragma unroll
                for (int e = 0; e < 8; ++e) uu[j][e] = av[e] * bv[e];
            } else {
#pragma unroll
                for (int e = 0; e < 8; ++e) uu[j][e] = 0.f;
            }
        }
        const uint4 sbv = *(const uint4*)(zr + Z_SB);
        float sbf[8], r[8]; unpack8(sbv, sbf);
        const float* wc = p.w_sc + (size_t)l * 768 + chk * 8;
#pragma unroll
        for (int e = 0; e < 8; ++e) r[e] = sbf[e] * (wc[e] * uu[0][e] + wc[256 + e] * uu[1][e] + wc[512 + e] * uu[2][e]);
        *(uint4*)(ACT + (size_t)tok * ACTW + 512 + chk * 8) = pack8(r);
    }
}
DEVINL void phase_branch(const Params& p, int chunk, int l, char* smem) {
    for (int tile = blockIdx.x; tile < 1536; tile += gridDim.x) {
        if (tile < 512) attn_unit(p, chunk, l, tile, smem);
        else if (tile < 1024) conva_tile(p, chunk, l, tile - 512, smem);
        else if (tile < 1280) pool_tile(p, chunk, l, tile - 1024, smem);
        else convc_tile(p, chunk, l, tile - 1280);
        __syncthreads();
    }
}

#define XB_TMO      128
#define XB_XCNT(j)  (256  + 64 * (j))
#define XB_XSUB(j)  (1280 + 64 * (j))
#define XB_XGEN(j)  (2304 + 64 * (j))
#define XB_TOP      3328
#define XB_TOPGEN   3392
#define XB_SPIN_CAP (1u << 20)
DEVINL unsigned xb_ld(unsigned* p) { return __hip_atomic_load(p, __ATOMIC_RELAXED, __HIP_MEMORY_SCOPE_AGENT); }
DEVINL unsigned xb_add(unsigned* p, unsigned v) { return __hip_atomic_fetch_add(p, v, __ATOMIC_RELAXED, __HIP_MEMORY_SCOPE_AGENT); }
DEVINL unsigned xb_xcc_id() { return (unsigned)__builtin_amdgcn_s_getreg((3 << 11) | 20) & 0xFu; }
#define XB_SPIN(cond, bar) do { unsigned _sp = 0; while (cond) { __builtin_amdgcn_s_sleep(1); \
    if ((++_sp & 255u) == 0u) { if (xb_ld(&(bar)[XB_TMO])) break; if (_sp > XB_SPIN_CAP) { atomicAdd(&(bar)[XB_TMO], 1u); break; } } } } while (0)
struct XcdBar { unsigned* bar; unsigned x, nloc, nx; };
DEVINL void xb_census(unsigned* bar, unsigned x, unsigned& nloc, unsigned& nx) {
    const unsigned G = gridDim.x;
    unsigned sum, cnt, mine, sp = 0u;
    for (;;) {
        sum = 0u; cnt = 0u; mine = 0u;
#pragma unroll
        for (unsigned j = 0; j < 16; ++j) { const unsigned c = xb_ld(&bar[XB_XCNT(j)]); sum += c; cnt += (c > 0u) ? 1u : 0u; mine = (j == x) ? c : mine; }
        if (sum == G) break;
        __builtin_amdgcn_s_sleep(1);
        if ((++sp & 255u) == 0u) { if (xb_ld(&bar[XB_TMO])) break; if (sp > XB_SPIN_CAP) { atomicAdd(&bar[XB_TMO], 1u); break; } }
    }
    nloc = mine > 0u ? mine : 1u; nx = cnt > 0u ? cnt : 1u;
}
DEVINL void gsync(XcdBar& b) {
    asm volatile("s_waitcnt vmcnt(0)" ::: "memory");
    __syncthreads();
    if (threadIdx.x == 0) {
        unsigned* bar = b.bar;
        __builtin_amdgcn_s_waitcnt(0);
        if (b.nloc == 0u) xb_census(bar, b.x, b.nloc, b.nx);
        const unsigned nloc = b.nloc, nx = b.nx;
        const unsigned old = xb_add(&bar[XB_XSUB(b.x)], 1u);
        const unsigned gen = old / nloc;
        if (old + 1u == (gen + 1u) * nloc) {
            __builtin_amdgcn_fence(__ATOMIC_RELEASE, "agent");
            asm volatile("s_waitcnt vmcnt(0)" ::: "memory");
            const unsigned og = xb_add(&bar[XB_TOP], 1u);
            const unsigned tg = og / nx;
            if (og + 1u == (tg + 1u) * nx) xb_add(&bar[XB_TOPGEN], 1u);
            else XB_SPIN(xb_ld(&bar[XB_TOPGEN]) == tg, bar);
            __builtin_amdgcn_fence(__ATOMIC_ACQUIRE, "agent");
            xb_add(&bar[XB_XGEN(b.x)], 1u);
            asm volatile("s_waitcnt vmcnt(0)" ::: "memory");
        } else {
            XB_SPIN(xb_ld(&bar[XB_XGEN(b.x)]) == gen, bar);
            __builtin_amdgcn_fence(__ATOMIC_ACQUIRE, "agent");
            asm volatile("s_waitcnt vmcnt(0)" ::: "memory");
        }
    }
    __syncthreads();
}
__global__ void __launch_bounds__(256, 3) mega(Params p) {
    __shared__ __attribute__((aligned(16))) char smem[49152];
    cg::grid_group grid = cg::this_grid();
    grid.sync();
    XcdBar xb; xb.bar = (unsigned*)(p.ws + OFF_BAR); xb.x = xb_xcc_id(); xb.nloc = 0u; xb.nx = 0u;
    if (threadIdx.x == 0) (void)xb_add(&xb.bar[XB_XCNT(xb.x)], 1u);
#pragma unroll 1
    for (int step = 0; step < NSTEPS; ++step) {
        int ph, ch = 0, l = 0;
        if (step == 0) ph = 8;
        else if (step == 1) ph = 9;
        else { const int s = step - 2; ch = s >> 4; const int r = s & 15; l = r >> 3; ph = r & 7; }
        const bf16_t* WT = (const bf16_t*)(p.ws + OFF_WT) + (size_t)l * W_LAYER;
        const bf16_t* H = (const bf16_t*)(p.ws + OFF_H);
        int kind = 0;
        GemmDesc g; g.A = H; g.W = WT; g.lda = LDH; g.ldb = LW1; g.K = D; g.nN = 8; g.epi = 1; g.l = l; g.chunk = ch;
        int rp_mode = 1, rp_which = 1, rp_hsel = 0, rp_lh = l;
        switch (ph) {
            case 8: kind = 3; break;
            case 9: kind = 1; rp_mode = 0; rp_hsel = 1; rp_lh = 0; break;
            case 0: g.W = WT + WO_IN; g.nN = 50; g.epi = 0; break;
            case 1: kind = 2; break;
            case 2: g.A = (const bf16_t*)(p.ws + OFF_ACT); g.lda = ACTW; g.W = WT + WO_A; g.ldb = LWM; g.K = 1280; g.epi = 3; break;
            case 3: g.W = WT + WO_O; break;
            case 4: kind = 1; rp_which = 1; rp_hsel = 2; break;
            case 5: g.W = WT + WO_F1; g.nN = 32; g.epi = 2; break;
            case 6: g.A = (const bf16_t*)(p.ws + OFF_HID); g.lda = LDHID; g.W = WT + WO_F2; g.ldb = LW4; g.K = DFF; break;
            default: kind = 1; rp_which = 2; rp_hsel = (l == 0) ? 1 : 0; rp_lh = 1; break;
        }
        if (kind == 0) phase_gemm_any(p, g, smem);
        else if (kind == 1) {
            const int nrep = (ph == 7 && l == 1 && ch < 2) ? 2 : 1;
#pragma unroll 1
            for (int rep = 0; rep < nrep; ++rep) {
                if (rep == 1) { ch += 1; rp_mode = 0; rp_which = 1; rp_hsel = 1; rp_lh = 0; }
                rowpass(p, ch, rp_mode, l, rp_which, rp_hsel, rp_lh);
            }
        }
        else if (kind == 2) phase_branch(p, ch, l, smem);
        else phase_prep(p, smem);
        gsync(xb);
    }
}

extern "C" void kernel_launch(void* const* d_in, const int* in_sizes, int n_in, void* d_out, int out_size, void* d_ws, size_t ws_size, hipStream_t stream) {
    static int grid_blocks = 0;
    if (!grid_blocks) {
        int dev = 0, cus = 0, per_cu = 0;
        (void)hipGetDevice(&dev);
        (void)hipDeviceGetAttribute(&cus, hipDeviceAttributeMultiprocessorCount, dev);
        (void)hipOccupancyMaxActiveBlocksPerMultiprocessor(&per_cu, mega, 256, 0);
        if (per_cu > 3) per_cu = 3;
        if (per_cu < 1) per_cu = 1;
        grid_blocks = cus * per_cu;
    }
    Params p{};
    const float** pp = (const float**)&p;
    for (int i = 0; i < 28; ++i) pp[i] = (const float*)d_in[i];
    p.out = (float*)d_out;
    p.ws = (char*)d_ws;
    (void)hipMemsetAsync((char*)d_ws + OFF_BAR, 0, 16384, stream);
    void* args[] = {&p};
    hipError_t e = hipLaunchCooperativeKernel((void*)mega, dim3(grid_blocks), dim3(256), args, 0, stream);
    if (e != hipSuccess) fprintf(stderr, "cooperative launch failed: %s (grid %d)\n", hipGetErrorString(e), grid_blocks);
}
```

```cpp
#include <hip/hip_runtime.h>
#include <hip/hip_cooperative_groups.h>
#include <stdint.h>
#include <cstdio>
namespace cg = cooperative_groups;

typedef unsigned short bf16_t;
typedef short bf16x8 __attribute__((ext_vector_type(8)));
typedef short bf16x4 __attribute__((ext_vector_type(4)));
typedef float f32x4 __attribute__((ext_vector_type(4)));
typedef unsigned u32x4 __attribute__((ext_vector_type(4)));
#define DEVINL __device__ __forceinline__

constexpr int D = 1024, INW = 6400, CH = 8192  , ACTW = 1344  , DFF = 4096;
constexpr int LDH = 1088, LDHID = 4160, LW1 = 1088, LWM = 1344, LW4 = 4160;
constexpr int Z_AVAL = 0, Z_AGATE = 256, Z_POOL = 512, Z_SB = 768, Z_SC = 1024, Z_SH = 1280, Z_Q = 1536, Z_K = 2048, Z_V = 2176, Z_G = 2304;
constexpr float EPS = 1e-6f;
#ifndef NSTEPS
#define NSTEPS 50
#endif
constexpr size_t WO_IN = 0, WO_A = WO_IN + (size_t)6400 * LW1, WO_O = WO_A + (size_t)1024 * LWM, WO_F1 = WO_O + (size_t)1024 * LW1, WO_F2 = WO_F1 + (size_t)4096 * LW1,
                 W_LAYER = WO_F2 + (size_t)1024 * LW4;
constexpr size_t OFF_WT = 0, OFF_MOD = OFF_WT + 2 * W_LAYER * 2, OFF_CKV = OFF_MOD + 2 * 5 * 6144 * 4, OFF_TAB = OFF_CKV + 2 * 262144 * 2,
                 OFF_H = OFF_TAB + 8192, OFF_ACT = OFF_H + (size_t)CH * LDH * 2, OFF_Z = OFF_ACT + (size_t)CH * ACTW * 2,
                 OFF_MF = OFF_Z, OFF_HID = OFF_Z + (size_t)CH * D * 4, OFF_BAR = OFF_Z + (size_t)CH * INW * 2;
constexpr size_t OUT_K = 25165824, OUT_V = 27262976;

struct Params {
    const float *x_prompt, *x_sample, *cache_k, *cache_v, *c, *c_ctx, *w_ada, *b_ada, *g_pre_mix, *g_post_mix, *g_pre_ffn, *g_post_ffn, *w_in,
        *w_conv_a, *b_conv_a, *ln_g_a, *ln_b_a, *w_a_out, *w_pool, *pool_scale, *w_b_out, *w_sc, *w_c_out, *sink, *w_d_out, *w_o, *w_ff1, *w_ff2;
    float* out;
    char* ws;
};

DEVINL int tid() { int t = threadIdx.x; asm volatile("" : "+v"(t)); return t; }
DEVINL float bf_lo(uint32_t u) { return __uint_as_float(u << 16); }
DEVINL float bf_hi(uint32_t u) { return __uint_as_float(u & 0xffff0000u); }
typedef __bf16 bf16x2_t __attribute__((ext_vector_type(2)));
typedef float f32x2_t __attribute__((ext_vector_type(2)));
DEVINL uint32_t pack_bf16(float lo, float hi) { const f32x2_t v = {lo, hi}; const bf16x2_t b = __builtin_convertvector(v, bf16x2_t); return __builtin_bit_cast(uint32_t, b); }
DEVINL void unpack8(const uint4& u, float (&f)[8]) {
    f[0] = bf_lo(u.x); f[1] = bf_hi(u.x); f[2] = bf_lo(u.y); f[3] = bf_hi(u.y); f[4] = bf_lo(u.z); f[5] = bf_hi(u.z); f[6] = bf_lo(u.w); f[7] = bf_hi(u.w);
}
DEVINL uint4 pack8(const float (&f)[8]) { uint4 u; u.x = pack_bf16(f[0], f[1]); u.y = pack_bf16(f[2], f[3]); u.z = pack_bf16(f[4], f[5]); u.w = pack_bf16(f[6], f[7]); return u; }
DEVINL float sigmoidf_(float x) { return 1.f / (1.f + __expf(-x)); }
DEVINL float wave_sum(float v) {
#pragma unroll
    for (int o = 32; o > 0; o >>= 1) v += __shfl_xor(v, o);
    return v;
}
DEVINL bf16x8 as_bf16x8(const uint4& u) { union { uint4 a; bf16x8 b; } x; x.a = u; return x.b; }

#define SCHED_FENCE() __builtin_amdgcn_sched_barrier(0)
template <bool FKK>
DEVINL void gemm_compute(const char* cur, int aoff, int boff, int fq, int sw, f32x4 (&acc)[4][4]) {
#pragma unroll
    for (int kk = 0; kk < 2; ++kk) {
        if (FKK) SCHED_FENCE();
        bf16x8 af[4], bfr[4];
        const int co = ((kk * 4 + fq) ^ sw) << 4;
#pragma unroll
        for (int i = 0; i < 4; ++i) { af[i] = *(const bf16x8*)(cur + aoff + i * 2048 + co); bfr[i] = *(const bf16x8*)(cur + boff + i * 2048 + co); }
        __builtin_amdgcn_s_setprio(1);
#pragma unroll
        for (int mi = 0; mi < 4; ++mi)
#pragma unroll
            for (int ni = 0; ni < 4; ++ni) acc[mi][ni] = __builtin_amdgcn_mfma_f32_16x16x32_bf16(bfr[ni], af[mi], acc[mi][ni], 0, 0, 0);
        __builtin_amdgcn_s_setprio(0);
    }
}
struct NoHook { DEVINL void operator()(int, f32x4 (&)[4][4]) const {} };
template <int DEPTH, class Hook = NoHook>
DEVINL void gemm_loop(const bf16_t* __restrict__ A, int lda, const bf16_t* __restrict__ B, int ldb, int K, char* smem, f32x4 (&acc)[4][4], const Hook& hook = Hook()) {
    const int t = tid(), lane = t & 63, w = t >> 6, wm = w >> 1, wn = w & 1, fr = lane & 15, fq = lane >> 4;
    const int sc = t & 7, sr = t >> 3;
    const bf16_t* ag = A + (size_t)sr * lda + sc * 8;
    const bf16_t* bg = B + (size_t)sr * ldb + sc * 8;
    const int soff = sr * 128 + ((sc ^ ((sr >> 1) & 7)) << 4);
    const int aoff = (wm * 64 + fr) * 128, boff = 16384 + (wn * 64 + fr) * 128, sw = (fr >> 1) & 7;
    const int nk = K >> 6;
    u32x4 r0a[4], r0b[4], r1a[4], r1b[4];
#define G_LOAD(RA, RB, KT) { _Pragma("unroll") for (int i = 0; i < 4; ++i) { RA[i] = *(const u32x4*)(ag + (size_t)i * 32 * lda + (KT) * 64); RB[i] = *(const u32x4*)(bg + (size_t)i * 32 * ldb + (KT) * 64); } }
#define G_STORE(RA, RB, BUF) { _Pragma("unroll") for (int i = 0; i < 4; ++i) { *(u32x4*)(smem + (BUF) * 32768 + soff + i * 4096) = RA[i]; *(u32x4*)(smem + (BUF) * 32768 + 16384 + soff + i * 4096) = RB[i]; } }
    G_LOAD(r0a, r0b, 0);
    G_LOAD(r1a, r1b, 1);
    SCHED_FENCE();
    __syncthreads();
    G_STORE(r0a, r0b, 0);
    __syncthreads();
    for (int kt = 0; kt < nk; kt += 2) {
        G_LOAD(r0a, r0b, min(kt + 2, nk - 1));
        SCHED_FENCE();
        gemm_compute<false>(smem, aoff, boff, fq, sw, acc);
        SCHED_FENCE();
        G_STORE(r1a, r1b, 1);
        __syncthreads();
        G_LOAD(r1a, r1b, min(kt + 3, nk - 1));
        SCHED_FENCE();
        gemm_compute<false>(smem + 32768, aoff, boff, fq, sw, acc);
        SCHED_FENCE();
        hook(kt + 1, acc);
        G_STORE(r0a, r0b, 0);
        __syncthreads();
    }
#undef G_LOAD
#undef G_STORE
}
#define LAS3 __attribute__((address_space(3)))
template <class Hook = NoHook>
DEVINL void gemm_loop_dma(const bf16_t* __restrict__ A, int lda, const bf16_t* __restrict__ B, int ldb, int K, char* smem, f32x4 (&acc)[4][4], const Hook& hook = Hook()) {
    const int t = tid(), lane = t & 63, w = t >> 6, wm = w >> 1, wn = w & 1, fr = lane & 15, fq = lane >> 4;
    const int sc = t & 7, sr = t >> 3;
    const bf16_t* ag = A + (size_t)sr * lda + ((sc ^ ((sr >> 1) & 7)) << 3);
    const int srp = 8 * ((sr & 15) >> 2) + 4 * (sr >> 4) + (sr & 3);
    const bf16_t* bg = B + (size_t)srp * ldb + ((sc ^ ((sr >> 1) & 7)) << 3);
    const int aoff = (wm * 64 + fr) * 128, boff = 16384 + (wn * 64 + fr) * 128, sw = (fr >> 1) & 7;
    const int nk = K >> 6;
    LAS3 char* lds = (LAS3 char*)smem;
    const int pw = w * 1024;
#define D_ISSUE(BUF, KT) { _Pragma("unroll") for (int i = 0; i < 4; ++i) { \
        __builtin_amdgcn_global_load_lds((const unsigned*)(ag + (size_t)i * 32 * lda + (KT) * 64), (LAS3 unsigned*)(lds + (BUF) * 32768 + i * 4096 + pw), 16, 0, 0); \
        __builtin_amdgcn_global_load_lds((const unsigned*)(bg + (size_t)i * 32 * ldb + (KT) * 64), (LAS3 unsigned*)(lds + (BUF) * 32768 + 16384 + i * 4096 + pw), 16, 0, 0); } }
#define D_WAIT() { asm volatile("s_waitcnt vmcnt(0)" ::: "memory"); __builtin_amdgcn_s_barrier(); asm volatile("" ::: "memory"); }
    D_ISSUE(0, 0);
    D_WAIT();
    for (int kt = 0; kt < nk; kt += 2) {
        D_ISSUE(1, kt + 1);
        SCHED_FENCE();
        gemm_compute<false>(smem, aoff, boff, fq, sw, acc);
        SCHED_FENCE();
        D_WAIT();
        if (kt + 2 < nk) D_ISSUE(0, kt + 2);
        SCHED_FENCE();
        gemm_compute<false>(smem + 32768, aoff, boff, fq, sw, acc);
        SCHED_FENCE();
        hook(kt + 1, acc);
        D_WAIT();
    }
#undef D_ISSUE
#undef D_WAIT
}
DEVINL void gemm_loop1(const bf16_t* __restrict__ A, int lda, const bf16_t* __restrict__ B, int ldb, int K, char* smem, f32x4 (&acc)[4][4]) {
    const int t = tid(), lane = t & 63, w = t >> 6, wm = w >> 1, wn = w & 1, fr = lane & 15, fq = lane >> 4;
    const int sc = t & 7, sr = t >> 3;
    const bf16_t* ag = A + (size_t)sr * lda + sc * 8;
    const bf16_t* bg = B + (size_t)sr * ldb + sc * 8;
    const int soff = sr * 128 + ((sc ^ ((sr >> 1) & 7)) << 4);
    u32x4 ra[4], rb[4];
    const int nk = K >> 6;
#pragma unroll
    for (int i = 0; i < 4; ++i) { ra[i] = *(const u32x4*)(ag + (size_t)i * 32 * lda); rb[i] = *(const u32x4*)(bg + (size_t)i * 32 * ldb); }
    __syncthreads();
#pragma unroll
    for (int i = 0; i < 4; ++i) { *(u32x4*)(smem + soff + i * 4096) = ra[i]; *(u32x4*)(smem + 16384 + soff + i * 4096) = rb[i]; }
    __syncthreads();
    const int aoff = (wm * 64 + fr) * 128, boff = 16384 + (wn * 64 + fr) * 128, sw = (fr >> 1) & 7;
    for (int kt = 0; kt < nk; ++kt) {
        const char* cur = smem + (kt & 1) * 32768;
        if (kt + 1 < nk) {
#pragma unroll
            for (int i = 0; i < 4; ++i) { ra[i] = *(const u32x4*)(ag + (size_t)i * 32 * lda + (kt + 1) * 64); rb[i] = *(const u32x4*)(bg + (size_t)i * 32 * ldb + (kt + 1) * 64); }
        }
        gemm_compute<false>(cur, aoff, boff, fq, sw, acc);
        if (kt + 1 < nk) {
            char* nxt = smem + ((kt + 1) & 1) * 32768;
#pragma unroll
            for (int i = 0; i < 4; ++i) { *(u32x4*)(nxt + soff + i * 4096) = ra[i]; *(u32x4*)(nxt + 16384 + soff + i * 4096) = rb[i]; }
        }
        __syncthreads();
    }
}
DEVINL void zero_acc(f32x4 (&acc)[4][4]) {
#pragma unroll
    for (int i = 0; i < 4; ++i)
#pragma unroll
        for (int j = 0; j < 4; ++j) acc[i][j] = (f32x4){0.f, 0.f, 0.f, 0.f};
}
DEVINL void tile_order(int t, int nN, int& pm, int& pn) { const int g = t / (8 * nN), r = t % (8 * nN); pn = r >> 3; pm = g * 8 + (r & 7); }
struct TileWalk {
    int nN, i, x, j, nb; bool xcd;
    DEVINL void init(int nN_) { nN = nN_; i = 0; xcd = (gridDim.x & 7) == 0; x = blockIdx.x & 7; j = blockIdx.x >> 3; nb = gridDim.x >> 3; }
    DEVINL bool next(int& pm, int& pn) {
        if (xcd) { const int s = i * nb + j; ++i; if (s >= 8 * nN) return false; pn = s >> 3; pm = x * 8 + (s & 7); return true; }
        const int t = blockIdx.x + i * gridDim.x; ++i; if (t >= 64 * nN) return false; tile_order(t, nN, pm, pn); return true;
    }
};

DEVINL void wt_tile2(const float* __restrict__ src, int K, int N, bf16_t* __restrict__ dst, int ldd, int tile0, char* smem) {
    const int nNt = N >> 6, t = tid();
    float* tl = (float*)smem;
    const int r = t >> 4, c4 = t & 15;
    f32x4 v[2][4];
#pragma unroll
    for (int u = 0; u < 2; ++u) {
        const int tile = tile0 + u, k0 = (tile / nNt) * 64, n0 = (tile % nNt) * 64;
#pragma unroll
        for (int i = 0; i < 4; ++i) v[u][i] = *(const f32x4*)(src + (size_t)(k0 + r + 16 * i) * N + n0 + c4 * 4);
    }
    asm volatile("" : "+v"(v[0][0]), "+v"(v[0][1]), "+v"(v[0][2]), "+v"(v[0][3]), "+v"(v[1][0]), "+v"(v[1][1]), "+v"(v[1][2]), "+v"(v[1][3]));
#pragma unroll
    for (int u = 0; u < 2; ++u)
#pragma unroll
        for (int i = 0; i < 4; ++i) { float* q = tl + u * 4160 + (r + 16 * i) * 65 + c4 * 4; q[0] = v[u][i][0]; q[1] = v[u][i][1]; q[2] = v[u][i][2]; q[3] = v[u][i][3]; }
    __syncthreads();
    const int n = t >> 2, kq = t & 3;
#pragma unroll
    for (int u = 0; u < 2; ++u) {
        const int tile = tile0 + u, k0 = (tile / nNt) * 64, n0 = (tile % nNt) * 64;
        uint32_t pk[8];
#pragma unroll
        for (int e = 0; e < 8; ++e) pk[e] = pack_bf16(tl[u * 4160 + (kq * 16 + 2 * e) * 65 + n], tl[u * 4160 + (kq * 16 + 2 * e + 1) * 65 + n]);
        uint4* o = (uint4*)(dst + (size_t)(n0 + n) * ldd + k0 + kq * 16);
        o[0] = make_uint4(pk[0], pk[1], pk[2], pk[3]); o[1] = make_uint4(pk[4], pk[5], pk[6], pk[7]);
    }
    __syncthreads();
}
DEVINL void mod_tile(const Params& p, int tile, char* smem) {
    const int l = tile / 96, n0 = (tile % 96) * 64, t = tid(), kg = t >> 6, col = t & 63;
    float* sl = (float*)smem;
    float* red = sl + 5 * 1024;
    for (int i = t; i < 5 * 1024; i += 256) { const int cb = i >> 10, k = i & 1023; const float x = cb == 0 ? p.c_ctx[k] : p.c[(cb - 1) * 1024 + k]; sl[i] = x * sigmoidf_(x); }
    __syncthreads();
    float a0 = 0.f, a1 = 0.f, a2 = 0.f, a3 = 0.f, a4 = 0.f;
    const float* wp = p.w_ada + ((size_t)l * 1024 + kg * 256) * 6144 + n0 + col;
#pragma unroll 1
    for (int k0 = 0; k0 < 256; k0 += 32) {
        float wv[32];
#pragma unroll
        for (int k = 0; k < 32; ++k) wv[k] = wp[(size_t)(k0 + k) * 6144];
        SCHED_FENCE();
#pragma unroll
        for (int k = 0; k < 32; ++k) {
            const int kk = kg * 256 + k0 + k;
            a0 += sl[kk] * wv[k]; a1 += sl[1024 + kk] * wv[k]; a2 += sl[2048 + kk] * wv[k]; a3 += sl[3072 + kk] * wv[k]; a4 += sl[4096 + kk] * wv[k];
        }
    }
    red[(kg * 5 + 0) * 64 + col] = a0; red[(kg * 5 + 1) * 64 + col] = a1; red[(kg * 5 + 2) * 64 + col] = a2; red[(kg * 5 + 3) * 64 + col] = a3; red[(kg * 5 + 4) * 64 + col] = a4;
    __syncthreads();
    float* mod = (float*)(p.ws + OFF_MOD);
    for (int i = t; i < 320; i += 256) {
        const int cb = i >> 6, cc = i & 63;
        const float s = red[(0 * 5 + cb) * 64 + cc] + red[(1 * 5 + cb) * 64 + cc] + red[(2 * 5 + cb) * 64 + cc] + red[(3 * 5 + cb) * 64 + cc];
        mod[((size_t)l * 5 + cb) * 6144 + n0 + cc] = s + p.b_ada[l * 6144 + n0 + cc];
    }
    __syncthreads();
}
DEVINL void phase_prep(const Params& p, char* smem) {
    const int t = tid();
    bf16_t* WT = (bf16_t*)(p.ws + OFF_WT);
    constexpr int NMOD = 192, NW = 4224  , NC = 256, NT = NMOD + NW + NC + 1;
    for (int tile = blockIdx.x; tile < NT; tile += gridDim.x) {
        if (tile < NMOD) mod_tile(p, tile, smem);
        else if (tile < NMOD + NW) {
            int wt = (tile - NMOD) * 2; const int l = wt / 4224; wt -= l * 4224;
            const float* src; int K, N, ldd; size_t dofs;
            if (wt < 1600) { src = p.w_in + (size_t)l * 1024 * 6400; K = 1024; N = 6400; ldd = LW1; dofs = WO_IN; }
            else if (wt < 1664) { wt -= 1600; src = p.w_a_out + (size_t)l * 256 * 1024; K = 256; N = 1024; ldd = LWM; dofs = WO_A; }
            else if (wt < 1728) { wt -= 1664; src = p.w_b_out + (size_t)l * 256 * 1024; K = 256; N = 1024; ldd = LWM; dofs = WO_A + 256; }
            else if (wt < 1792) { wt -= 1728; src = p.w_c_out + (size_t)l * 256 * 1024; K = 256; N = 1024; ldd = LWM; dofs = WO_A + 512; }
            else if (wt < 1920) { wt -= 1792; src = p.w_d_out + (size_t)l * 512 * 1024; K = 512; N = 1024; ldd = LWM; dofs = WO_A + 768; }
            else if (wt < 2176) { wt -= 1920; src = p.w_o + (size_t)l * 1024 * 1024; K = 1024; N = 1024; ldd = LW1; dofs = WO_O; }
            else if (wt < 3200) { wt -= 2176; src = p.w_ff1 + (size_t)l * 1024 * 4096; K = 1024; N = 4096; ldd = LW1; dofs = WO_F1; }
            else { wt -= 3200; src = p.w_ff2 + (size_t)l * 4096 * 1024; K = 4096; N = 1024; ldd = LW4; dofs = WO_F2; }
            wt_tile2(src, K, N, WT + (size_t)l * W_LAYER + dofs, ldd, wt, smem);
        } else if (tile < NMOD + NW + NC) {
            const int i = (tile - NMOD - NW) * 256 + t;
            const float* src = (i < 32768) ? p.cache_k + (size_t)i * 8 : p.cache_v + (size_t)(i - 32768) * 8;
            const float4 a = *(const float4*)src, b = *(const float4*)(src + 4);
            uint4 o; o.x = pack_bf16(a.x, a.y); o.y = pack_bf16(a.z, a.w); o.z = pack_bf16(b.x, b.y); o.w = pack_bf16(b.z, b.w);
            *(uint4*)(p.ws + OFF_CKV + (size_t)i * 16) = o;
        } else {
            float2* tab = (float2*)(p.ws + OFF_TAB);
            for (int i = t; i < 1024; i += 256) {
                const int pos = i >> 4, fi = i & 15;
                const float freq = exp2f(-(float)fi * (13.287712379549449f / 16.f));
                const float ang = (float)pos * freq;
                tab[i] = make_float2(__cosf(ang), __sinf(ang));
            }
        }
    }
}

DEVINL void rowpass(const Params& p, int chunk, int mode, int lpost, int which_post, int hsel, int lh) {
    const int lane = tid() & 63, w = tid() >> 6;
    const float* mod = (const float*)(p.ws + OFF_MOD);
    const bf16_t* MF = (const bf16_t*)(p.ws + OFF_MF);
    bf16_t* H = (bf16_t*)(p.ws + OFF_H);
    const float* xin = chunk == 0 ? p.x_prompt : p.x_sample + (size_t)(chunk - 1) * CH * D;
    float* xres = p.out + (size_t)chunk * CH * D;
    const float* xsrc = mode == 0 ? xin : xres;
    const float* gpost = which_post == 1 ? p.g_post_mix + lpost * D : p.g_post_ffn + lpost * D;
    const float* gpre = hsel == 1 ? p.g_pre_mix + lh * D : p.g_pre_ffn + lh * D;
    for (int base = (blockIdx.x * 4 + w) * 4; base < CH; base += gridDim.x * 16) {
        const int cb = chunk == 0 ? 0 : 1 + (chunk - 1) * 2 + (base >> 12);
        float pg[16], hg[16], hs[16];
        if (mode == 1) {
            const float* gate = mod + ((size_t)lpost * 5 + cb) * 6144 + (which_post == 1 ? 2 : 5) * 1024;
            float4 gp[4], gt[4];
#pragma unroll
            for (int i = 0; i < 4; ++i) { const int c = i * 256 + lane * 4; gp[i] = *(const float4*)(gpost + c); gt[i] = *(const float4*)(gate + c); }
            SCHED_FENCE();
#pragma unroll
            for (int i = 0; i < 4; ++i) { pg[4 * i] = gp[i].x * gt[i].x; pg[4 * i + 1] = gp[i].y * gt[i].y; pg[4 * i + 2] = gp[i].z * gt[i].z; pg[4 * i + 3] = gp[i].w * gt[i].w; }
        }
        if (hsel) {
            const float* mb = mod + ((size_t)lh * 5 + cb) * 6144 + (hsel == 1 ? 0 : 3) * 1024;
            float4 g[4], sh[4], sc[4];
#pragma unroll
            for (int i = 0; i < 4; ++i) { const int c = i * 256 + lane * 4; g[i] = *(const float4*)(gpre + c); sh[i] = *(const float4*)(mb + c); sc[i] = *(const float4*)(mb + 1024 + c); }
            SCHED_FENCE();
#pragma unroll
            for (int i = 0; i < 4; ++i) {
                hg[4 * i] = g[i].x * (1.f + sc[i].x); hg[4 * i + 1] = g[i].y * (1.f + sc[i].y); hg[4 * i + 2] = g[i].z * (1.f + sc[i].z); hg[4 * i + 3] = g[i].w * (1.f + sc[i].w);
                hs[4 * i] = sh[i].x; hs[4 * i + 1] = sh[i].y; hs[4 * i + 2] = sh[i].z; hs[4 * i + 3] = sh[i].w;
            }
        }
#pragma unroll 1
        for (int pr = 0; pr < 2; ++pr) {
            const int row0 = base + pr * 2;
            float x[2][16], m[2][16];
#pragma unroll
            for (int r = 0; r < 2; ++r)
#pragma unroll
                for (int i = 0; i < 4; ++i) {
                    const size_t o = (size_t)(row0 + r) * D + i * 256 + lane * 4;
                    const float4 v = *(const float4*)(xsrc + o);
                    x[r][4 * i] = v.x; x[r][4 * i + 1] = v.y; x[r][4 * i + 2] = v.z; x[r][4 * i + 3] = v.w;
                    if (mode == 1) { const uint2 q = *(const uint2*)(MF + o); m[r][4 * i] = bf_lo(q.x); m[r][4 * i + 1] = bf_hi(q.x); m[r][4 * i + 2] = bf_lo(q.y); m[r][4 * i + 3] = bf_hi(q.y); }
                }
            SCHED_FENCE();
#pragma unroll
            for (int r = 0; r < 2; ++r) {
                if (mode == 1) {
                    float ss = 0.f;
#pragma unroll
                    for (int i = 0; i < 16; ++i) ss += m[r][i] * m[r][i];
                    ss = wave_sum(ss);
                    const float rs = rsqrtf(ss * (1.f / D) + EPS);
#pragma unroll
                    for (int i = 0; i < 16; ++i) x[r][i] += (m[r][i] * rs) * pg[i];
                }
#pragma unroll
                for (int i = 0; i < 4; ++i) *(float4*)(xres + (size_t)(row0 + r) * D + i * 256 + lane * 4) = make_float4(x[r][4 * i], x[r][4 * i + 1], x[r][4 * i + 2], x[r][4 * i + 3]);
                if (hsel) {
                    float ss = 0.f;
#pragma unroll
                    for (int i = 0; i < 16; ++i) ss += x[r][i] * x[r][i];
                    ss = wave_sum(ss);
                    const float rs = rsqrtf(ss * (1.f / D) + EPS);
#pragma unroll
                    for (int i = 0; i < 4; ++i) {
                        const float h0 = x[r][4 * i] * rs * hg[4 * i] + hs[4 * i], h1 = x[r][4 * i + 1] * rs * hg[4 * i + 1] + hs[4 * i + 1];
                        const float h2 = x[r][4 * i + 2] * rs * hg[4 * i + 2] + hs[4 * i + 2], h3 = x[r][4 * i + 3] * rs * hg[4 * i + 3] + hs[4 * i + 3];
                        *(uint2*)(H + (size_t)(row0 + r) * LDH + i * 256 + lane * 4) = make_uint2(pack_bf16(h0, h1), pack_bf16(h2, h3));
                    }
                }
            }
        }
    }
}

DEVINL void unpack8u(const uint4& u, float (&f)[8]) { unpack8(u, f); }
struct MergeHook {
    const bf16_t* zg;
    bool on;
    DEVINL void operator()(int k, f32x4 (&acc)[4][4]) const {
        if (!on || (k & 3) != 3 || k > 11) return;
        const int b = k >> 2;
        const bf16_t* z = zg + b * 1024;
        uint4 ga[4][2], gb[4][2];
#pragma unroll
        for (int mi = 0; mi < 4; ++mi)
#pragma unroll
            for (int q = 0; q < 2; ++q) { ga[mi][q] = *(const uint4*)(z + (size_t)mi * 16 * INW + q * 32); gb[mi][q] = *(const uint4*)(z + 1024 + (size_t)mi * 16 * INW + q * 32); }
        SCHED_FENCE();
#pragma unroll
        for (int mi = 0; mi < 4; ++mi)
#pragma unroll
            for (int q = 0; q < 2; ++q) {
                float a[8], bb[8]; unpack8(ga[mi][q], a); unpack8(gb[mi][q], bb);
#pragma unroll
                for (int e = 0; e < 8; ++e) acc[mi][2 * q + (e >> 2)][e & 3] *= (1.f + __expf(-bb[e])) * __builtin_amdgcn_rcpf(1.f + __expf(-a[e]));
            }
    }
};
struct GemmDesc { const bf16_t* A; const bf16_t* W; int lda, ldb, K, nN, epi, l, chunk; };
DEVINL void phase_gemm_any(const Params& p, const GemmDesc& g, char* smem) {
    const int lane = tid() & 63, w = tid() >> 6, wm = w >> 1, wn = w & 1, fr = lane & 15, fq = lane >> 4;
    bf16_t* Z = (bf16_t*)(p.ws + OFF_Z);
    bf16_t* MF = (bf16_t*)(p.ws + OFF_MF);
    bf16_t* HID = (bf16_t*)(p.ws + OFF_HID);
    bf16_t* MG = (bf16_t*)(p.ws + OFF_H);
    TileWalk tw; tw.init(g.nN);
    for (int pm, pn; tw.next(pm, pn);) {
        f32x4 acc[4][4]; zero_acc(acc);
        const int row0 = pm * 128 + wm * 64 + fr, col0 = pn * 128 + wn * 64 + fq * 8;
        MergeHook hook; hook.on = (g.epi == 3); hook.zg = Z + (size_t)row0 * INW + Z_G + col0;
        gemm_loop_dma(g.A + (size_t)pm * 128 * g.lda, g.lda, g.W + (size_t)pn * 128 * g.ldb, g.ldb, g.K, smem, acc, hook);
        if (g.epi == 0) {
            const bool kv = (g.chunk == 0) && (pn == 16 || pn == 17);
            bf16_t* zo = Z + (size_t)row0 * INW + col0;
            asm volatile("" : "+v"(zo));
#pragma unroll
            for (int mi = 0; mi < 4; ++mi)
#pragma unroll
                for (int q = 0; q < 2; ++q) {
                    const f32x4 v0 = acc[mi][2 * q], v1 = acc[mi][2 * q + 1];
                    *(uint4*)(zo + (size_t)mi * 16 * INW + q * 32) = make_uint4(pack_bf16(v0[0], v0[1]), pack_bf16(v0[2], v0[3]), pack_bf16(v1[0], v1[1]), pack_bf16(v1[2], v1[3]));
                    if (kv) {
                        const int row = row0 + mi * 16, cl = wn * 64 + q * 32 + fq * 8;
                        float* dst = p.out + (pn == 16 ? OUT_K : OUT_V) + ((size_t)((row >> 8) * 2 + g.l) * 256 + (row & 255)) * 128 + cl;
                        *(f32x4*)dst = v0; *(f32x4*)(dst + 4) = v1;
                    }
                }
        } else if (g.epi == 1) {
            bf16_t* mo = MF + (size_t)row0 * D + col0;
            asm volatile("" : "+v"(mo));
#pragma unroll
            for (int mi = 0; mi < 4; ++mi)
#pragma unroll
                for (int q = 0; q < 2; ++q) {
                    const f32x4 v0 = acc[mi][2 * q], v1 = acc[mi][2 * q + 1];
                    *(uint4*)(mo + (size_t)mi * 16 * D + q * 32) = make_uint4(pack_bf16(v0[0], v0[1]), pack_bf16(v0[2], v0[3]), pack_bf16(v1[0], v1[1]), pack_bf16(v1[2], v1[3]));
                }
        } else if (g.epi == 2) {
            bf16_t* ho = HID + (size_t)row0 * LDHID + col0;
            asm volatile("" : "+v"(ho));
#pragma unroll
            for (int mi = 0; mi < 4; ++mi)
#pragma unroll
                for (int q = 0; q < 2; ++q) {
                    float r[8];
#pragma unroll
                    for (int e = 0; e < 8; ++e) { const float x = fmaxf(acc[mi][2 * q + (e >> 2)][e & 3], 0.f); r[e] = x * x; }
                    *(uint4*)(ho + (size_t)mi * 16 * LDHID + q * 32) = pack8(r);
                }
        } else {
            const bf16_t* z3 = hook.zg + 3 * 1024;
            bf16_t* mg = MG + (size_t)row0 * LDH + col0;
            uint4 g3[4][2];
#pragma unroll
            for (int mi = 0; mi < 4; ++mi)
#pragma unroll
                for (int q = 0; q < 2; ++q) g3[mi][q] = *(const uint4*)(z3 + (size_t)mi * 16 * INW + q * 32);
            SCHED_FENCE();
#pragma unroll
            for (int mi = 0; mi < 4; ++mi)
#pragma unroll
                for (int q = 0; q < 2; ++q) {
                    float gg[8], r[8]; unpack8(g3[mi][q], gg);
#pragma unroll
                    for (int e = 0; e < 8; ++e) r[e] = acc[mi][2 * q + (e >> 2)][e & 3] * sigmoidf_(gg[e]);
                    *(uint4*)(mg + (size_t)mi * 16 * LDH + q * 32) = pack8(r);
                }
        }
    }
}

struct AttTile { const bf16_t* kptr; const bf16_t* vptr; int stride, kstart; bool rope, maskf; };
DEVINL bool att_tile(int it, bool is_ctx, const bf16_t* Zs, const bf16_t* CKb, int q0, int kvh, AttTile& d) {
    d.rope = false; d.maskf = false;
    if (is_ctx) { d.kstart = it * 64; d.kptr = Zs + (size_t)d.kstart * INW + Z_K + kvh * 64; d.vptr = d.kptr + 128; d.stride = INW; return true; }
    if (it < 5) {
        d.kstart = (q0 & ~63) - 128 + it * 64; d.stride = INW; d.rope = true; d.maskf = true;
        if (d.kstart < 0 || d.kstart >= 4096) return false;
        d.kptr = Zs + (size_t)d.kstart * INW + Z_K + kvh * 64; d.vptr = d.kptr + 128; return true;
    }
    d.kstart = (it - 5) * 64; d.kptr = CKb + (size_t)d.kstart * 128 + kvh * 64; d.vptr = d.kptr + 262144; d.stride = 128; return true;
}
DEVINL void attn_unit(const Params& p, int chunk, int layer, int unit, char* smem) {
    const int t = tid(), lane = t & 63, w = t >> 6, fr = lane & 15, fq = lane >> 4;
    const bool is_ctx = (chunk == 0);
    int seq_base, q0, kvh, bseq = 0;
    if (is_ctx) { seq_base = (unit >> 4) * 256; q0 = ((unit >> 1) & 7) * 32; kvh = unit & 1; }
    else { const int sl = unit >> 8; seq_base = sl * 4096; q0 = ((unit >> 1) & 127) * 32; kvh = unit & 1; bseq = (chunk - 1) * 2 + sl; }
    const int head = kvh * 4 + w;
    const bf16_t* Zs = (const bf16_t*)(p.ws + OFF_Z) + (size_t)seq_base * INW;
    const bf16_t* CKb = (const bf16_t*)(p.ws + OFF_CKV) + (size_t)(bseq * 2 + layer) * 256 * 128;
    const float2* tab = (const float2*)(p.ws + OFF_TAB);
    bf16_t* ACT = (bf16_t*)(p.ws + OFF_ACT);
    char* Ks = smem;
    bf16_t* Vt = (bf16_t*)(smem + 8192);
    constexpr int VS = 68;

    bf16x8 qf[2][2];
#pragma unroll
    for (int qg = 0; qg < 2; ++qg)
#pragma unroll
        for (int dh = 0; dh < 2; ++dh) {
            const int pos = q0 + qg * 16 + fr;
            uint4 u = *(const uint4*)(Zs + (size_t)pos * INW + Z_Q + head * 64 + dh * 32 + fq * 8);
            if (!is_ctx) {
                uint4 pu; pu.x = __shfl_xor((int)u.x, 32); pu.y = __shfl_xor((int)u.y, 32); pu.z = __shfl_xor((int)u.z, 32); pu.w = __shfl_xor((int)u.w, 32);
                float x[8], y[8]; unpack8(u, x); unpack8(pu, y);
                const int pi = dh == 0 ? (pos >> 6) : (pos & 63);
                const float2* tp = tab + pi * 16 + (fq & 1) * 8;
                const float sgn = fq < 2 ? -1.f : 1.f;
#pragma unroll
                for (int e = 0; e < 8; ++e) { const float2 cs = tp[e]; x[e] = x[e] * cs.x + sgn * y[e] * cs.y; }
                u = pack8(x);
            }
            qf[qg][dh] = as_bf16x8(u);
        }
    f32x4 o[2][4];
#pragma unroll
    for (int i = 0; i < 2; ++i)
#pragma unroll
        for (int j = 0; j < 4; ++j) o[i][j] = (f32x4){0.f, 0.f, 0.f, 0.f};
    const float sk2 = p.sink[layer * 8 + head] * 1.4426950408889634f;
    float mrow[2], lsum[2];
#pragma unroll
    for (int i = 0; i < 2; ++i) { mrow[i] = sk2; lsum[i] = fq == 0 ? 1.f : 0.f; }
    const float sc2 = 0.125f * 1.4426950408889634f;

    const int ntiles = is_ctx ? 4 : 9;
    const int key = t >> 2, cp = t & 3, c = (cp & 1) + ((cp >> 1) << 2);
    const int vkey = t & 63, vch = t >> 6;
    AttTile cur; int it = 0;
    while (!att_tile(it, is_ctx, Zs, CKb, q0, kvh, cur)) ++it;
    u32x4 ku1, ku2, vu0, vu1; float2 cs[8];
#define ATT_LOAD(d) { const bf16_t* src = (d).kptr + (size_t)key * (d).stride + c * 8; ku1 = *(const u32x4*)src; ku2 = *(const u32x4*)(src + 16); \
        const bf16_t* vs = (d).vptr + (size_t)vkey * (d).stride + vch * 8; vu0 = *(const u32x4*)vs; vu1 = *(const u32x4*)(vs + 32); \
        if ((d).rope) { const int kpos = (d).kstart + key, pi = c < 4 ? (kpos >> 6) : (kpos & 63); const float2* tp = tab + pi * 16 + (c & 1) * 8; \
            _Pragma("unroll") for (int e = 0; e < 8; ++e) cs[e] = tp[e]; } }
    ATT_LOAD(cur);
    for (;;) {
        __syncthreads();
        {
            uint4 u1 = make_uint4(ku1[0], ku1[1], ku1[2], ku1[3]), u2 = make_uint4(ku2[0], ku2[1], ku2[2], ku2[3]);
            if (cur.rope) {
                float x1[8], x2[8], o1[8], o2[8]; unpack8(u1, x1); unpack8(u2, x2);
#pragma unroll
                for (int e = 0; e < 8; ++e) { o1[e] = x1[e] * cs[e].x - x2[e] * cs[e].y; o2[e] = x2[e] * cs[e].x + x1[e] * cs[e].y; }
                u1 = pack8(o1); u2 = pack8(o2);
            }
            *(uint4*)(Ks + key * 128 + ((c ^ (key & 7)) << 4)) = u1;
            *(uint4*)(Ks + key * 128 + (((c + 2) ^ (key & 7)) << 4)) = u2;
#pragma unroll
            for (int i = 0; i < 2; ++i) {
                const u32x4 u = i == 0 ? vu0 : vu1;
                bf16_t* dst = Vt + ((vch + 4 * i) * 8) * VS + vkey;
                dst[0] = (bf16_t)(u[0] & 0xffff); dst[VS] = (bf16_t)(u[0] >> 16); dst[2 * VS] = (bf16_t)(u[1] & 0xffff); dst[3 * VS] = (bf16_t)(u[1] >> 16);
                dst[4 * VS] = (bf16_t)(u[2] & 0xffff); dst[5 * VS] = (bf16_t)(u[2] >> 16); dst[6 * VS] = (bf16_t)(u[3] & 0xffff); dst[7 * VS] = (bf16_t)(u[3] >> 16);
            }
        }
        __syncthreads();
        AttTile nxt; int nit = it + 1; bool have = false;
        while (nit < ntiles) { if (att_tile(nit, is_ctx, Zs, CKb, q0, kvh, nxt)) { have = true; break; } ++nit; }
        if (have) ATT_LOAD(nxt);
        SCHED_FENCE();
        const int kstart = cur.kstart; const bool maskf = cur.maskf;
#pragma unroll 1
        for (int hk = 0; hk < 2; ++hk) {
            bf16x8 kf[2][2], vf[4];
#pragma unroll
            for (int kb = 0; kb < 2; ++kb)
#pragma unroll
                for (int dh = 0; dh < 2; ++dh) { const int row = hk * 32 + kb * 16 + fr; kf[kb][dh] = *(const bf16x8*)(Ks + row * 128 + (((dh * 4 + fq) ^ (row & 7)) << 4)); }
#pragma unroll
            for (int di = 0; di < 4; ++di) {
                const bf16_t* vp = Vt + (di * 16 + fr) * VS + hk * 32 + fq * 4;
                const bf16x4 lo = *(const bf16x4*)vp, hi = *(const bf16x4*)(vp + 16);
                vf[di] = __builtin_shufflevector(lo, hi, 0, 1, 2, 3, 4, 5, 6, 7);
            }
#pragma unroll
            for (int qg = 0; qg < 2; ++qg) {
                f32x4 s[2];
#pragma unroll
                for (int kb = 0; kb < 2; ++kb) {
                    s[kb] = __builtin_amdgcn_mfma_f32_16x16x32_bf16(kf[kb][0], qf[qg][0], (f32x4){0.f, 0.f, 0.f, 0.f}, 0, 0, 0);
                    s[kb] = __builtin_amdgcn_mfma_f32_16x16x32_bf16(kf[kb][1], qf[qg][1], s[kb], 0, 0, 0);
                }
                const int qpos = q0 + qg * 16 + fr;
                float mx = -1e30f;
#pragma unroll
                for (int kb = 0; kb < 2; ++kb)
#pragma unroll
                    for (int j = 0; j < 4; ++j) {
                        float v = s[kb][j] * sc2;
                        if (maskf) { const int d = qpos - (kstart + hk * 32 + kb * 16 + fq * 4 + j); if (d > 128 || d < -128) v = -1e30f; }
                        s[kb][j] = v; mx = fmaxf(mx, v);
                    }
                mx = fmaxf(mx, __shfl_xor(mx, 16)); mx = fmaxf(mx, __shfl_xor(mx, 32));
                const float mn = fmaxf(mrow[qg], mx), alpha = exp2f(mrow[qg] - mn);
                mrow[qg] = mn;
                float ps = 0.f;
#pragma unroll
                for (int kb = 0; kb < 2; ++kb)
#pragma unroll
                    for (int j = 0; j < 4; ++j) { const float pv = exp2f(s[kb][j] - mn); s[kb][j] = pv; ps += pv; }
                lsum[qg] = lsum[qg] * alpha + ps;
#pragma unroll
                for (int di = 0; di < 4; ++di) { o[qg][di][0] *= alpha; o[qg][di][1] *= alpha; o[qg][di][2] *= alpha; o[qg][di][3] *= alpha; }
                uint4 pu; pu.x = pack_bf16(s[0][0], s[0][1]); pu.y = pack_bf16(s[0][2], s[0][3]); pu.z = pack_bf16(s[1][0], s[1][1]); pu.w = pack_bf16(s[1][2], s[1][3]);
                const bf16x8 pf = as_bf16x8(pu);
#pragma unroll
                for (int di = 0; di < 4; ++di) o[qg][di] = __builtin_amdgcn_mfma_f32_16x16x32_bf16(vf[di], pf, o[qg][di], 0, 0, 0);
            }
        }
        if (!have) break;
        cur = nxt; it = nit;
    }
#undef ATT_LOAD
#pragma unroll
    for (int qg = 0; qg < 2; ++qg) {
        float l = lsum[qg]; l += __shfl_xor(l, 16); l += __shfl_xor(l, 32);
        const float inv = 1.f / l;
        const int tok = seq_base + q0 + qg * 16 + fr;
#pragma unroll
        for (int di = 0; di < 4; ++di) {
            const f32x4 v = o[qg][di];
            *(uint2*)(ACT + (size_t)tok * ACTW + 768 + head * 64 + di * 16 + fq * 4) = make_uint2(pack_bf16(v[0] * inv, v[1] * inv), pack_bf16(v[2] * inv, v[3] * inv));
        }
    }
}

DEVINL void conva_tile(const Params& p, int chunk, int l, int tile, char* smem) {
    const int t = tid(), lane = t & 63, w = t >> 6;
    const int S = chunk == 0 ? 256 : 4096;
    const int tok0 = tile * 32, pos0 = tok0 % S, sb = tok0 - pos0;
    const bf16_t* Z = (const bf16_t*)(p.ws + OFF_Z);
    bf16_t* ACT = (bf16_t*)(p.ws + OFF_ACT);
    float* glu = (float*)smem;
    {
        const int chk = t & 31, r0 = t >> 5;
#pragma unroll
        for (int h = 0; h < 2; ++h) {
            uint4 a[4], b[4];
#pragma unroll
            for (int i = 0; i < 4; ++i) {
                const int r = r0 + 8 * (h * 4 + i), pos = pos0 - 15 + r, pc = min(max(pos, 0), S - 1);
                const bf16_t* src = Z + (size_t)(sb + pc) * INW + chk * 8;
                a[i] = *(const uint4*)(src + Z_AVAL); b[i] = *(const uint4*)(src + Z_AGATE);
            }
            SCHED_FENCE();
#pragma unroll
            for (int i = 0; i < 4; ++i) {
                const int r = r0 + 8 * (h * 4 + i), pos = pos0 - 15 + r;
                if (r < 62) {
                    const float keep = (pos >= 0 && pos < S) ? 1.f : 0.f;
                    float av[8], bv[8], g[8]; unpack8(a[i], av); unpack8(b[i], bv);
#pragma unroll
                    for (int e = 0; e < 8; ++e) g[e] = keep * av[e] * sigmoidf_(bv[e]);
                    float4* d = (float4*)(glu + r * 256 + chk * 8);
                    d[0] = make_float4(g[0], g[1], g[2], g[3]); d[1] = make_float4(g[4], g[5], g[6], g[7]);
                }
            }
        }
    }
    __syncthreads();
    {
        float wv[31];
#pragma unroll
        for (int k = 0; k < 31; ++k) wv[k] = p.w_conv_a[((size_t)l * 31 + k) * 256 + t];
        const float bias = p.b_conv_a[l * 256 + t];
        for (int i = 0; i < 32; ++i) {
            float s = bias;
#pragma unroll
            for (int k = 0; k < 31; ++k) s += wv[k] * glu[(i + k) * 256 + t];
            glu[i * 256 + t] = s;
        }
    }
    __syncthreads();
    {
        const float4 g = *(const float4*)(p.ln_g_a + l * 256 + lane * 4), b = *(const float4*)(p.ln_b_a + l * 256 + lane * 4);
#pragma unroll
        for (int i = 0; i < 8; ++i) {
            const int r = w * 8 + i;
            const float4 v = *(const float4*)(glu + r * 256 + lane * 4);
            const float mu = wave_sum(v.x + v.y + v.z + v.w) * (1.f / 256.f);
            const float d0 = v.x - mu, d1 = v.y - mu, d2 = v.z - mu, d3 = v.w - mu;
            const float var = wave_sum(d0 * d0 + d1 * d1 + d2 * d2 + d3 * d3) * (1.f / 256.f);
            const float rs = rsqrtf(var + EPS);
            float y0 = d0 * rs * g.x + b.x, y1 = d1 * rs * g.y + b.y, y2 = d2 * rs * g.z + b.z, y3 = d3 * rs * g.w + b.w;
            y0 *= sigmoidf_(y0); y1 *= sigmoidf_(y1); y2 *= sigmoidf_(y2); y3 *= sigmoidf_(y3);
            *(uint2*)(ACT + (size_t)(tok0 + r) * ACTW + 0 + lane * 4) = make_uint2(pack_bf16(y0, y1), pack_bf16(y2, y3));
        }
    }
}
DEVINL void pool_tile(const Params& p, int chunk, int l, int tile, char* smem) {
    const int t = tid();
    const int S = chunk == 0 ? 256 : 4096;
    const int tok0 = tile * 32, pos0 = tok0 % S, sb = tok0 - pos0;
    const bf16_t* Z = (const bf16_t*)(p.ws + OFF_Z);
    bf16_t* ACT = (bf16_t*)(p.ws + OFF_ACT);
    float* u = (float*)smem;
    {
        const int chk = t & 31, r0 = t >> 5;
        uint4 av[6];
#pragma unroll
        for (int i = 0; i < 6; ++i) { const int pos = pos0 - 8 + r0 + 8 * i, pc = min(max(pos, 0), S - 1); av[i] = *(const uint4*)(Z + (size_t)(sb + pc) * INW + Z_POOL + chk * 8); }
        SCHED_FENCE();
#pragma unroll
        for (int i = 0; i < 6; ++i) {
            const int r = r0 + 8 * i, pos = pos0 - 8 + r;
            float g[8]; unpack8(av[i], g);
            const float keep = (pos >= 0 && pos < S) ? 1.f : 0.f;
            float4* d = (float4*)(u + r * 256 + chk * 8);
            d[0] = make_float4(g[0] * keep, g[1] * keep, g[2] * keep, g[3] * keep); d[1] = make_float4(g[4] * keep, g[5] * keep, g[6] * keep, g[7] * keep);
        }
    }
    __syncthreads();
    const int gi = t >> 6, w2 = 1 << gi;
    for (int i = 0; i < 32; ++i) {
        const int pos = pos0 + i;
        float s = 0.f;
        for (int j = -w2; j < w2; ++j) s += u[(i + 8 + j) * 256 + t];
        const int lo = max(pos - w2, 0), hi = min(pos + w2, S);
        const float pooled = s / (float)(hi - lo) - u[(i + 8) * 256 + t];
        u[i * 256 + t] = pooled;
    }
    __syncthreads();
    float acc[32];
#pragma unroll
    for (int i = 0; i < 32; ++i) acc[i] = 0.f;
    const float* wp = p.w_pool + ((size_t)l * 4 + gi) * 4096 + (t & 63);
#pragma unroll 1
    for (int c0 = 0; c0 < 64; c0 += 16) {
        float wv[16];
#pragma unroll
        for (int c = 0; c < 16; ++c) wv[c] = wp[(c0 + c) * 64];
#pragma unroll
        for (int c = 0; c < 16; ++c) {
            const float* up = u + gi * 64 + c0 + c;
#pragma unroll
            for (int i = 0; i < 32; ++i) acc[i] += up[i * 256] * wv[c];
        }
    }
    const float ps = p.pool_scale[l * 256 + t];
#pragma unroll
    for (int i = 0; i < 32; ++i) {
        const float v = acc[i] * ps;
        ACT[(size_t)(tok0 + i) * ACTW + 256 + t] = (bf16_t)(pack_bf16(v, 0.f) & 0xffff);
    }
}
DEVINL void convc_tile(const Params& p, int chunk, int l, int tile) {
    const int t = tid();
    const int S = chunk == 0 ? 256 : 4096;
    const bf16_t* Z = (const bf16_t*)(p.ws + OFF_Z);
    bf16_t* ACT = (bf16_t*)(p.ws + OFF_ACT);
#pragma unroll 1
    for (int i = 0; i < 4; ++i) {
        const int item = i * 256 + t, chk = item & 31, tok = tile * 32 + (item >> 5), pos = tok % S;
        const bf16_t* zr = Z + (size_t)tok * INW + chk * 8;
        float uu[3][8];
#pragma unroll
        for (int j = 0; j < 3; ++j) {
            const int pp = pos + j - 1;
            if (pp >= 0 && pp < S) {
                const uint4 a = *(const uint4*)(zr + (j - 1) * INW + Z_SC), b = *(const uint4*)(zr + (j - 1) * INW + Z_SH);
                float av[8], bv[8]; unpack8(a, av); unpack8(b, bv);
#pragma unroll
                for (int e = 0; e < 8; ++e) uu[j][e] = av[e] * bv[e];
            } else {
#pragma unroll
                for (int e = 0; e < 8; ++e) uu[j][e] = 0.f;
            }
        }
        const uint4 sbv = *(const uint4*)(zr + Z_SB);
        float sbf[8], r[8]; unpack8(sbv, sbf);
        const float* wc = p.w_sc + (size_t)l * 768 + chk * 8;
#pragma unroll
        for (int e = 0; e < 8; ++e) r[e] = sbf[e] * (wc[e] * uu[0][e] + wc[256 + e] * uu[1][e] + wc[512 + e] * uu[2][e]);
        *(uint4*)(ACT + (size_t)tok * ACTW + 512 + chk * 8) = pack8(r);
    }
}
DEVINL void phase_branch(const Params& p, int chunk, int l, char* smem) {
    for (int tile = blockIdx.x; tile < 1280; tile += gridDim.x) {
        if (tile < 512) attn_unit(p, chunk, l, tile, smem);
        else if (tile < 768) conva_tile(p, chunk, l, tile - 512, smem);
        else if (tile < 1024) pool_tile(p, chunk, l, tile - 768, smem);
        else convc_tile(p, chunk, l, tile - 1024);
        __syncthreads();
    }
}

#define XB_TMO      128
#define XB_XCNT(j)  (256  + 64 * (j))
#define XB_XSUB(j)  (1280 + 64 * (j))
#define XB_XGEN(j)  (2304 + 64 * (j))
#define XB_TOP      3328
#define XB_TOPGEN   3392
#define XB_SPIN_CAP (1u << 20)
DEVINL unsigned xb_ld(unsigned* p) { return __hip_atomic_load(p, __ATOMIC_RELAXED, __HIP_MEMORY_SCOPE_AGENT); }
DEVINL unsigned xb_add(unsigned* p, unsigned v) { return __hip_atomic_fetch_add(p, v, __ATOMIC_RELAXED, __HIP_MEMORY_SCOPE_AGENT); }
DEVINL unsigned xb_xcc_id() { return (unsigned)__builtin_amdgcn_s_getreg((3 << 11) | 20) & 0xFu; }
#define XB_SPIN(cond, bar) do { unsigned _sp = 0; while (cond) { __builtin_amdgcn_s_sleep(1); \
    if ((++_sp & 255u) == 0u) { if (xb_ld(&(bar)[XB_TMO])) break; if (_sp > XB_SPIN_CAP) { atomicAdd(&(bar)[XB_TMO], 1u); break; } } } } while (0)
struct XcdBar { unsigned* bar; unsigned x, nloc, nx; };
DEVINL void xb_census(unsigned* bar, unsigned x, unsigned& nloc, unsigned& nx) {
    const unsigned G = gridDim.x;
    unsigned sum, cnt, mine, sp = 0u;
    for (;;) {
        sum = 0u; cnt = 0u; mine = 0u;
#pragma unroll
        for (unsigned j = 0; j < 16; ++j) { const unsigned c = xb_ld(&bar[XB_XCNT(j)]); sum += c; cnt += (c > 0u) ? 1u : 0u; mine = (j == x) ? c : mine; }
        if (sum == G) break;
        __builtin_amdgcn_s_sleep(1);
        if ((++sp & 255u) == 0u) { if (xb_ld(&bar[XB_TMO])) break; if (sp > XB_SPIN_CAP) { atomicAdd(&bar[XB_TMO], 1u); break; } }
    }
    nloc = mine > 0u ? mine : 1u; nx = cnt > 0u ? cnt : 1u;
}
DEVINL void gsync(XcdBar& b) {
    asm volatile("s_waitcnt vmcnt(0)" ::: "memory");
    __syncthreads();
    if (threadIdx.x == 0) {
        unsigned* bar = b.bar;
        __builtin_amdgcn_s_waitcnt(0);
        if (b.nloc == 0u) xb_census(bar, b.x, b.nloc, b.nx);
        const unsigned nloc = b.nloc, nx = b.nx;
        const unsigned old = xb_add(&bar[XB_XSUB(b.x)], 1u);
        const unsigned gen = old / nloc;
        if (old + 1u == (gen + 1u) * nloc) {
            __builtin_amdgcn_fence(__ATOMIC_RELEASE, "agent");
            asm volatile("s_waitcnt vmcnt(0)" ::: "memory");
            const unsigned og = xb_add(&bar[XB_TOP], 1u);
            const unsigned tg = og / nx;
            if (og + 1u == (tg + 1u) * nx) xb_add(&bar[XB_TOPGEN], 1u);
            else XB_SPIN(xb_ld(&bar[XB_TOPGEN]) == tg, bar);
            __builtin_amdgcn_fence(__ATOMIC_ACQUIRE, "agent");
            xb_add(&bar[XB_XGEN(b.x)], 1u);
            asm volatile("s_waitcnt vmcnt(0)" ::: "memory");
        } else {
            XB_SPIN(xb_ld(&bar[XB_XGEN(b.x)]) == gen, bar);
            __builtin_amdgcn_fence(__ATOMIC_ACQUIRE, "agent");
            asm volatile("s_waitcnt vmcnt(0)" ::: "memory");
        }
    }
    __syncthreads();
}
__global__ void __launch_bounds__(256, 2) mega(Params p) {
    __shared__ __attribute__((aligned(16))) char smem[65536];
    cg::grid_group grid = cg::this_grid();
    grid.sync();
    XcdBar xb; xb.bar = (unsigned*)(p.ws + OFF_BAR); xb.x = xb_xcc_id(); xb.nloc = 0u; xb.nx = 0u;
    if (threadIdx.x == 0) (void)xb_add(&xb.bar[XB_XCNT(xb.x)], 1u);
#pragma unroll 1
    for (int step = 0; step < NSTEPS; ++step) {
        int ph, ch = 0, l = 0;
        if (step == 0) ph = 8;
        else if (step == 1) ph = 9;
        else { const int s = step - 2; ch = s >> 4; const int r = s & 15; l = r >> 3; ph = r & 7; }
        const bf16_t* WT = (const bf16_t*)(p.ws + OFF_WT) + (size_t)l * W_LAYER;
        const bf16_t* H = (const bf16_t*)(p.ws + OFF_H);
        int kind = 0;
        GemmDesc g; g.A = H; g.W = WT; g.lda = LDH; g.ldb = LW1; g.K = D; g.nN = 8; g.epi = 1; g.l = l; g.chunk = ch;
        int rp_mode = 1, rp_which = 1, rp_hsel = 0, rp_lh = l;
        switch (ph) {
            case 8: kind = 3; break;
            case 9: kind = 1; rp_mode = 0; rp_hsel = 1; rp_lh = 0; break;
            case 0: g.W = WT + WO_IN; g.nN = 50; g.epi = 0; break;
            case 1: kind = 2; break;
            case 2: g.A = (const bf16_t*)(p.ws + OFF_ACT); g.lda = ACTW; g.W = WT + WO_A; g.ldb = LWM; g.K = 1280; g.epi = 3; break;
            case 3: g.W = WT + WO_O; break;
            case 4: kind = 1; rp_which = 1; rp_hsel = 2; break;
            case 5: g.W = WT + WO_F1; g.nN = 32; g.epi = 2; break;
            case 6: g.A = (const bf16_t*)(p.ws + OFF_HID); g.lda = LDHID; g.W = WT + WO_F2; g.ldb = LW4; g.K = DFF; break;
            default: kind = 1; rp_which = 2; rp_hsel = (l == 0) ? 1 : 0; rp_lh = 1; break;
        }
        if (kind == 0) phase_gemm_any(p, g, smem);
        else if (kind == 1) {
            const int nrep = (ph == 7 && l == 1 && ch < 2) ? 2 : 1;
#pragma unroll 1
            for (int rep = 0; rep < nrep; ++rep) {
                if (rep == 1) { ch += 1; rp_mode = 0; rp_which = 1; rp_hsel = 1; rp_lh = 0; }
                rowpass(p, ch, rp_mode, l, rp_which, rp_hsel, rp_lh);
            }
        }
        else if (kind == 2) phase_branch(p, ch, l, smem);
        else phase_prep(p, smem);
        gsync(xb);
    }
}

extern "C" void kernel_launch(void* const* d_in, const int* in_sizes, int n_in, void* d_out, int out_size, void* d_ws, size_t ws_size, hipStream_t stream) {
    static int grid_blocks = 0;
    if (!grid_blocks) {
        int dev = 0, cus = 0, per_cu = 0;
        (void)hipGetDevice(&dev);
        (void)hipDeviceGetAttribute(&cus, hipDeviceAttributeMultiprocessorCount, dev);
        (void)hipOccupancyMaxActiveBlocksPerMultiprocessor(&per_cu, mega, 256, 0);
        if (per_cu > 2) per_cu = 2;
        if (per_cu < 1) per_cu = 1;
        grid_blocks = cus * per_cu;
    }
    Params p{};
    const float** pp = (const float**)&p;
    for (int i = 0; i < 28; ++i) pp[i] = (const float*)d_in[i];
    p.out = (float*)d_out;
    p.ws = (char*)d_ws;
    (void)hipMemsetAsync((char*)d_ws + OFF_BAR, 0, 16384, stream);
    void* args[] = {&p};
    hipError_t e = hipLaunchCooperativeKernel((void*)mega, dim3(grid_blocks), dim3(256), args, 0, stream);
    if (e != hipSuccess) fprintf(stderr, "cooperative launch failed: %s (grid %d)\n", hipGetErrorString(e), grid_blocks);
}
```

```cpp
#include <hip/hip_runtime.h>
#include <hip/hip_cooperative_groups.h>
#include <stdint.h>
#include <cstdio>
namespace cg = cooperative_groups;

typedef unsigned short bf16_t;
typedef short bf16x8 __attribute__((ext_vector_type(8)));
typedef short bf16x4 __attribute__((ext_vector_type(4)));
typedef float f32x4 __attribute__((ext_vector_type(4)));
typedef unsigned u32x4 __attribute__((ext_vector_type(4)));
#define DEVINL __device__ __forceinline__

constexpr int D = 1024, INW = 6400, CH = 8192  , ACTW = 1344  , DFF = 4096;
constexpr int LDH = 1088, LDHID = 4160, LW1 = 1088, LWM = 1344, LW4 = 4160;
constexpr int Z_AVAL = 0, Z_AGATE = 256, Z_POOL = 512, Z_SB = 768, Z_SC = 1024, Z_SH = 1280, Z_Q = 1536, Z_K = 2048, Z_V = 2176, Z_G = 2304;
constexpr float EPS = 1e-6f;
#ifndef NSTEPS
#define NSTEPS 50
#endif
constexpr size_t WO_IN = 0, WO_A = WO_IN + (size_t)6400 * LW1, WO_O = WO_A + (size_t)1024 * LWM, WO_F1 = WO_O + (size_t)1024 * LW1, WO_F2 = WO_F1 + (size_t)4096 * LW1,
                 W_LAYER = WO_F2 + (size_t)1024 * LW4;
constexpr size_t OFF_WT = 0, OFF_MOD = OFF_WT + 2 * W_LAYER * 2, OFF_CKV = OFF_MOD + 2 * 5 * 6144 * 4, OFF_TAB = OFF_CKV + 2 * 262144 * 2,
                 OFF_H = OFF_TAB + 8192, OFF_ACT = OFF_H + (size_t)CH * LDH * 2, OFF_Z = OFF_ACT + (size_t)CH * ACTW * 2,
                 OFF_MF = OFF_Z, OFF_HID = OFF_Z + (size_t)CH * D * 4, OFF_BAR = OFF_Z + (size_t)CH * INW * 2;
constexpr size_t OUT_K = 25165824, OUT_V = 27262976;

struct Params {
    const float *x_prompt, *x_sample, *cache_k, *cache_v, *c, *c_ctx, *w_ada, *b_ada, *g_pre_mix, *g_post_mix, *g_pre_ffn, *g_post_ffn, *w_in,
        *w_conv_a, *b_conv_a, *ln_g_a, *ln_b_a, *w_a_out, *w_pool, *pool_scale, *w_b_out, *w_sc, *w_c_out, *sink, *w_d_out, *w_o, *w_ff1, *w_ff2;
    float* out;
    char* ws;
};

DEVINL int tid() { int t = threadIdx.x; asm volatile("" : "+v"(t)); return t; }
DEVINL float bf_lo(uint32_t u) { return __uint_as_float(u << 16); }
DEVINL float bf_hi(uint32_t u) { return __uint_as_float(u & 0xffff0000u); }
typedef __bf16 bf16x2_t __attribute__((ext_vector_type(2)));
typedef float f32x2_t __attribute__((ext_vector_type(2)));
DEVINL uint32_t pack_bf16(float lo, float hi) { const f32x2_t v = {lo, hi}; const bf16x2_t b = __builtin_convertvector(v, bf16x2_t); return __builtin_bit_cast(uint32_t, b); }
DEVINL void unpack8(const uint4& u, float (&f)[8]) {
    f[0] = bf_lo(u.x); f[1] = bf_hi(u.x); f[2] = bf_lo(u.y); f[3] = bf_hi(u.y); f[4] = bf_lo(u.z); f[5] = bf_hi(u.z); f[6] = bf_lo(u.w); f[7] = bf_hi(u.w);
}
DEVINL uint4 pack8(const float (&f)[8]) { uint4 u; u.x = pack_bf16(f[0], f[1]); u.y = pack_bf16(f[2], f[3]); u.z = pack_bf16(f[4], f[5]); u.w = pack_bf16(f[6], f[7]); return u; }
DEVINL float sigmoidf_(float x) { return 1.f / (1.f + __expf(-x)); }
DEVINL float wave_sum(float v) {
#pragma unroll
    for (int o = 32; o > 0; o >>= 1) v += __shfl_xor(v, o);
    return v;
}
DEVINL bf16x8 as_bf16x8(const uint4& u) { union { uint4 a; bf16x8 b; } x; x.a = u; return x.b; }

#define SCHED_FENCE() __builtin_amdgcn_sched_barrier(0)
template <bool FKK>
DEVINL void gemm_compute(const char* cur, int aoff, int boff, int fq, int sw, f32x4 (&acc)[4][4]) {
#pragma unroll
    for (int kk = 0; kk < 2; ++kk) {
        if (FKK) SCHED_FENCE();
        bf16x8 af[4], bfr[4];
        const int co = ((kk * 4 + fq) ^ sw) << 4;
#pragma unroll
        for (int i = 0; i < 4; ++i) { af[i] = *(const bf16x8*)(cur + aoff + i * 2048 + co); bfr[i] = *(const bf16x8*)(cur + boff + i * 2048 + co); }
        __builtin_amdgcn_s_setprio(1);
#pragma unroll
        for (int mi = 0; mi < 4; ++mi)
#pragma unroll
            for (int ni = 0; ni < 4; ++ni) acc[mi][ni] = __builtin_amdgcn_mfma_f32_16x16x32_bf16(bfr[ni], af[mi], acc[mi][ni], 0, 0, 0);
        __builtin_amdgcn_s_setprio(0);
    }
}
struct NoHook { DEVINL void operator()(int, f32x4 (&)[4][4]) const {} };
template <int DEPTH, class Hook = NoHook>
DEVINL void gemm_loop(const bf16_t* __restrict__ A, int lda, const bf16_t* __restrict__ B, int ldb, int K, char* smem, f32x4 (&acc)[4][4], const Hook& hook = Hook()) {
    const int t = tid(), lane = t & 63, w = t >> 6, wm = w >> 1, wn = w & 1, fr = lane & 15, fq = lane >> 4;
    const int sc = t & 7, sr = t >> 3;
    const bf16_t* ag = A + (size_t)sr * lda + sc * 8;
    const bf16_t* bg = B + (size_t)sr * ldb + sc * 8;
    const int soff = sr * 128 + ((sc ^ ((sr >> 1) & 7)) << 4);
    const int aoff = (wm * 64 + fr) * 128, boff = 16384 + (wn * 64 + fr) * 128, sw = (fr >> 1) & 7;
    const int nk = K >> 6;
    u32x4 r0a[4], r0b[4], r1a[4], r1b[4];
#define G_LOAD(RA, RB, KT) { _Pragma("unroll") for (int i = 0; i < 4; ++i) { RA[i] = *(const u32x4*)(ag + (size_t)i * 32 * lda + (KT) * 64); RB[i] = *(const u32x4*)(bg + (size_t)i * 32 * ldb + (KT) * 64); } }
#define G_STORE(RA, RB, BUF) { _Pragma("unroll") for (int i = 0; i < 4; ++i) { *(u32x4*)(smem + (BUF) * 32768 + soff + i * 4096) = RA[i]; *(u32x4*)(smem + (BUF) * 32768 + 16384 + soff + i * 4096) = RB[i]; } }
    G_LOAD(r0a, r0b, 0);
    G_LOAD(r1a, r1b, 1);
    SCHED_FENCE();
    __syncthreads();
    G_STORE(r0a, r0b, 0);
    __syncthreads();
    for (int kt = 0; kt < nk; kt += 2) {
        G_LOAD(r0a, r0b, min(kt + 2, nk - 1));
        SCHED_FENCE();
        gemm_compute<false>(smem, aoff, boff, fq, sw, acc);
        SCHED_FENCE();
        G_STORE(r1a, r1b, 1);
        __syncthreads();
        G_LOAD(r1a, r1b, min(kt + 3, nk - 1));
        SCHED_FENCE();
        gemm_compute<false>(smem + 32768, aoff, boff, fq, sw, acc);
        SCHED_FENCE();
        hook(kt + 1, acc);
        G_STORE(r0a, r0b, 0);
        __syncthreads();
    }
#undef G_LOAD
#undef G_STORE
}
#define LAS3 __attribute__((address_space(3)))
template <class Hook = NoHook>
DEVINL void gemm_loop_dma(const bf16_t* __restrict__ A, int lda, const bf16_t* __restrict__ B, int ldb, int K, char* smem, f32x4 (&acc)[4][4], const Hook& hook,
                          const bf16_t* An, const bf16_t* Bn, bool pre) {
    const int t = tid(), lane = t & 63, w = t >> 6, wm = w >> 1, wn = w & 1, fr = lane & 15, fq = lane >> 4;
    const int sc = t & 7, sr = t >> 3;
    const bf16_t* ag = A + (size_t)sr * lda + ((sc ^ ((sr >> 1) & 7)) << 3);
    const int srp = 8 * ((sr & 15) >> 2) + 4 * (sr >> 4) + (sr & 3);
    const bf16_t* bg = B + (size_t)srp * ldb + ((sc ^ ((sr >> 1) & 7)) << 3);
    const int aoff = (wm * 64 + fr) * 128, boff = 16384 + (wn * 64 + fr) * 128, sw = (fr >> 1) & 7;
    const int nk = K >> 6;
    LAS3 char* lds = (LAS3 char*)smem;
    const int pw = w * 1024;
#define D_ISSUE(BUF, KT) { _Pragma("unroll") for (int i = 0; i < 4; ++i) { \
        __builtin_amdgcn_global_load_lds((const unsigned*)(ag + (size_t)i * 32 * lda + (KT) * 64), (LAS3 unsigned*)(lds + (BUF) * 32768 + i * 4096 + pw), 16, 0, 0); \
        __builtin_amdgcn_global_load_lds((const unsigned*)(bg + (size_t)i * 32 * ldb + (KT) * 64), (LAS3 unsigned*)(lds + (BUF) * 32768 + 16384 + i * 4096 + pw), 16, 0, 0); } }
#define D_WAIT() { asm volatile("s_waitcnt vmcnt(0)" ::: "memory"); __builtin_amdgcn_s_barrier(); asm volatile("" ::: "memory"); }
    if (!pre) D_ISSUE(0, 0);
    D_WAIT();
    for (int kt = 0; kt < nk; kt += 2) {
        D_ISSUE(1, kt + 1);
        SCHED_FENCE();
        gemm_compute<false>(smem, aoff, boff, fq, sw, acc);
        SCHED_FENCE();
        D_WAIT();
        if (kt + 2 < nk) D_ISSUE(0, kt + 2)
        else if (An) {
            const bf16_t* ag2 = An + (size_t)sr * lda + ((sc ^ ((sr >> 1) & 7)) << 3);
            const bf16_t* bg2 = Bn + (size_t)srp * ldb + ((sc ^ ((sr >> 1) & 7)) << 3);
#pragma unroll
            for (int i = 0; i < 4; ++i) {
                __builtin_amdgcn_global_load_lds((const unsigned*)(ag2 + (size_t)i * 32 * lda), (LAS3 unsigned*)(lds + i * 4096 + pw), 16, 0, 0);
                __builtin_amdgcn_global_load_lds((const unsigned*)(bg2 + (size_t)i * 32 * ldb), (LAS3 unsigned*)(lds + 16384 + i * 4096 + pw), 16, 0, 0);
            }
        }
        SCHED_FENCE();
        gemm_compute<false>(smem + 32768, aoff, boff, fq, sw, acc);
        SCHED_FENCE();
        hook(kt + 1, acc);
        if (kt + 2 < nk) D_WAIT();
    }
#undef D_ISSUE
#undef D_WAIT
}
DEVINL void gemm_loop1(const bf16_t* __restrict__ A, int lda, const bf16_t* __restrict__ B, int ldb, int K, char* smem, f32x4 (&acc)[4][4]) {
    const int t = tid(), lane = t & 63, w = t >> 6, wm = w >> 1, wn = w & 1, fr = lane & 15, fq = lane >> 4;
    const int sc = t & 7, sr = t >> 3;
    const bf16_t* ag = A + (size_t)sr * lda + sc * 8;
    const bf16_t* bg = B + (size_t)sr * ldb + sc * 8;
    const int soff = sr * 128 + ((sc ^ ((sr >> 1) & 7)) << 4);
    u32x4 ra[4], rb[4];
    const int nk = K >> 6;
#pragma unroll
    for (int i = 0; i < 4; ++i) { ra[i] = *(const u32x4*)(ag + (size_t)i * 32 * lda); rb[i] = *(const u32x4*)(bg + (size_t)i * 32 * ldb); }
    __syncthreads();
#pragma unroll
    for (int i = 0; i < 4; ++i) { *(u32x4*)(smem + soff + i * 4096) = ra[i]; *(u32x4*)(smem + 16384 + soff + i * 4096) = rb[i]; }
    __syncthreads();
    const int aoff = (wm * 64 + fr) * 128, boff = 16384 + (wn * 64 + fr) * 128, sw = (fr >> 1) & 7;
    for (int kt = 0; kt < nk; ++kt) {
        const char* cur = smem + (kt & 1) * 32768;
        if (kt + 1 < nk) {
#pragma unroll
            for (int i = 0; i < 4; ++i) { ra[i] = *(const u32x4*)(ag + (size_t)i * 32 * lda + (kt + 1) * 64); rb[i] = *(const u32x4*)(bg + (size_t)i * 32 * ldb + (kt + 1) * 64); }
        }
        gemm_compute<false>(cur, aoff, boff, fq, sw, acc);
        if (kt + 1 < nk) {
            char* nxt = smem + ((kt + 1) & 1) * 32768;
#pragma unroll
            for (int i = 0; i < 4; ++i) { *(u32x4*)(nxt + soff + i * 4096) = ra[i]; *(u32x4*)(nxt + 16384 + soff + i * 4096) = rb[i]; }
        }
        __syncthreads();
    }
}
DEVINL void zero_acc(f32x4 (&acc)[4][4]) {
#pragma unroll
    for (int i = 0; i < 4; ++i)
#pragma unroll
        for (int j = 0; j < 4; ++j) acc[i][j] = (f32x4){0.f, 0.f, 0.f, 0.f};
}
DEVINL void tile_order(int t, int nN, int& pm, int& pn) { const int g = t / (8 * nN), r = t % (8 * nN); pn = r >> 3; pm = g * 8 + (r & 7); }
struct TileWalk {
    int nN, i, x, j, nb; bool xcd;
    DEVINL void init(int nN_) { nN = nN_; i = 0; xcd = (gridDim.x & 7) == 0; x = blockIdx.x & 7; j = blockIdx.x >> 3; nb = gridDim.x >> 3; }
    DEVINL bool next(int& pm, int& pn) {
        if (xcd) { const int s = i * nb + j; ++i; if (s >= 8 * nN) return false; pn = s >> 3; pm = x * 8 + (s & 7); return true; }
        const int t = blockIdx.x + i * gridDim.x; ++i; if (t >= 64 * nN) return false; tile_order(t, nN, pm, pn); return true;
    }
};

DEVINL void wt_tile2(const float* __restrict__ src, int K, int N, bf16_t* __restrict__ dst, int ldd, int tile0, char* smem) {
    const int nNt = N >> 6, t = tid();
    float* tl = (float*)smem;
    const int r = t >> 4, c4 = t & 15;
    f32x4 v[2][4];
#pragma unroll
    for (int u = 0; u < 2; ++u) {
        const int tile = tile0 + u, k0 = (tile / nNt) * 64, n0 = (tile % nNt) * 64;
#pragma unroll
        for (int i = 0; i < 4; ++i) v[u][i] = *(const f32x4*)(src + (size_t)(k0 + r + 16 * i) * N + n0 + c4 * 4);
    }
    asm volatile("" : "+v"(v[0][0]), "+v"(v[0][1]), "+v"(v[0][2]), "+v"(v[0][3]), "+v"(v[1][0]), "+v"(v[1][1]), "+v"(v[1][2]), "+v"(v[1][3]));
#pragma unroll
    for (int u = 0; u < 2; ++u)
#pragma unroll
        for (int i = 0; i < 4; ++i) { float* q = tl + u * 4160 + (r + 16 * i) * 65 + c4 * 4; q[0] = v[u][i][0]; q[1] = v[u][i][1]; q[2] = v[u][i][2]; q[3] = v[u][i][3]; }
    __syncthreads();
    const int n = t >> 2, kq = t & 3;
#pragma unroll
    for (int u = 0; u < 2; ++u) {
        const int tile = tile0 + u, k0 = (tile / nNt) * 64, n0 = (tile % nNt) * 64;
        uint32_t pk[8];
#pragma unroll
        for (int e = 0; e < 8; ++e) pk[e] = pack_bf16(tl[u * 4160 + (kq * 16 + 2 * e) * 65 + n], tl[u * 4160 + (kq * 16 + 2 * e + 1) * 65 + n]);
        uint4* o = (uint4*)(dst + (size_t)(n0 + n) * ldd + k0 + kq * 16);
        o[0] = make_uint4(pk[0], pk[1], pk[2], pk[3]); o[1] = make_uint4(pk[4], pk[5], pk[6], pk[7]);
    }
    __syncthreads();
}
DEVINL void mod_tile(const Params& p, int tile, char* smem) {
    const int l = tile / 96, n0 = (tile % 96) * 64, t = tid(), kg = t >> 6, col = t & 63;
    float* sl = (float*)smem;
    float* red = sl + 5 * 1024;
    for (int i = t; i < 5 * 1024; i += 256) { const int cb = i >> 10, k = i & 1023; const float x = cb == 0 ? p.c_ctx[k] : p.c[(cb - 1) * 1024 + k]; sl[i] = x * sigmoidf_(x); }
    __syncthreads();
    float a0 = 0.f, a1 = 0.f, a2 = 0.f, a3 = 0.f, a4 = 0.f;
    const float* wp = p.w_ada + ((size_t)l * 1024 + kg * 256) * 6144 + n0 + col;
#pragma unroll 1
    for (int k0 = 0; k0 < 256; k0 += 32) {
        float wv[32];
#pragma unroll
        for (int k = 0; k < 32; ++k) wv[k] = wp[(size_t)(k0 + k) * 6144];
        SCHED_FENCE();
#pragma unroll
        for (int k = 0; k < 32; ++k) {
            const int kk = kg * 256 + k0 + k;
            a0 += sl[kk] * wv[k]; a1 += sl[1024 + kk] * wv[k]; a2 += sl[2048 + kk] * wv[k]; a3 += sl[3072 + kk] * wv[k]; a4 += sl[4096 + kk] * wv[k];
        }
    }
    red[(kg * 5 + 0) * 64 + col] = a0; red[(kg * 5 + 1) * 64 + col] = a1; red[(kg * 5 + 2) * 64 + col] = a2; red[(kg * 5 + 3) * 64 + col] = a3; red[(kg * 5 + 4) * 64 + col] = a4;
    __syncthreads();
    float* mod = (float*)(p.ws + OFF_MOD);
    for (int i = t; i < 320; i += 256) {
        const int cb = i >> 6, cc = i & 63;
        const float s = red[(0 * 5 + cb) * 64 + cc] + red[(1 * 5 + cb) * 64 + cc] + red[(2 * 5 + cb) * 64 + cc] + red[(3 * 5 + cb) * 64 + cc];
        mod[((size_t)l * 5 + cb) * 6144 + n0 + cc] = s + p.b_ada[l * 6144 + n0 + cc];
    }
    __syncthreads();
}
DEVINL void phase_prep(const Params& p, char* smem) {
    const int t = tid();
    bf16_t* WT = (bf16_t*)(p.ws + OFF_WT);
    constexpr int NMOD = 192, NW = 4224  , NC = 256, NT = NMOD + NW + NC + 1;
    for (int tile = blockIdx.x; tile < NT; tile += gridDim.x) {
        if (tile < NMOD) mod_tile(p, tile, smem);
        else if (tile < NMOD + NW) {
            int wt = (tile - NMOD) * 2; const int l = wt / 4224; wt -= l * 4224;
            const float* src; int K, N, ldd; size_t dofs;
            if (wt < 1600) { src = p.w_in + (size_t)l * 1024 * 6400; K = 1024; N = 6400; ldd = LW1; dofs = WO_IN; }
            else if (wt < 1664) { wt -= 1600; src = p.w_a_out + (size_t)l * 256 * 1024; K = 256; N = 1024; ldd = LWM; dofs = WO_A; }
            else if (wt < 1728) { wt -= 1664; src = p.w_b_out + (size_t)l * 256 * 1024; K = 256; N = 1024; ldd = LWM; dofs = WO_A + 256; }
            else if (wt < 1792) { wt -= 1728; src = p.w_c_out + (size_t)l * 256 * 1024; K = 256; N = 1024; ldd = LWM; dofs = WO_A + 512; }
            else if (wt < 1920) { wt -= 1792; src = p.w_d_out + (size_t)l * 512 * 1024; K = 512; N = 1024; ldd = LWM; dofs = WO_A + 768; }
            else if (wt < 2176) { wt -= 1920; src = p.w_o + (size_t)l * 1024 * 1024; K = 1024; N = 1024; ldd = LW1; dofs = WO_O; }
            else if (wt < 3200) { wt -= 2176; src = p.w_ff1 + (size_t)l * 1024 * 4096; K = 1024; N = 4096; ldd = LW1; dofs = WO_F1; }
            else { wt -= 3200; src = p.w_ff2 + (size_t)l * 4096 * 1024; K = 4096; N = 1024; ldd = LW4; dofs = WO_F2; }
            wt_tile2(src, K, N, WT + (size_t)l * W_LAYER + dofs, ldd, wt, smem);
        } else if (tile < NMOD + NW + NC) {
            const int i = (tile - NMOD - NW) * 256 + t;
            const float* src = (i < 32768) ? p.cache_k + (size_t)i * 8 : p.cache_v + (size_t)(i - 32768) * 8;
            const float4 a = *(const float4*)src, b = *(const float4*)(src + 4);
            uint4 o; o.x = pack_bf16(a.x, a.y); o.y = pack_bf16(a.z, a.w); o.z = pack_bf16(b.x, b.y); o.w = pack_bf16(b.z, b.w);
            *(uint4*)(p.ws + OFF_CKV + (size_t)i * 16) = o;
        } else {
            float2* tab = (float2*)(p.ws + OFF_TAB);
            for (int i = t; i < 1024; i += 256) {
                const int pos = i >> 4, fi = i & 15;
                const float freq = exp2f(-(float)fi * (13.287712379549449f / 16.f));
                const float ang = (float)pos * freq;
                tab[i] = make_float2(__cosf(ang), __sinf(ang));
            }
        }
    }
}

DEVINL void rowpass(const Params& p, int chunk, int mode, int lpost, int which_post, int hsel, int lh) {
    const int lane = tid() & 63, w = tid() >> 6;
    const float* mod = (const float*)(p.ws + OFF_MOD);
    const bf16_t* MF = (const bf16_t*)(p.ws + OFF_MF);
    bf16_t* H = (bf16_t*)(p.ws + OFF_H);
    const float* xin = chunk == 0 ? p.x_prompt : p.x_sample + (size_t)(chunk - 1) * CH * D;
    float* xres = p.out + (size_t)chunk * CH * D;
    const float* xsrc = mode == 0 ? xin : xres;
    const float* gpost = which_post == 1 ? p.g_post_mix + lpost * D : p.g_post_ffn + lpost * D;
    const float* gpre = hsel == 1 ? p.g_pre_mix + lh * D : p.g_pre_ffn + lh * D;
    for (int base = (blockIdx.x * 4 + w) * 4; base < CH; base += gridDim.x * 16) {
        const int cb = chunk == 0 ? 0 : 1 + (chunk - 1) * 2 + (base >> 12);
        float pg[16], hg[16], hs[16];
        if (mode == 1) {
            const float* gate = mod + ((size_t)lpost * 5 + cb) * 6144 + (which_post == 1 ? 2 : 5) * 1024;
            float4 gp[4], gt[4];
#pragma unroll
            for (int i = 0; i < 4; ++i) { const int c = i * 256 + lane * 4; gp[i] = *(const float4*)(gpost + c); gt[i] = *(const float4*)(gate + c); }
            SCHED_FENCE();
#pragma unroll
            for (int i = 0; i < 4; ++i) { pg[4 * i] = gp[i].x * gt[i].x; pg[4 * i + 1] = gp[i].y * gt[i].y; pg[4 * i + 2] = gp[i].z * gt[i].z; pg[4 * i + 3] = gp[i].w * gt[i].w; }
        }
        if (hsel) {
            const float* mb = mod + ((size_t)lh * 5 + cb) * 6144 + (hsel == 1 ? 0 : 3) * 1024;
            float4 g[4], sh[4], sc[4];
#pragma unroll
            for (int i = 0; i < 4; ++i) { const int c = i * 256 + lane * 4; g[i] = *(const float4*)(gpre + c); sh[i] = *(const float4*)(mb + c); sc[i] = *(const float4*)(mb + 1024 + c); }
            SCHED_FENCE();
#pragma unroll
            for (int i = 0; i < 4; ++i) {
                hg[4 * i] = g[i].x * (1.f + sc[i].x); hg[4 * i + 1] = g[i].y * (1.f + sc[i].y); hg[4 * i + 2] = g[i].z * (1.f + sc[i].z); hg[4 * i + 3] = g[i].w * (1.f + sc[i].w);
                hs[4 * i] = sh[i].x; hs[4 * i + 1] = sh[i].y; hs[4 * i + 2] = sh[i].z; hs[4 * i + 3] = sh[i].w;
            }
        }
#pragma unroll 1
        for (int pr = 0; pr < 2; ++pr) {
            const int row0 = base + pr * 2;
            float x[2][16], m[2][16];
#pragma unroll
            for (int r = 0; r < 2; ++r)
#pragma unroll
                for (int i = 0; i < 4; ++i) {
                    const size_t o = (size_t)(row0 + r) * D + i * 256 + lane * 4;
                    const float4 v = *(const float4*)(xsrc + o);
                    x[r][4 * i] = v.x; x[r][4 * i + 1] = v.y; x[r][4 * i + 2] = v.z; x[r][4 * i + 3] = v.w;
                    if (mode == 1) { const uint2 q = *(const uint2*)(MF + o); m[r][4 * i] = bf_lo(q.x); m[r][4 * i + 1] = bf_hi(q.x); m[r][4 * i + 2] = bf_lo(q.y); m[r][4 * i + 3] = bf_hi(q.y); }
                }
            SCHED_FENCE();
#pragma unroll
            for (int r = 0; r < 2; ++r) {
                if (mode == 1) {
                    float ss = 0.f;
#pragma unroll
                    for (int i = 0; i < 16; ++i) ss += m[r][i] * m[r][i];
                    ss = wave_sum(ss);
                    const float rs = rsqrtf(ss * (1.f / D) + EPS);
#pragma unroll
                    for (int i = 0; i < 16; ++i) x[r][i] += (m[r][i] * rs) * pg[i];
                }
#pragma unroll
                for (int i = 0; i < 4; ++i) *(float4*)(xres + (size_t)(row0 + r) * D + i * 256 + lane * 4) = make_float4(x[r][4 * i], x[r][4 * i + 1], x[r][4 * i + 2], x[r][4 * i + 3]);
                if (hsel) {
                    float ss = 0.f;
#pragma unroll
                    for (int i = 0; i < 16; ++i) ss += x[r][i] * x[r][i];
                    ss = wave_sum(ss);
                    const float rs = rsqrtf(ss * (1.f / D) + EPS);
#pragma unroll
                    for (int i = 0; i < 4; ++i) {
                        const float h0 = x[r][4 * i] * rs * hg[4 * i] + hs[4 * i], h1 = x[r][4 * i + 1] * rs * hg[4 * i + 1] + hs[4 * i + 1];
                        const float h2 = x[r][4 * i + 2] * rs * hg[4 * i + 2] + hs[4 * i + 2], h3 = x[r][4 * i + 3] * rs * hg[4 * i + 3] + hs[4 * i + 3];
                        *(uint2*)(H + (size_t)(row0 + r) * LDH + i * 256 + lane * 4) = make_uint2(pack_bf16(h0, h1), pack_bf16(h2, h3));
                    }
                }
            }
        }
    }
}

DEVINL void unpack8u(const uint4& u, float (&f)[8]) { unpack8(u, f); }
struct MergeHook {
    const bf16_t* zg;
    bool on;
    DEVINL void operator()(int k, f32x4 (&acc)[4][4]) const {
        if (!on || (k & 3) != 3 || k > 11) return;
        const int b = k >> 2;
        const bf16_t* z = zg + b * 1024;
        uint4 ga[4][2], gb[4][2];
#pragma unroll
        for (int mi = 0; mi < 4; ++mi)
#pragma unroll
            for (int q = 0; q < 2; ++q) { ga[mi][q] = *(const uint4*)(z + (size_t)mi * 16 * INW + q * 32); gb[mi][q] = *(const uint4*)(z + 1024 + (size_t)mi * 16 * INW + q * 32); }
        SCHED_FENCE();
#pragma unroll
        for (int mi = 0; mi < 4; ++mi)
#pragma unroll
            for (int q = 0; q < 2; ++q) {
                float a[8], bb[8]; unpack8(ga[mi][q], a); unpack8(gb[mi][q], bb);
#pragma unroll
                for (int e = 0; e < 8; ++e) acc[mi][2 * q + (e >> 2)][e & 3] *= (1.f + __expf(-bb[e])) * __builtin_amdgcn_rcpf(1.f + __expf(-a[e]));
            }
    }
};
struct GemmDesc { const bf16_t* A; const bf16_t* W; int lda, ldb, K, nN, epi, l, chunk; };
DEVINL void phase_gemm_any(const Params& p, const GemmDesc& g, char* smem) {
    const int lane = tid() & 63, w = tid() >> 6, wm = w >> 1, wn = w & 1, fr = lane & 15, fq = lane >> 4;
    bf16_t* Z = (bf16_t*)(p.ws + OFF_Z);
    bf16_t* MF = (bf16_t*)(p.ws + OFF_MF);
    bf16_t* HID = (bf16_t*)(p.ws + OFF_HID);
    bf16_t* MG = (bf16_t*)(p.ws + OFF_H);
    TileWalk tw; tw.init(g.nN);
    int pm, pn, pm2 = 0, pn2 = 0;
    bool have = tw.next(pm, pn), pre = false;
    for (; have; pm = pm2, pn = pn2) {
        const bool have2 = tw.next(pm2, pn2);
        f32x4 acc[4][4]; zero_acc(acc);
        const int row0 = pm * 128 + wm * 64 + fr, col0 = pn * 128 + wn * 64 + fq * 8;
        MergeHook hook; hook.on = (g.epi == 3); hook.zg = Z + (size_t)row0 * INW + Z_G + col0;
        gemm_loop_dma(g.A + (size_t)pm * 128 * g.lda, g.lda, g.W + (size_t)pn * 128 * g.ldb, g.ldb, g.K, smem, acc, hook,
                      have2 ? g.A + (size_t)pm2 * 128 * g.lda : nullptr, have2 ? g.W + (size_t)pn2 * 128 * g.ldb : nullptr, pre);
        pre = have2; have = have2;
        if (g.epi == 0) {
            const bool kv = (g.chunk == 0) && (pn == 16 || pn == 17);
            bf16_t* zo = Z + (size_t)row0 * INW + col0;
            asm volatile("" : "+v"(zo));
#pragma unroll
            for (int mi = 0; mi < 4; ++mi)
#pragma unroll
                for (int q = 0; q < 2; ++q) {
                    const f32x4 v0 = acc[mi][2 * q], v1 = acc[mi][2 * q + 1];
                    *(uint4*)(zo + (size_t)mi * 16 * INW + q * 32) = make_uint4(pack_bf16(v0[0], v0[1]), pack_bf16(v0[2], v0[3]), pack_bf16(v1[0], v1[1]), pack_bf16(v1[2], v1[3]));
                    if (kv) {
                        const int row = row0 + mi * 16, cl = wn * 64 + q * 32 + fq * 8;
                        float* dst = p.out + (pn == 16 ? OUT_K : OUT_V) + ((size_t)((row >> 8) * 2 + g.l) * 256 + (row & 255)) * 128 + cl;
                        *(f32x4*)dst = v0; *(f32x4*)(dst + 4) = v1;
                    }
                }
        } else if (g.epi == 1) {
            bf16_t* mo = MF + (size_t)row0 * D + col0;
            asm volatile("" : "+v"(mo));
#pragma unroll
            for (int mi = 0; mi < 4; ++mi)
#pragma unroll
                for (int q = 0; q < 2; ++q) {
                    const f32x4 v0 = acc[mi][2 * q], v1 = acc[mi][2 * q + 1];
                    *(uint4*)(mo + (size_t)mi * 16 * D + q * 32) = make_uint4(pack_bf16(v0[0], v0[1]), pack_bf16(v0[2], v0[3]), pack_bf16(v1[0], v1[1]), pack_bf16(v1[2], v1[3]));
                }
        } else if (g.epi == 2) {
            bf16_t* ho = HID + (size_t)row0 * LDHID + col0;
            asm volatile("" : "+v"(ho));
#pragma unroll
            for (int mi = 0; mi < 4; ++mi)
#pragma unroll
                for (int q = 0; q < 2; ++q) {
                    float r[8];
#pragma unroll
                    for (int e = 0; e < 8; ++e) { const float x = fmaxf(acc[mi][2 * q + (e >> 2)][e & 3], 0.f); r[e] = x * x; }
                    *(uint4*)(ho + (size_t)mi * 16 * LDHID + q * 32) = pack8(r);
                }
        } else {
            const bf16_t* z3 = hook.zg + 3 * 1024;
            bf16_t* mg = MG + (size_t)row0 * LDH + col0;
            uint4 g3[4][2];
#pragma unroll
            for (int mi = 0; mi < 4; ++mi)
#pragma unroll
                for (int q = 0; q < 2; ++q) g3[mi][q] = *(const uint4*)(z3 + (size_t)mi * 16 * INW + q * 32);
            SCHED_FENCE();
#pragma unroll
            for (int mi = 0; mi < 4; ++mi)
#pragma unroll
                for (int q = 0; q < 2; ++q) {
                    float gg[8], r[8]; unpack8(g3[mi][q], gg);
#pragma unroll
                    for (int e = 0; e < 8; ++e) r[e] = acc[mi][2 * q + (e >> 2)][e & 3] * sigmoidf_(gg[e]);
                    *(uint4*)(mg + (size_t)mi * 16 * LDH + q * 32) = pack8(r);
                }
        }
    }
}

struct AttTile { const bf16_t* kptr; const bf16_t* vptr; int stride, kstart; bool rope, maskf; };
DEVINL bool att_tile(int it, bool is_ctx, const bf16_t* Zs, const bf16_t* CKb, int q0, int kvh, AttTile& d) {
    d.rope = false; d.maskf = false;
    if (is_ctx) { d.kstart = it * 64; d.kptr = Zs + (size_t)d.kstart * INW + Z_K + kvh * 64; d.vptr = d.kptr + 128; d.stride = INW; return true; }
    if (it < 5) {
        d.kstart = (q0 & ~63) - 128 + it * 64; d.stride = INW; d.rope = true; d.maskf = true;
        if (d.kstart < 0 || d.kstart >= 4096) return false;
        d.kptr = Zs + (size_t)d.kstart * INW + Z_K + kvh * 64; d.vptr = d.kptr + 128; return true;
    }
    d.kstart = (it - 5) * 64; d.kptr = CKb + (size_t)d.kstart * 128 + kvh * 64; d.vptr = d.kptr + 262144; d.stride = 128; return true;
}
DEVINL void attn_unit(const Params& p, int chunk, int layer, int unit, char* smem) {
    const int t = tid(), lane = t & 63, w = t >> 6, fr = lane & 15, fq = lane >> 4;
    const bool is_ctx = (chunk == 0);
    int seq_base, q0, kvh, bseq = 0;
    if (is_ctx) { seq_base = (unit >> 4) * 256; q0 = ((unit >> 1) & 7) * 32; kvh = unit & 1; }
    else { const int sl = unit >> 8; seq_base = sl * 4096; q0 = ((unit >> 1) & 127) * 32; kvh = unit & 1; bseq = (chunk - 1) * 2 + sl; }
    const int head = kvh * 4 + w;
    const bf16_t* Zs = (const bf16_t*)(p.ws + OFF_Z) + (size_t)seq_base * INW;
    const bf16_t* CKb = (const bf16_t*)(p.ws + OFF_CKV) + (size_t)(bseq * 2 + layer) * 256 * 128;
    const float2* tab = (const float2*)(p.ws + OFF_TAB);
    bf16_t* ACT = (bf16_t*)(p.ws + OFF_ACT);
    char* Ks = smem;
    bf16_t* Vt = (bf16_t*)(smem + 8192);
    constexpr int VS = 68;

    bf16x8 qf[2][2];
#pragma unroll
    for (int qg = 0; qg < 2; ++qg)
#pragma unroll
        for (int dh = 0; dh < 2; ++dh) {
            const int pos = q0 + qg * 16 + fr;
            uint4 u = *(const uint4*)(Zs + (size_t)pos * INW + Z_Q + head * 64 + dh * 32 + fq * 8);
            if (!is_ctx) {
                uint4 pu; pu.x = __shfl_xor((int)u.x, 32); pu.y = __shfl_xor((int)u.y, 32); pu.z = __shfl_xor((int)u.z, 32); pu.w = __shfl_xor((int)u.w, 32);
                float x[8], y[8]; unpack8(u, x); unpack8(pu, y);
                const int pi = dh == 0 ? (pos >> 6) : (pos & 63);
                const float2* tp = tab + pi * 16 + (fq & 1) * 8;
                const float sgn = fq < 2 ? -1.f : 1.f;
#pragma unroll
                for (int e = 0; e < 8; ++e) { const float2 cs = tp[e]; x[e] = x[e] * cs.x + sgn * y[e] * cs.y; }
                u = pack8(x);
            }
            qf[qg][dh] = as_bf16x8(u);
        }
    f32x4 o[2][4];
#pragma unroll
    for (int i = 0; i < 2; ++i)
#pragma unroll
        for (int j = 0; j < 4; ++j) o[i][j] = (f32x4){0.f, 0.f, 0.f, 0.f};
    const float sk2 = p.sink[layer * 8 + head] * 1.4426950408889634f;
    float mrow[2], lsum[2];
#pragma unroll
    for (int i = 0; i < 2; ++i) { mrow[i] = sk2; lsum[i] = fq == 0 ? 1.f : 0.f; }
    const float sc2 = 0.125f * 1.4426950408889634f;

    const int ntiles = is_ctx ? 4 : 9;
    const int key = t >> 2, cp = t & 3, c = (cp & 1) + ((cp >> 1) << 2);
    const int vkp = t & 31, vc = t >> 5;
    AttTile cur; int it = 0;
    while (!att_tile(it, is_ctx, Zs, CKb, q0, kvh, cur)) ++it;
    u32x4 ku1, ku2, vu0, vu1; float2 cs[8];
#define ATT_LOAD(d) { const bf16_t* src = (d).kptr + (size_t)key * (d).stride + c * 8; ku1 = *(const u32x4*)src; ku2 = *(const u32x4*)(src + 16); \
        const bf16_t* vs = (d).vptr + (size_t)(2 * vkp) * (d).stride + vc * 8; vu0 = *(const u32x4*)vs; vu1 = *(const u32x4*)(vs + (d).stride); \
        if ((d).rope) { const int kpos = (d).kstart + key, pi = c < 4 ? (kpos >> 6) : (kpos & 63); const float2* tp = tab + pi * 16 + (c & 1) * 8; \
            _Pragma("unroll") for (int e = 0; e < 8; ++e) cs[e] = tp[e]; } }
    ATT_LOAD(cur);
    for (;;) {
        __syncthreads();
        {
            uint4 u1 = make_uint4(ku1[0], ku1[1], ku1[2], ku1[3]), u2 = make_uint4(ku2[0], ku2[1], ku2[2], ku2[3]);
            if (cur.rope) {
                float x1[8], x2[8], o1[8], o2[8]; unpack8(u1, x1); unpack8(u2, x2);
#pragma unroll
                for (int e = 0; e < 8; ++e) { o1[e] = x1[e] * cs[e].x - x2[e] * cs[e].y; o2[e] = x2[e] * cs[e].x + x1[e] * cs[e].y; }
                u1 = pack8(o1); u2 = pack8(o2);
            }
            *(uint4*)(Ks + key * 128 + ((c ^ (key & 7)) << 4)) = u1;
            *(uint4*)(Ks + key * 128 + (((c + 2) ^ (key & 7)) << 4)) = u2;
            {
                uint32_t* dst = (uint32_t*)(Vt + (vc * 8) * VS + 2 * vkp);
#pragma unroll
                for (int m = 0; m < 4; ++m) {
                    dst[(2 * m) * (VS / 2)] = (vu0[m] & 0xffffu) | (vu1[m] << 16);
                    dst[(2 * m + 1) * (VS / 2)] = (vu0[m] >> 16) | (vu1[m] & 0xffff0000u);
                }
            }
        }
        __syncthreads();
        AttTile nxt; int nit = it + 1; bool have = false;
        while (nit < ntiles) { if (att_tile(nit, is_ctx, Zs, CKb, q0, kvh, nxt)) { have = true; break; } ++nit; }
        if (have) ATT_LOAD(nxt);
        SCHED_FENCE();
        const int kstart = cur.kstart; const bool maskf = cur.maskf;
#pragma unroll 1
        for (int hk = 0; hk < 2; ++hk) {
            bf16x8 kf[2][2], vf[4];
#pragma unroll
            for (int kb = 0; kb < 2; ++kb)
#pragma unroll
                for (int dh = 0; dh < 2; ++dh) { const int row = hk * 32 + kb * 16 + fr; kf[kb][dh] = *(const bf16x8*)(Ks + row * 128 + (((dh * 4 + fq) ^ (row & 7)) << 4)); }
#pragma unroll
            for (int di = 0; di < 4; ++di) {
                const bf16_t* vp = Vt + (di * 16 + fr) * VS + hk * 32 + fq * 4;
                const bf16x4 lo = *(const bf16x4*)vp, hi = *(const bf16x4*)(vp + 16);
                vf[di] = __builtin_shufflevector(lo, hi, 0, 1, 2, 3, 4, 5, 6, 7);
            }
#pragma unroll
            for (int qg = 0; qg < 2; ++qg) {
                f32x4 s[2];
#pragma unroll
                for (int kb = 0; kb < 2; ++kb) {
                    s[kb] = __builtin_amdgcn_mfma_f32_16x16x32_bf16(kf[kb][0], qf[qg][0], (f32x4){0.f, 0.f, 0.f, 0.f}, 0, 0, 0);
                    s[kb] = __builtin_amdgcn_mfma_f32_16x16x32_bf16(kf[kb][1], qf[qg][1], s[kb], 0, 0, 0);
                }
                const int qpos = q0 + qg * 16 + fr;
                float mx = -1e30f;
#pragma unroll
                for (int kb = 0; kb < 2; ++kb)
#pragma unroll
                    for (int j = 0; j < 4; ++j) {
                        float v = s[kb][j] * sc2;
                        if (maskf) { const int d = qpos - (kstart + hk * 32 + kb * 16 + fq * 4 + j); if (d > 128 || d < -128) v = -1e30f; }
                        s[kb][j] = v; mx = fmaxf(mx, v);
                    }
                mx = fmaxf(mx, __shfl_xor(mx, 16)); mx = fmaxf(mx, __shfl_xor(mx, 32));
                const float mn = fmaxf(mrow[qg], mx), alpha = exp2f(mrow[qg] - mn);
                mrow[qg] = mn;
                float ps = 0.f;
#pragma unroll
                for (int kb = 0; kb < 2; ++kb)
#pragma unroll
                    for (int j = 0; j < 4; ++j) { const float pv = exp2f(s[kb][j] - mn); s[kb][j] = pv; ps += pv; }
                lsum[qg] = lsum[qg] * alpha + ps;
#pragma unroll
                for (int di = 0; di < 4; ++di) { o[qg][di][0] *= alpha; o[qg][di][1] *= alpha; o[qg][di][2] *= alpha; o[qg][di][3] *= alpha; }
                uint4 pu; pu.x = pack_bf16(s[0][0], s[0][1]); pu.y = pack_bf16(s[0][2], s[0][3]); pu.z = pack_bf16(s[1][0], s[1][1]); pu.w = pack_bf16(s[1][2], s[1][3]);
                const bf16x8 pf = as_bf16x8(pu);
#pragma unroll
                for (int di = 0; di < 4; ++di) o[qg][di] = __builtin_amdgcn_mfma_f32_16x16x32_bf16(vf[di], pf, o[qg][di], 0, 0, 0);
            }
        }
        if (!have) break;
        cur = nxt; it = nit;
    }
#undef ATT_LOAD
#pragma unroll
    for (int qg = 0; qg < 2; ++qg) {
        float l = lsum[qg]; l += __shfl_xor(l, 16); l += __shfl_xor(l, 32);
        const float inv = 1.f / l;
        const int tok = seq_base + q0 + qg * 16 + fr;
#pragma unroll
        for (int di = 0; di < 4; ++di) {
            const f32x4 v = o[qg][di];
            *(uint2*)(ACT + (size_t)tok * ACTW + 768 + head * 64 + di * 16 + fq * 4) = make_uint2(pack_bf16(v[0] * inv, v[1] * inv), pack_bf16(v[2] * inv, v[3] * inv));
        }
    }
}

DEVINL void conva_tile(const Params& p, int chunk, int l, int tile, char* smem) {
    const int t = tid(), lane = t & 63, w = t >> 6;
    const int S = chunk == 0 ? 256 : 4096;
    const int tok0 = tile * 32, pos0 = tok0 % S, sb = tok0 - pos0;
    const bf16_t* Z = (const bf16_t*)(p.ws + OFF_Z);
    bf16_t* ACT = (bf16_t*)(p.ws + OFF_ACT);
    float* glu = (float*)smem;
    {
        const int chk = t & 31, r0 = t >> 5;
#pragma unroll
        for (int h = 0; h < 2; ++h) {
            uint4 a[4], b[4];
#pragma unroll
            for (int i = 0; i < 4; ++i) {
                const int r = r0 + 8 * (h * 4 + i), pos = pos0 - 15 + r, pc = min(max(pos, 0), S - 1);
                const bf16_t* src = Z + (size_t)(sb + pc) * INW + chk * 8;
                a[i] = *(const uint4*)(src + Z_AVAL); b[i] = *(const uint4*)(src + Z_AGATE);
            }
            SCHED_FENCE();
#pragma unroll
            for (int i = 0; i < 4; ++i) {
                const int r = r0 + 8 * (h * 4 + i), pos = pos0 - 15 + r;
                if (r < 62) {
                    const float keep = (pos >= 0 && pos < S) ? 1.f : 0.f;
                    float av[8], bv[8], g[8]; unpack8(a[i], av); unpack8(b[i], bv);
#pragma unroll
                    for (int e = 0; e < 8; ++e) g[e] = keep * av[e] * sigmoidf_(bv[e]);
                    float4* d = (float4*)(glu + r * 256 + chk * 8);
                    d[0] = make_float4(g[0], g[1], g[2], g[3]); d[1] = make_float4(g[4], g[5], g[6], g[7]);
                }
            }
        }
    }
    __syncthreads();
    {
        float wv[31];
#pragma unroll
        for (int k = 0; k < 31; ++k) wv[k] = p.w_conv_a[((size_t)l * 31 + k) * 256 + t];
        const float bias = p.b_conv_a[l * 256 + t];
        for (int i = 0; i < 32; ++i) {
            float s = bias;
#pragma unroll
            for (int k = 0; k < 31; ++k) s += wv[k] * glu[(i + k) * 256 + t];
            glu[i * 256 + t] = s;
        }
    }
    __syncthreads();
    {
        const float4 g = *(const float4*)(p.ln_g_a + l * 256 + lane * 4), b = *(const float4*)(p.ln_b_a + l * 256 + lane * 4);
#pragma unroll
        for (int i = 0; i < 8; ++i) {
            const int r = w * 8 + i;
            const float4 v = *(const float4*)(glu + r * 256 + lane * 4);
            const float mu = wave_sum(v.x + v.y + v.z + v.w) * (1.f / 256.f);
            const float d0 = v.x - mu, d1 = v.y - mu, d2 = v.z - mu, d3 = v.w - mu;
            const float var = wave_sum(d0 * d0 + d1 * d1 + d2 * d2 + d3 * d3) * (1.f / 256.f);
            const float rs = rsqrtf(var + EPS);
            float y0 = d0 * rs * g.x + b.x, y1 = d1 * rs * g.y + b.y, y2 = d2 * rs * g.z + b.z, y3 = d3 * rs * g.w + b.w;
            y0 *= sigmoidf_(y0); y1 *= sigmoidf_(y1); y2 *= sigmoidf_(y2); y3 *= sigmoidf_(y3);
            *(uint2*)(ACT + (size_t)(tok0 + r) * ACTW + 0 + lane * 4) = make_uint2(pack_bf16(y0, y1), pack_bf16(y2, y3));
        }
    }
}
DEVINL void pool_tile(const Params& p, int chunk, int l, int tile, char* smem) {
    const int t = tid();
    const int S = chunk == 0 ? 256 : 4096;
    const int tok0 = tile * 32, pos0 = tok0 % S, sb = tok0 - pos0;
    const bf16_t* Z = (const bf16_t*)(p.ws + OFF_Z);
    bf16_t* ACT = (bf16_t*)(p.ws + OFF_ACT);
    float* u = (float*)smem;
    {
        const int chk = t & 31, r0 = t >> 5;
        uint4 av[6];
#pragma unroll
        for (int i = 0; i < 6; ++i) { const int pos = pos0 - 8 + r0 + 8 * i, pc = min(max(pos, 0), S - 1); av[i] = *(const uint4*)(Z + (size_t)(sb + pc) * INW + Z_POOL + chk * 8); }
        SCHED_FENCE();
#pragma unroll
        for (int i = 0; i < 6; ++i) {
            const int r = r0 + 8 * i, pos = pos0 - 8 + r;
            float g[8]; unpack8(av[i], g);
            const float keep = (pos >= 0 && pos < S) ? 1.f : 0.f;
            float4* d = (float4*)(u + r * 256 + chk * 8);
            d[0] = make_float4(g[0] * keep, g[1] * keep, g[2] * keep, g[3] * keep); d[1] = make_float4(g[4] * keep, g[5] * keep, g[6] * keep, g[7] * keep);
        }
    }
    __syncthreads();
    const int gi = t >> 6, w2 = 1 << gi;
    for (int i = 0; i < 32; ++i) {
        const int pos = pos0 + i;
        float s = 0.f;
        for (int j = -w2; j < w2; ++j) s += u[(i + 8 + j) * 256 + t];
        const int lo = max(pos - w2, 0), hi = min(pos + w2, S);
        const float pooled = s / (float)(hi - lo) - u[(i + 8) * 256 + t];
        u[i * 256 + t] = pooled;
    }
    __syncthreads();
    float acc[32];
#pragma unroll
    for (int i = 0; i < 32; ++i) acc[i] = 0.f;
    const float* wp = p.w_pool + ((size_t)l * 4 + gi) * 4096 + (t & 63);
#pragma unroll 1
    for (int c0 = 0; c0 < 64; c0 += 16) {
        float wv[16];
#pragma unroll
        for (int c = 0; c < 16; ++c) wv[c] = wp[(c0 + c) * 64];
#pragma unroll
        for (int c = 0; c < 16; ++c) {
            const float* up = u + gi * 64 + c0 + c;
#pragma unroll
            for (int i = 0; i < 32; ++i) acc[i] += up[i * 256] * wv[c];
        }
    }
    const float ps = p.pool_scale[l * 256 + t];
#pragma unroll
    for (int i = 0; i < 32; ++i) {
        const float v = acc[i] * ps;
        ACT[(size_t)(tok0 + i) * ACTW + 256 + t] = (bf16_t)(pack_bf16(v, 0.f) & 0xffff);
    }
}
DEVINL void convc_tile(const Params& p, int chunk, int l, int tile) {
    const int t = tid();
    const int S = chunk == 0 ? 256 : 4096;
    const bf16_t* Z = (const bf16_t*)(p.ws + OFF_Z);
    bf16_t* ACT = (bf16_t*)(p.ws + OFF_ACT);
#pragma unroll 1
    for (int i = 0; i < 4; ++i) {
        const int item = i * 256 + t, chk = item & 31, tok = tile * 32 + (item >> 5), pos = tok % S;
        const bf16_t* zr = Z + (size_t)tok * INW + chk * 8;
        float uu[3][8];
#pragma unroll
        for (int j = 0; j < 3; ++j) {
            const int pp = pos + j - 1;
            if (pp >= 0 && pp < S) {
                const uint4 a = *(const uint4*)(zr + (j - 1) * INW + Z_SC), b = *(const uint4*)(zr + (j - 1) * INW + Z_SH);
                float av[8], bv[8]; unpack8(a, av); unpack8(b, bv);
#pragma unroll
                for (int e = 0; e < 8; ++e) uu[j][e] = av[e] * bv[e];
            } else {
#pragma unroll
                for (int e = 0; e < 8; ++e) uu[j][e] = 0.f;
            }
        }
        const uint4 sbv = *(const uint4*)(zr + Z_SB);
        float sbf[8], r[8]; unpack8(sbv, sbf);
        const float* wc = p.w_sc + (size_t)l * 768 + chk * 8;
#pragma unroll
        for (int e = 0; e < 8; ++e) r[e] = sbf[e] * (wc[e] * uu[0][e] + wc[256 + e] * uu[1][e] + wc[512 + e] * uu[2][e]);
        *(uint4*)(ACT + (size_t)tok * ACTW + 512 + chk * 8) = pack8(r);
    }
}
DEVINL void phase_branch(const Params& p, int chunk, int l, char* smem) {
    for (int tile = blockIdx.x; tile < 1280; tile += gridDim.x) {
        if (tile < 512) attn_unit(p, chunk, l, tile, smem);
        else if (tile < 768) conva_tile(p, chunk, l, tile - 512, smem);
        else if (tile < 1024) pool_tile(p, chunk, l, tile - 768, smem);
        else convc_tile(p, chunk, l, tile - 1024);
        __syncthreads();
    }
}

#define XB_TMO      128
#define XB_XCNT(j)  (256  + 64 * (j))
#define XB_XSUB(j)  (1280 + 64 * (j))
#define XB_XGEN(j)  (2304 + 64 * (j))
#define XB_TOP      3328
#define XB_TOPGEN   3392
#define XB_SPIN_CAP (1u << 20)
DEVINL unsigned xb_ld(unsigned* p) { return __hip_atomic_load(p, __ATOMIC_RELAXED, __HIP_MEMORY_SCOPE_AGENT); }
DEVINL unsigned xb_add(unsigned* p, unsigned v) { return __hip_atomic_fetch_add(p, v, __ATOMIC_RELAXED, __HIP_MEMORY_SCOPE_AGENT); }
DEVINL unsigned xb_xcc_id() { return (unsigned)__builtin_amdgcn_s_getreg((3 << 11) | 20) & 0xFu; }
#define XB_SPIN(cond, bar) do { unsigned _sp = 0; while (cond) { __builtin_amdgcn_s_sleep(1); \
    if ((++_sp & 255u) == 0u) { if (xb_ld(&(bar)[XB_TMO])) break; if (_sp > XB_SPIN_CAP) { atomicAdd(&(bar)[XB_TMO], 1u); break; } } } } while (0)
struct XcdBar { unsigned* bar; unsigned x, nloc, nx; };
DEVINL void xb_census(unsigned* bar, unsigned x, unsigned& nloc, unsigned& nx) {
    const unsigned G = gridDim.x;
    unsigned sum, cnt, mine, sp = 0u;
    for (;;) {
        sum = 0u; cnt = 0u; mine = 0u;
#pragma unroll
        for (unsigned j = 0; j < 16; ++j) { const unsigned c = xb_ld(&bar[XB_XCNT(j)]); sum += c; cnt += (c > 0u) ? 1u : 0u; mine = (j == x) ? c : mine; }
        if (sum == G) break;
        __builtin_amdgcn_s_sleep(1);
        if ((++sp & 255u) == 0u) { if (xb_ld(&bar[XB_TMO])) break; if (sp > XB_SPIN_CAP) { atomicAdd(&bar[XB_TMO], 1u); break; } }
    }
    nloc = mine > 0u ? mine : 1u; nx = cnt > 0u ? cnt : 1u;
}
DEVINL void gsync(XcdBar& b) {
    asm volatile("s_waitcnt vmcnt(0)" ::: "memory");
    __syncthreads();
    if (threadIdx.x == 0) {
        unsigned* bar = b.bar;
        __builtin_amdgcn_s_waitcnt(0);
        if (b.nloc == 0u) xb_census(bar, b.x, b.nloc, b.nx);
        const unsigned nloc = b.nloc, nx = b.nx;
        const unsigned old = xb_add(&bar[XB_XSUB(b.x)], 1u);
        const unsigned gen = old / nloc;
        if (old + 1u == (gen + 1u) * nloc) {
            __builtin_amdgcn_fence(__ATOMIC_RELEASE, "agent");
            asm volatile("s_waitcnt vmcnt(0)" ::: "memory");
            const unsigned og = xb_add(&bar[XB_TOP], 1u);
            const unsigned tg = og / nx;
            if (og + 1u == (tg + 1u) * nx) xb_add(&bar[XB_TOPGEN], 1u);
            else XB_SPIN(xb_ld(&bar[XB_TOPGEN]) == tg, bar);
            __builtin_amdgcn_fence(__ATOMIC_ACQUIRE, "agent");
            xb_add(&bar[XB_XGEN(b.x)], 1u);
            asm volatile("s_waitcnt vmcnt(0)" ::: "memory");
        } else {
            XB_SPIN(xb_ld(&bar[XB_XGEN(b.x)]) == gen, bar);
            __builtin_amdgcn_fence(__ATOMIC_ACQUIRE, "agent");
            asm volatile("s_waitcnt vmcnt(0)" ::: "memory");
        }
    }
    __syncthreads();
}
__global__ void __launch_bounds__(256, 2) mega(Params p) {
    __shared__ __attribute__((aligned(16))) char smem[65536];
    cg::grid_group grid = cg::this_grid();
    grid.sync();
    XcdBar xb; xb.bar = (unsigned*)(p.ws + OFF_BAR); xb.x = xb_xcc_id(); xb.nloc = 0u; xb.nx = 0u;
    if (threadIdx.x == 0) (void)xb_add(&xb.bar[XB_XCNT(xb.x)], 1u);
#pragma unroll 1
    for (int step = 0; step < NSTEPS; ++step) {
        int ph, ch = 0, l = 0;
        if (step == 0) ph = 8;
        else if (step == 1) ph = 9;
        else { const int s = step - 2; ch = s >> 4; const int r = s & 15; l = r >> 3; ph = r & 7; }
        const bf16_t* WT = (const bf16_t*)(p.ws + OFF_WT) + (size_t)l * W_LAYER;
        const bf16_t* H = (const bf16_t*)(p.ws + OFF_H);
        int kind = 0;
        GemmDesc g; g.A = H; g.W = WT; g.lda = LDH; g.ldb = LW1; g.K = D; g.nN = 8; g.epi = 1; g.l = l; g.chunk = ch;
        int rp_mode = 1, rp_which = 1, rp_hsel = 0, rp_lh = l;
        switch (ph) {
            case 8: kind = 3; break;
            case 9: kind = 1; rp_mode = 0; rp_hsel = 1; rp_lh = 0; break;
            case 0: g.W = WT + WO_IN; g.nN = 50; g.epi = 0; break;
            case 1: kind = 2; break;
            case 2: g.A = (const bf16_t*)(p.ws + OFF_ACT); g.lda = ACTW; g.W = WT + WO_A; g.ldb = LWM; g.K = 1280; g.epi = 3; break;
            case 3: g.W = WT + WO_O; break;
            case 4: kind = 1; rp_which = 1; rp_hsel = 2; break;
            case 5: g.W = WT + WO_F1; g.nN = 32; g.epi = 2; break;
            case 6: g.A = (const bf16_t*)(p.ws + OFF_HID); g.lda = LDHID; g.W = WT + WO_F2; g.ldb = LW4; g.K = DFF; break;
            default: kind = 1; rp_which = 2; rp_hsel = (l == 0) ? 1 : 0; rp_lh = 1; break;
        }
        if (kind == 0) phase_gemm_any(p, g, smem);
        else if (kind == 1) {
            const int nrep = (ph == 7 && l == 1 && ch < 2) ? 2 : 1;
#pragma unroll 1
            for (int rep = 0; rep < nrep; ++rep) {
                if (rep == 1) { ch += 1; rp_mode = 0; rp_which = 1; rp_hsel = 1; rp_lh = 0; }
                rowpass(p, ch, rp_mode, l, rp_which, rp_hsel, rp_lh);
            }
        }
        else if (kind == 2) phase_branch(p, ch, l, smem);
        else phase_prep(p, smem);
        gsync(xb);
    }
}

extern "C" void kernel_launch(void* const* d_in, const int* in_sizes, int n_in, void* d_out, int out_size, void* d_ws, size_t ws_size, hipStream_t stream) {
    static int grid_blocks = 0;
    if (!grid_blocks) {
        int dev = 0, cus = 0, per_cu = 0;
        (void)hipGetDevice(&dev);
        (void)hipDeviceGetAttribute(&cus, hipDeviceAttributeMultiprocessorCount, dev);
        (void)hipOccupancyMaxActiveBlocksPerMultiprocessor(&per_cu, mega, 256, 0);
        if (per_cu > 2) per_cu = 2;
        if (per_cu < 1) per_cu = 1;
        grid_blocks = cus * per_cu;
    }
    Params p{};
    const float** pp = (const float**)&p;
    for (int i = 0; i < 28; ++i) pp[i] = (const float*)d_in[i];
    p.out = (float*)d_out;
    p.ws = (char*)d_ws;
    (void)hipMemsetAsync((char*)d_ws + OFF_BAR, 0, 16384, stream);
    void* args[] = {&p};
    hipError_t e = hipLaunchCooperativeKernel((void*)mega, dim3(grid_blocks), dim3(256), args, 0, stream);
    if (e != hipSuccess) fprintf(stderr, "cooperative launch failed: %s (grid %d)\n", hipGetErrorString(e), grid_blocks);
}
```

```cpp
#include <hip/hip_runtime.h>
#include <hip/hip_cooperative_groups.h>
#include <stdint.h>
#include <cstdio>
namespace cg = cooperative_groups;

typedef unsigned short bf16_t;
typedef short bf16x8 __attribute__((ext_vector_type(8)));
typedef short bf16x4 __attribute__((ext_vector_type(4)));
typedef float f32x4 __attribute__((ext_vector_type(4)));
typedef unsigned u32x4 __attribute__((ext_vector_type(4)));
#define DEVINL __device__ __forceinline__

constexpr int D = 1024, INW = 6400, CH = 8192  , ACTW = 1344  , DFF = 4096;
constexpr int LDH = 1088, LDHID = 4160, LW1 = 1088, LWM = 1344, LW4 = 4160;
constexpr int Z_AVAL = 0, Z_AGATE = 256, Z_POOL = 512, Z_SB = 768, Z_SC = 1024, Z_SH = 1280, Z_Q = 1536, Z_K = 2048, Z_V = 2176, Z_G = 2304;
constexpr float EPS = 1e-6f;
#ifndef NSTEPS
#define NSTEPS 50
#endif
constexpr size_t WO_IN = 0, WO_A = WO_IN + (size_t)6400 * LW1, WO_O = WO_A + (size_t)1024 * LWM, WO_F1 = WO_O + (size_t)1024 * LW1, WO_F2 = WO_F1 + (size_t)4096 * LW1,
                 W_LAYER = WO_F2 + (size_t)1024 * LW4;
constexpr size_t OFF_WT = 0, OFF_MOD = OFF_WT + 2 * W_LAYER * 2, OFF_CKV = OFF_MOD + 2 * 5 * 6144 * 4, OFF_TAB = OFF_CKV + 2 * 262144 * 2,
                 OFF_H = OFF_TAB + 8192, OFF_ACT = OFF_H + (size_t)CH * LDH * 2, OFF_Z = OFF_ACT + (size_t)CH * ACTW * 2,
                 OFF_MF = OFF_Z, OFF_HID = OFF_Z + (size_t)CH * D * 4, OFF_BAR = OFF_Z + (size_t)CH * INW * 2;
constexpr size_t OUT_K = 25165824, OUT_V = 27262976;

struct Params {
    const float *x_prompt, *x_sample, *cache_k, *cache_v, *c, *c_ctx, *w_ada, *b_ada, *g_pre_mix, *g_post_mix, *g_pre_ffn, *g_post_ffn, *w_in,
        *w_conv_a, *b_conv_a, *ln_g_a, *ln_b_a, *w_a_out, *w_pool, *pool_scale, *w_b_out, *w_sc, *w_c_out, *sink, *w_d_out, *w_o, *w_ff1, *w_ff2;
    float* out;
    char* ws;
};

DEVINL int tid() { int t = threadIdx.x; asm volatile("" : "+v"(t)); return t; }
DEVINL float bf_lo(uint32_t u) { return __uint_as_float(u << 16); }
DEVINL float bf_hi(uint32_t u) { return __uint_as_float(u & 0xffff0000u); }
typedef __bf16 bf16x2_t __attribute__((ext_vector_type(2)));
typedef float f32x2_t __attribute__((ext_vector_type(2)));
DEVINL uint32_t pack_bf16(float lo, float hi) { const f32x2_t v = {lo, hi}; const bf16x2_t b = __builtin_convertvector(v, bf16x2_t); return __builtin_bit_cast(uint32_t, b); }
DEVINL void unpack8(const uint4& u, float (&f)[8]) {
    f[0] = bf_lo(u.x); f[1] = bf_hi(u.x); f[2] = bf_lo(u.y); f[3] = bf_hi(u.y); f[4] = bf_lo(u.z); f[5] = bf_hi(u.z); f[6] = bf_lo(u.w); f[7] = bf_hi(u.w);
}
DEVINL uint4 pack8(const float (&f)[8]) { uint4 u; u.x = pack_bf16(f[0], f[1]); u.y = pack_bf16(f[2], f[3]); u.z = pack_bf16(f[4], f[5]); u.w = pack_bf16(f[6], f[7]); return u; }
DEVINL float sigmoidf_(float x) { return 1.f / (1.f + __expf(-x)); }
DEVINL float wave_sum(float v) {
#pragma unroll
    for (int o = 32; o > 0; o >>= 1) v += __shfl_xor(v, o);
    return v;
}
DEVINL bf16x8 as_bf16x8(const uint4& u) { union { uint4 a; bf16x8 b; } x; x.a = u; return x.b; }

#define SCHED_FENCE() __builtin_amdgcn_sched_barrier(0)
template <bool FKK>
DEVINL void gemm_compute(const char* cur, int aoff, int boff, int fq, int sw, f32x4 (&acc)[4][4]) {
#pragma unroll
    for (int kk = 0; kk < 2; ++kk) {
        if (FKK) SCHED_FENCE();
        bf16x8 af[4], bfr[4];
        const int co = ((kk * 4 + fq) ^ sw) << 4;
#pragma unroll
        for (int i = 0; i < 4; ++i) { af[i] = *(const bf16x8*)(cur + aoff + i * 2048 + co); bfr[i] = *(const bf16x8*)(cur + boff + i * 2048 + co); }
        __builtin_amdgcn_s_setprio(1);
#pragma unroll
        for (int mi = 0; mi < 4; ++mi)
#pragma unroll
            for (int ni = 0; ni < 4; ++ni) acc[mi][ni] = __builtin_amdgcn_mfma_f32_16x16x32_bf16(bfr[ni], af[mi], acc[mi][ni], 0, 0, 0);
        __builtin_amdgcn_s_setprio(0);
    }
}
struct NoHook { DEVINL void operator()(int, f32x4 (&)[4][4]) const {} };
template <int DEPTH, class Hook = NoHook>
DEVINL void gemm_loop(const bf16_t* __restrict__ A, int lda, const bf16_t* __restrict__ B, int ldb, int K, char* smem, f32x4 (&acc)[4][4], const Hook& hook = Hook()) {
    const int t = tid(), lane = t & 63, w = t >> 6, wm = w >> 1, wn = w & 1, fr = lane & 15, fq = lane >> 4;
    const int sc = t & 7, sr = t >> 3;
    const bf16_t* ag = A + (size_t)sr * lda + sc * 8;
    const bf16_t* bg = B + (size_t)sr * ldb + sc * 8;
    const int soff = sr * 128 + ((sc ^ ((sr >> 1) & 7)) << 4);
    const int aoff = (wm * 64 + fr) * 128, boff = 16384 + (wn * 64 + fr) * 128, sw = (fr >> 1) & 7;
    const int nk = K >> 6;
    u32x4 r0a[4], r0b[4], r1a[4], r1b[4];
#define G_LOAD(RA, RB, KT) { _Pragma("unroll") for (int i = 0; i < 4; ++i) { RA[i] = *(const u32x4*)(ag + (size_t)i * 32 * lda + (KT) * 64); RB[i] = *(const u32x4*)(bg + (size_t)i * 32 * ldb + (KT) * 64); } }
#define G_STORE(RA, RB, BUF) { _Pragma("unroll") for (int i = 0; i < 4; ++i) { *(u32x4*)(smem + (BUF) * 32768 + soff + i * 4096) = RA[i]; *(u32x4*)(smem + (BUF) * 32768 + 16384 + soff + i * 4096) = RB[i]; } }
    G_LOAD(r0a, r0b, 0);
    G_LOAD(r1a, r1b, 1);
    SCHED_FENCE();
    __syncthreads();
    G_STORE(r0a, r0b, 0);
    __syncthreads();
    for (int kt = 0; kt < nk; kt += 2) {
        G_LOAD(r0a, r0b, min(kt + 2, nk - 1));
        SCHED_FENCE();
        gemm_compute<false>(smem, aoff, boff, fq, sw, acc);
        SCHED_FENCE();
        G_STORE(r1a, r1b, 1);
        __syncthreads();
        G_LOAD(r1a, r1b, min(kt + 3, nk - 1));
        SCHED_FENCE();
        gemm_compute<false>(smem + 32768, aoff, boff, fq, sw, acc);
        SCHED_FENCE();
        hook(kt + 1, acc);
        G_STORE(r0a, r0b, 0);
        __syncthreads();
    }
#undef G_LOAD
#undef G_STORE
}
#define LAS3 __attribute__((address_space(3)))
template <class Hook = NoHook>
DEVINL void gemm_loop_dma(const bf16_t* __restrict__ A, int lda, const bf16_t* __restrict__ B, int ldb, int K, char* smem, f32x4 (&acc)[4][4], const Hook& hook,
                          const bf16_t* An, const bf16_t* Bn, bool pre) {
    const int t = tid(), lane = t & 63, w = __builtin_amdgcn_readfirstlane(t >> 6)  , wm = w >> 1, wn = w & 1, fr = lane & 15, fq = lane >> 4;
    const int sc = t & 7, sr = t >> 3;
    const int srp = 8 * ((sr & 15) >> 2) + 4 * (sr >> 4) + (sr & 3);
    const unsigned voA = (unsigned)(sr * lda + ((sc ^ ((sr >> 1) & 7)) << 3)) * 2u, voB = (unsigned)(srp * ldb + ((sc ^ ((sr >> 1) & 7)) << 3)) * 2u;
    const __amdgpu_buffer_rsrc_t srdA = __builtin_amdgcn_make_buffer_rsrc((void*)A, (short)0, 0x7fffffff, 0x00020000);
    const __amdgpu_buffer_rsrc_t srdB = __builtin_amdgcn_make_buffer_rsrc((void*)B, (short)0, 0x7fffffff, 0x00020000);
    const int aoff = (wm * 64 + fr) * 128, boff = 16384 + (wn * 64 + fr) * 128, sw = (fr >> 1) & 7;
    const int nk = K >> 6;
    LAS3 char* lds = (LAS3 char*)smem;
    const unsigned ldsb = (unsigned)__builtin_amdgcn_readfirstlane((int)(unsigned)(unsigned long)lds) + (unsigned)w * 1024u;
    const int stepA = 32 * lda * 2, stepB = 32 * ldb * 2;
#define D_ONE(SRD, VO, SOFF, M0V) asm volatile("s_mov_b32 m0, %0\n\ts_nop 0\n\tbuffer_load_dwordx4 %1, %2, %3 offen lds" :: "s"(M0V), "v"(VO), "s"(SRD), "s"(SOFF) : "m0", "memory")
#define D_ISSUE(BUF, KT) { _Pragma("unroll") for (int i = 0; i < 4; ++i) { \
        D_ONE(srdA, voA, (KT) * 128 + i * stepA, ldsb + (BUF) * 32768 + i * 4096); \
        D_ONE(srdB, voB, (KT) * 128 + i * stepB, ldsb + (BUF) * 32768 + 16384 + i * 4096); } }
#define D_WAIT() { asm volatile("s_waitcnt vmcnt(0)" ::: "memory"); __builtin_amdgcn_s_barrier(); asm volatile("" ::: "memory"); }
    if (!pre) D_ISSUE(0, 0);
    D_WAIT();
    for (int kt = 0; kt < nk; kt += 2) {
        D_ISSUE(1, kt + 1);
        SCHED_FENCE();
        gemm_compute<false>(smem, aoff, boff, fq, sw, acc);
        SCHED_FENCE();
        D_WAIT();
        if (kt + 2 < nk) D_ISSUE(0, kt + 2)
        else if (An) {
            const __amdgpu_buffer_rsrc_t srdA2 = __builtin_amdgcn_make_buffer_rsrc((void*)An, (short)0, 0x7fffffff, 0x00020000);
            const __amdgpu_buffer_rsrc_t srdB2 = __builtin_amdgcn_make_buffer_rsrc((void*)Bn, (short)0, 0x7fffffff, 0x00020000);
#pragma unroll
            for (int i = 0; i < 4; ++i) { D_ONE(srdA2, voA, i * stepA, ldsb + i * 4096); D_ONE(srdB2, voB, i * stepB, ldsb + 16384 + i * 4096); }
        }
        SCHED_FENCE();
        gemm_compute<false>(smem + 32768, aoff, boff, fq, sw, acc);
        SCHED_FENCE();
        hook(kt + 1, acc);
        if (kt + 2 < nk) D_WAIT();
    }
#undef D_ISSUE
#undef D_ONE
#undef D_WAIT
}
DEVINL void gemm_loop1(const bf16_t* __restrict__ A, int lda, const bf16_t* __restrict__ B, int ldb, int K, char* smem, f32x4 (&acc)[4][4]) {
    const int t = tid(), lane = t & 63, w = t >> 6, wm = w >> 1, wn = w & 1, fr = lane & 15, fq = lane >> 4;
    const int sc = t & 7, sr = t >> 3;
    const bf16_t* ag = A + (size_t)sr * lda + sc * 8;
    const bf16_t* bg = B + (size_t)sr * ldb + sc * 8;
    const int soff = sr * 128 + ((sc ^ ((sr >> 1) & 7)) << 4);
    u32x4 ra[4], rb[4];
    const int nk = K >> 6;
#pragma unroll
    for (int i = 0; i < 4; ++i) { ra[i] = *(const u32x4*)(ag + (size_t)i * 32 * lda); rb[i] = *(const u32x4*)(bg + (size_t)i * 32 * ldb); }
    __syncthreads();
#pragma unroll
    for (int i = 0; i < 4; ++i) { *(u32x4*)(smem + soff + i * 4096) = ra[i]; *(u32x4*)(smem + 16384 + soff + i * 4096) = rb[i]; }
    __syncthreads();
    const int aoff = (wm * 64 + fr) * 128, boff = 16384 + (wn * 64 + fr) * 128, sw = (fr >> 1) & 7;
    for (int kt = 0; kt < nk; ++kt) {
        const char* cur = smem + (kt & 1) * 32768;
        if (kt + 1 < nk) {
#pragma unroll
            for (int i = 0; i < 4; ++i) { ra[i] = *(const u32x4*)(ag + (size_t)i * 32 * lda + (kt + 1) * 64); rb[i] = *(const u32x4*)(bg + (size_t)i * 32 * ldb + (kt + 1) * 64); }
        }
        gemm_compute<false>(cur, aoff, boff, fq, sw, acc);
        if (kt + 1 < nk) {
            char* nxt = smem + ((kt + 1) & 1) * 32768;
#pragma unroll
            for (int i = 0; i < 4; ++i) { *(u32x4*)(nxt + soff + i * 4096) = ra[i]; *(u32x4*)(nxt + 16384 + soff + i * 4096) = rb[i]; }
        }
        __syncthreads();
    }
}
DEVINL void zero_acc(f32x4 (&acc)[4][4]) {
#pragma unroll
    for (int i = 0; i < 4; ++i)
#pragma unroll
        for (int j = 0; j < 4; ++j) acc[i][j] = (f32x4){0.f, 0.f, 0.f, 0.f};
}
DEVINL void tile_order(int t, int nN, int& pm, int& pn) { const int g = t / (8 * nN), r = t % (8 * nN); pn = r >> 3; pm = g * 8 + (r & 7); }
struct TileWalk {
    int nN, i, x, j, nb; bool xcd;
    DEVINL void init(int nN_) { nN = nN_; i = 0; xcd = (gridDim.x & 7) == 0; x = blockIdx.x & 7; j = blockIdx.x >> 3; nb = gridDim.x >> 3; }
    DEVINL bool next(int& pm, int& pn) {
        if (xcd) { const int s = i * nb + j; ++i; if (s >= 8 * nN) return false; pn = s >> 3; pm = x * 8 + (s & 7); return true; }
        const int t = blockIdx.x + i * gridDim.x; ++i; if (t >= 64 * nN) return false; tile_order(t, nN, pm, pn); return true;
    }
};

DEVINL void wt_tile2(const float* __restrict__ src, int K, int N, bf16_t* __restrict__ dst, int ldd, int tile0, char* smem) {
    const int nNt = N >> 6, t = tid();
    float* tl = (float*)smem;
    const int r = t >> 4, c4 = t & 15;
    f32x4 v[2][4];
#pragma unroll
    for (int u = 0; u < 2; ++u) {
        const int tile = tile0 + u, k0 = (tile / nNt) * 64, n0 = (tile % nNt) * 64;
#pragma unroll
        for (int i = 0; i < 4; ++i) v[u][i] = *(const f32x4*)(src + (size_t)(k0 + r + 16 * i) * N + n0 + c4 * 4);
    }
    asm volatile("" : "+v"(v[0][0]), "+v"(v[0][1]), "+v"(v[0][2]), "+v"(v[0][3]), "+v"(v[1][0]), "+v"(v[1][1]), "+v"(v[1][2]), "+v"(v[1][3]));
#pragma unroll
    for (int u = 0; u < 2; ++u)
#pragma unroll
        for (int i = 0; i < 4; ++i) { float* q = tl + u * 4160 + (r + 16 * i) * 65 + c4 * 4; q[0] = v[u][i][0]; q[1] = v[u][i][1]; q[2] = v[u][i][2]; q[3] = v[u][i][3]; }
    __syncthreads();
    const int n = t >> 2, kq = t & 3;
#pragma unroll
    for (int u = 0; u < 2; ++u) {
        const int tile = tile0 + u, k0 = (tile / nNt) * 64, n0 = (tile % nNt) * 64;
        uint32_t pk[8];
#pragma unroll
        for (int e = 0; e < 8; ++e) pk[e] = pack_bf16(tl[u * 4160 + (kq * 16 + 2 * e) * 65 + n], tl[u * 4160 + (kq * 16 + 2 * e + 1) * 65 + n]);
        uint4* o = (uint4*)(dst + (size_t)(n0 + n) * ldd + k0 + kq * 16);
        o[0] = make_uint4(pk[0], pk[1], pk[2], pk[3]); o[1] = make_uint4(pk[4], pk[5], pk[6], pk[7]);
    }
    __syncthreads();
}
DEVINL void mod_tile(const Params& p, int tile, char* smem) {
    const int l = tile / 96, n0 = (tile % 96) * 64, t = tid(), kg = t >> 6, col = t & 63;
    float* sl = (float*)smem;
    float* red = sl + 5 * 1024;
    for (int i = t; i < 5 * 1024; i += 256) { const int cb = i >> 10, k = i & 1023; const float x = cb == 0 ? p.c_ctx[k] : p.c[(cb - 1) * 1024 + k]; sl[i] = x * sigmoidf_(x); }
    __syncthreads();
    float a0 = 0.f, a1 = 0.f, a2 = 0.f, a3 = 0.f, a4 = 0.f;
    const float* wp = p.w_ada + ((size_t)l * 1024 + kg * 256) * 6144 + n0 + col;
#pragma unroll 1
    for (int k0 = 0; k0 < 256; k0 += 32) {
        float wv[32];
#pragma unroll
        for (int k = 0; k < 32; ++k) wv[k] = wp[(size_t)(k0 + k) * 6144];
        SCHED_FENCE();
#pragma unroll
        for (int k = 0; k < 32; ++k) {
            const int kk = kg * 256 + k0 + k;
            a0 += sl[kk] * wv[k]; a1 += sl[1024 + kk] * wv[k]; a2 += sl[2048 + kk] * wv[k]; a3 += sl[3072 + kk] * wv[k]; a4 += sl[4096 + kk] * wv[k];
        }
    }
    red[(kg * 5 + 0) * 64 + col] = a0; red[(kg * 5 + 1) * 64 + col] = a1; red[(kg * 5 + 2) * 64 + col] = a2; red[(kg * 5 + 3) * 64 + col] = a3; red[(kg * 5 + 4) * 64 + col] = a4;
    __syncthreads();
    float* mod = (float*)(p.ws + OFF_MOD);
    for (int i = t; i < 320; i += 256) {
        const int cb = i >> 6, cc = i & 63;
        const float s = red[(0 * 5 + cb) * 64 + cc] + red[(1 * 5 + cb) * 64 + cc] + red[(2 * 5 + cb) * 64 + cc] + red[(3 * 5 + cb) * 64 + cc];
        mod[((size_t)l * 5 + cb) * 6144 + n0 + cc] = s + p.b_ada[l * 6144 + n0 + cc];
    }
    __syncthreads();
}
DEVINL void phase_prep(const Params& p, char* smem) {
    const int t = tid();
    bf16_t* WT = (bf16_t*)(p.ws + OFF_WT);
    constexpr int NMOD = 192, NW = 4224  , NC = 256, NT = NMOD + NW + NC + 1;
    for (int tile = blockIdx.x; tile < NT; tile += gridDim.x) {
        if (tile < NMOD) mod_tile(p, tile, smem);
        else if (tile < NMOD + NW) {
            int wt = (tile - NMOD) * 2; const int l = wt / 4224; wt -= l * 4224;
            const float* src; int K, N, ldd; size_t dofs;
            if (wt < 1600) { src = p.w_in + (size_t)l * 1024 * 6400; K = 1024; N = 6400; ldd = LW1; dofs = WO_IN; }
            else if (wt < 1664) { wt -= 1600; src = p.w_a_out + (size_t)l * 256 * 1024; K = 256; N = 1024; ldd = LWM; dofs = WO_A; }
            else if (wt < 1728) { wt -= 1664; src = p.w_b_out + (size_t)l * 256 * 1024; K = 256; N = 1024; ldd = LWM; dofs = WO_A + 256; }
            else if (wt < 1792) { wt -= 1728; src = p.w_c_out + (size_t)l * 256 * 1024; K = 256; N = 1024; ldd = LWM; dofs = WO_A + 512; }
            else if (wt < 1920) { wt -= 1792; src = p.w_d_out + (size_t)l * 512 * 1024; K = 512; N = 1024; ldd = LWM; dofs = WO_A + 768; }
            else if (wt < 2176) { wt -= 1920; src = p.w_o + (size_t)l * 1024 * 1024; K = 1024; N = 1024; ldd = LW1; dofs = WO_O; }
            else if (wt < 3200) { wt -= 2176; src = p.w_ff1 + (size_t)l * 1024 * 4096; K = 1024; N = 4096; ldd = LW1; dofs = WO_F1; }
            else { wt -= 3200; src = p.w_ff2 + (size_t)l * 4096 * 1024; K = 4096; N = 1024; ldd = LW4; dofs = WO_F2; }
            wt_tile2(src, K, N, WT + (size_t)l * W_LAYER + dofs, ldd, wt, smem);
        } else if (tile < NMOD + NW + NC) {
            const int i = (tile - NMOD - NW) * 256 + t;
            const float* src = (i < 32768) ? p.cache_k + (size_t)i * 8 : p.cache_v + (size_t)(i - 32768) * 8;
            const float4 a = *(const float4*)src, b = *(const float4*)(src + 4);
            uint4 o; o.x = pack_bf16(a.x, a.y); o.y = pack_bf16(a.z, a.w); o.z = pack_bf16(b.x, b.y); o.w = pack_bf16(b.z, b.w);
            *(uint4*)(p.ws + OFF_CKV + (size_t)i * 16) = o;
        } else {
            float2* tab = (float2*)(p.ws + OFF_TAB);
            for (int i = t; i < 1024; i += 256) {
                const int pos = i >> 4, fi = i & 15;
                const float freq = exp2f(-(float)fi * (13.287712379549449f / 16.f));
                const float ang = (float)pos * freq;
                tab[i] = make_float2(__cosf(ang), __sinf(ang));
            }
        }
    }
}

DEVINL void rowpass(const Params& p, int chunk, int mode, int lpost, int which_post, int hsel, int lh) {
    const int lane = tid() & 63, w = tid() >> 6;
    const float* mod = (const float*)(p.ws + OFF_MOD);
    const bf16_t* MF = (const bf16_t*)(p.ws + OFF_MF);
    bf16_t* H = (bf16_t*)(p.ws + OFF_H);
    const float* xin = chunk == 0 ? p.x_prompt : p.x_sample + (size_t)(chunk - 1) * CH * D;
    float* xres = p.out + (size_t)chunk * CH * D;
    const float* xsrc = mode == 0 ? xin : xres;
    const float* gpost = which_post == 1 ? p.g_post_mix + lpost * D : p.g_post_ffn + lpost * D;
    const float* gpre = hsel == 1 ? p.g_pre_mix + lh * D : p.g_pre_ffn + lh * D;
    for (int base = (blockIdx.x * 4 + w) * 4; base < CH; base += gridDim.x * 16) {
        const int cb = chunk == 0 ? 0 : 1 + (chunk - 1) * 2 + (base >> 12);
        float pg[16], hg[16], hs[16];
        if (mode == 1) {
            const float* gate = mod + ((size_t)lpost * 5 + cb) * 6144 + (which_post == 1 ? 2 : 5) * 1024;
            float4 gp[4], gt[4];
#pragma unroll
            for (int i = 0; i < 4; ++i) { const int c = i * 256 + lane * 4; gp[i] = *(const float4*)(gpost + c); gt[i] = *(const float4*)(gate + c); }
            SCHED_FENCE();
#pragma unroll
            for (int i = 0; i < 4; ++i) { pg[4 * i] = gp[i].x * gt[i].x; pg[4 * i + 1] = gp[i].y * gt[i].y; pg[4 * i + 2] = gp[i].z * gt[i].z; pg[4 * i + 3] = gp[i].w * gt[i].w; }
        }
        if (hsel) {
            const float* mb = mod + ((size_t)lh * 5 + cb) * 6144 + (hsel == 1 ? 0 : 3) * 1024;
            float4 g[4], sh[4], sc[4];
#pragma unroll
            for (int i = 0; i < 4; ++i) { const int c = i * 256 + lane * 4; g[i] = *(const float4*)(gpre + c); sh[i] = *(const float4*)(mb + c); sc[i] = *(const float4*)(mb + 1024 + c); }
            SCHED_FENCE();
#pragma unroll
            for (int i = 0; i < 4; ++i) {
                hg[4 * i] = g[i].x * (1.f + sc[i].x); hg[4 * i + 1] = g[i].y * (1.f + sc[i].y); hg[4 * i + 2] = g[i].z * (1.f + sc[i].z); hg[4 * i + 3] = g[i].w * (1.f + sc[i].w);
                hs[4 * i] = sh[i].x; hs[4 * i + 1] = sh[i].y; hs[4 * i + 2] = sh[i].z; hs[4 * i + 3] = sh[i].w;
            }
        }
#pragma unroll 1
        for (int pr = 0; pr < 2; ++pr) {
            const int row0 = base + pr * 2;
            float x[2][16], m[2][16];
#pragma unroll
            for (int r = 0; r < 2; ++r)
#pragma unroll
                for (int i = 0; i < 4; ++i) {
                    const size_t o = (size_t)(row0 + r) * D + i * 256 + lane * 4;
                    const float4 v = *(const float4*)(xsrc + o);
                    x[r][4 * i] = v.x; x[r][4 * i + 1] = v.y; x[r][4 * i + 2] = v.z; x[r][4 * i + 3] = v.w;
                    if (mode == 1) { const uint2 q = *(const uint2*)(MF + o); m[r][4 * i] = bf_lo(q.x); m[r][4 * i + 1] = bf_hi(q.x); m[r][4 * i + 2] = bf_lo(q.y); m[r][4 * i + 3] = bf_hi(q.y); }
                }
            SCHED_FENCE();
#pragma unroll
            for (int r = 0; r < 2; ++r) {
                if (mode == 1) {
                    float ss = 0.f;
#pragma unroll
                    for (int i = 0; i < 16; ++i) ss += m[r][i] * m[r][i];
                    ss = wave_sum(ss);
                    const float rs = rsqrtf(ss * (1.f / D) + EPS);
#pragma unroll
                    for (int i = 0; i < 16; ++i) x[r][i] += (m[r][i] * rs) * pg[i];
                }
#pragma unroll
                for (int i = 0; i < 4; ++i) *(float4*)(xres + (size_t)(row0 + r) * D + i * 256 + lane * 4) = make_float4(x[r][4 * i], x[r][4 * i + 1], x[r][4 * i + 2], x[r][4 * i + 3]);
                if (hsel) {
                    float ss = 0.f;
#pragma unroll
                    for (int i = 0; i < 16; ++i) ss += x[r][i] * x[r][i];
                    ss = wave_sum(ss);
                    const float rs = rsqrtf(ss * (1.f / D) + EPS);
#pragma unroll
                    for (int i = 0; i < 4; ++i) {
                        const float h0 = x[r][4 * i] * rs * hg[4 * i] + hs[4 * i], h1 = x[r][4 * i + 1] * rs * hg[4 * i + 1] + hs[4 * i + 1];
                        const float h2 = x[r][4 * i + 2] * rs * hg[4 * i + 2] + hs[4 * i + 2], h3 = x[r][4 * i + 3] * rs * hg[4 * i + 3] + hs[4 * i + 3];
                        *(uint2*)(H + (size_t)(row0 + r) * LDH + i * 256 + lane * 4) = make_uint2(pack_bf16(h0, h1), pack_bf16(h2, h3));
                    }
                }
            }
        }
    }
}

DEVINL void unpack8u(const uint4& u, float (&f)[8]) { unpack8(u, f); }
struct MergeHook {
    const bf16_t* zg;
    bool on;
    DEVINL void operator()(int k, f32x4 (&acc)[4][4]) const {
        if (!on || (k & 3) != 3 || k > 11) return;
        const int b = k >> 2;
        const bf16_t* z = zg + b * 1024;
        uint4 ga[4][2], gb[4][2];
#pragma unroll
        for (int mi = 0; mi < 4; ++mi)
#pragma unroll
            for (int q = 0; q < 2; ++q) { ga[mi][q] = *(const uint4*)(z + (size_t)mi * 16 * INW + q * 32); gb[mi][q] = *(const uint4*)(z + 1024 + (size_t)mi * 16 * INW + q * 32); }
        SCHED_FENCE();
#pragma unroll
        for (int mi = 0; mi < 4; ++mi)
#pragma unroll
            for (int q = 0; q < 2; ++q) {
                float a[8], bb[8]; unpack8(ga[mi][q], a); unpack8(gb[mi][q], bb);
#pragma unroll
                for (int e = 0; e < 8; ++e) acc[mi][2 * q + (e >> 2)][e & 3] *= (1.f + __expf(-bb[e])) * __builtin_amdgcn_rcpf(1.f + __expf(-a[e]));
            }
    }
};
struct GemmDesc { const bf16_t* A; const bf16_t* W; int lda, ldb, K, nN, epi, l, chunk; };
DEVINL void phase_gemm_any(const Params& p, const GemmDesc& g, char* smem) {
    const int lane = tid() & 63, w = tid() >> 6, wm = w >> 1, wn = w & 1, fr = lane & 15, fq = lane >> 4;
    bf16_t* Z = (bf16_t*)(p.ws + OFF_Z);
    bf16_t* MF = (bf16_t*)(p.ws + OFF_MF);
    bf16_t* HID = (bf16_t*)(p.ws + OFF_HID);
    bf16_t* MG = (bf16_t*)(p.ws + OFF_H);
    TileWalk tw; tw.init(g.nN);
    int pm, pn, pm2 = 0, pn2 = 0;
    bool have = tw.next(pm, pn), pre = false;
    for (; have; pm = pm2, pn = pn2) {
        const bool have2 = tw.next(pm2, pn2);
        f32x4 acc[4][4]; zero_acc(acc);
        const int row0 = pm * 128 + wm * 64 + fr, col0 = pn * 128 + wn * 64 + fq * 8;
        MergeHook hook; hook.on = (g.epi == 3); hook.zg = Z + (size_t)row0 * INW + Z_G + col0;
        gemm_loop_dma(g.A + (size_t)pm * 128 * g.lda, g.lda, g.W + (size_t)pn * 128 * g.ldb, g.ldb, g.K, smem, acc, hook,
                      have2 ? g.A + (size_t)pm2 * 128 * g.lda : nullptr, have2 ? g.W + (size_t)pn2 * 128 * g.ldb : nullptr, pre);
        pre = have2; have = have2;
        if (g.epi == 0) {
            const bool kv = (g.chunk == 0) && (pn == 16 || pn == 17);
            bf16_t* zo = Z + (size_t)row0 * INW + col0;
            asm volatile("" : "+v"(zo));
#pragma unroll
            for (int mi = 0; mi < 4; ++mi)
#pragma unroll
                for (int q = 0; q < 2; ++q) {
                    const f32x4 v0 = acc[mi][2 * q], v1 = acc[mi][2 * q + 1];
                    *(uint4*)(zo + (size_t)mi * 16 * INW + q * 32) = make_uint4(pack_bf16(v0[0], v0[1]), pack_bf16(v0[2], v0[3]), pack_bf16(v1[0], v1[1]), pack_bf16(v1[2], v1[3]));
                    if (kv) {
                        const int row = row0 + mi * 16, cl = wn * 64 + q * 32 + fq * 8;
                        float* dst = p.out + (pn == 16 ? OUT_K : OUT_V) + ((size_t)((row >> 8) * 2 + g.l) * 256 + (row & 255)) * 128 + cl;
                        *(f32x4*)dst = v0; *(f32x4*)(dst + 4) = v1;
                    }
                }
        } else if (g.epi == 1) {
            bf16_t* mo = MF + (size_t)row0 * D + col0;
            asm volatile("" : "+v"(mo));
#pragma unroll
            for (int mi = 0; mi < 4; ++mi)
#pragma unroll
                for (int q = 0; q < 2; ++q) {
                    const f32x4 v0 = acc[mi][2 * q], v1 = acc[mi][2 * q + 1];
                    *(uint4*)(mo + (size_t)mi * 16 * D + q * 32) = make_uint4(pack_bf16(v0[0], v0[1]), pack_bf16(v0[2], v0[3]), pack_bf16(v1[0], v1[1]), pack_bf16(v1[2], v1[3]));
                }
        } else if (g.epi == 2) {
            bf16_t* ho = HID + (size_t)row0 * LDHID + col0;
            asm volatile("" : "+v"(ho));
#pragma unroll
            for (int mi = 0; mi < 4; ++mi)
#pragma unroll
                for (int q = 0; q < 2; ++q) {
                    float r[8];
#pragma unroll
                    for (int e = 0; e < 8; ++e) { const float x = fmaxf(acc[mi][2 * q + (e >> 2)][e & 3], 0.f); r[e] = x * x; }
                    *(uint4*)(ho + (size_t)mi * 16 * LDHID + q * 32) = pack8(r);
                }
        } else {
            const bf16_t* z3 = hook.zg + 3 * 1024;
            bf16_t* mg = MG + (size_t)row0 * LDH + col0;
            uint4 g3[4][2];
#pragma unroll
            for (int mi = 0; mi < 4; ++mi)
#pragma unroll
                for (int q = 0; q < 2; ++q) g3[mi][q] = *(const uint4*)(z3 + (size_t)mi * 16 * INW + q * 32);
            SCHED_FENCE();
#pragma unroll
            for (int mi = 0; mi < 4; ++mi)
#pragma unroll
                for (int q = 0; q < 2; ++q) {
                    float gg[8], r[8]; unpack8(g3[mi][q], gg);
#pragma unroll
                    for (int e = 0; e < 8; ++e) r[e] = acc[mi][2 * q + (e >> 2)][e & 3] * sigmoidf_(gg[e]);
                    *(uint4*)(mg + (size_t)mi * 16 * LDH + q * 32) = pack8(r);
                }
        }
    }
}

struct AttTile { const bf16_t* kptr; const bf16_t* vptr; int stride, kstart; bool rope, maskf; };
DEVINL bool att_tile(int it, bool is_ctx, const bf16_t* Zs, const bf16_t* CKb, int q0, int kvh, AttTile& d) {
    d.rope = false; d.maskf = false;
    if (is_ctx) { d.kstart = it * 64; d.kptr = Zs + (size_t)d.kstart * INW + Z_K + kvh * 64; d.vptr = d.kptr + 128; d.stride = INW; return true; }
    if (it < 5) {
        d.kstart = (q0 & ~63) - 128 + it * 64; d.stride = INW; d.rope = true; d.maskf = true;
        if (d.kstart < 0 || d.kstart >= 4096) return false;
        d.kptr = Zs + (size_t)d.kstart * INW + Z_K + kvh * 64; d.vptr = d.kptr + 128; return true;
    }
    d.kstart = (it - 5) * 64; d.kptr = CKb + (size_t)d.kstart * 128 + kvh * 64; d.vptr = d.kptr + 262144; d.stride = 128; return true;
}
DEVINL void attn_unit(const Params& p, int chunk, int layer, int unit, char* smem) {
    const int t = tid(), lane = t & 63, w = t >> 6, fr = lane & 15, fq = lane >> 4;
    const bool is_ctx = (chunk == 0);
    int seq_base, q0, kvh, bseq = 0;
    if (is_ctx) { seq_base = (unit >> 4) * 256; q0 = ((unit >> 1) & 7) * 32; kvh = unit & 1; }
    else { const int sl = unit >> 8; seq_base = sl * 4096; q0 = ((unit >> 1) & 127) * 32; kvh = unit & 1; bseq = (chunk - 1) * 2 + sl; }
    const int head = kvh * 4 + w;
    const bf16_t* Zs = (const bf16_t*)(p.ws + OFF_Z) + (size_t)seq_base * INW;
    const bf16_t* CKb = (const bf16_t*)(p.ws + OFF_CKV) + (size_t)(bseq * 2 + layer) * 256 * 128;
    const float2* tab = (const float2*)(p.ws + OFF_TAB);
    bf16_t* ACT = (bf16_t*)(p.ws + OFF_ACT);
    char* Ks = smem;
    bf16_t* Vt = (bf16_t*)(smem + 8192);
    constexpr int VS = 68;

    bf16x8 qf[2][2];
#pragma unroll
    for (int qg = 0; qg < 2; ++qg)
#pragma unroll
        for (int dh = 0; dh < 2; ++dh) {
            const int pos = q0 + qg * 16 + fr;
            uint4 u = *(const uint4*)(Zs + (size_t)pos * INW + Z_Q + head * 64 + dh * 32 + fq * 8);
            if (!is_ctx) {
                uint4 pu; pu.x = __shfl_xor((int)u.x, 32); pu.y = __shfl_xor((int)u.y, 32); pu.z = __shfl_xor((int)u.z, 32); pu.w = __shfl_xor((int)u.w, 32);
                float x[8], y[8]; unpack8(u, x); unpack8(pu, y);
                const int pi = dh == 0 ? (pos >> 6) : (pos & 63);
                const float2* tp = tab + pi * 16 + (fq & 1) * 8;
                const float sgn = fq < 2 ? -1.f : 1.f;
#pragma unroll
                for (int e = 0; e < 8; ++e) { const float2 cs = tp[e]; x[e] = x[e] * cs.x + sgn * y[e] * cs.y; }
                u = pack8(x);
            }
            qf[qg][dh] = as_bf16x8(u);
        }
    f32x4 o[2][4];
#pragma unroll
    for (int i = 0; i < 2; ++i)
#pragma unroll
        for (int j = 0; j < 4; ++j) o[i][j] = (f32x4){0.f, 0.f, 0.f, 0.f};
    const float sk2 = p.sink[layer * 8 + head] * 1.4426950408889634f;
    float mrow[2], lsum[2];
#pragma unroll
    for (int i = 0; i < 2; ++i) { mrow[i] = sk2; lsum[i] = fq == 0 ? 1.f : 0.f; }
    const float sc2 = 0.125f * 1.4426950408889634f;

    const int ntiles = is_ctx ? 4 : 9;
    const int key = t >> 2, cp = t & 3, c = (cp & 1) + ((cp >> 1) << 2);
    const int vkp = t & 31, vc = t >> 5;
    AttTile cur; int it = 0;
    while (!att_tile(it, is_ctx, Zs, CKb, q0, kvh, cur)) ++it;
    u32x4 ku1, ku2, vu0, vu1; float2 cs[8];
#define ATT_LOAD(d) { const bf16_t* src = (d).kptr + (size_t)key * (d).stride + c * 8; ku1 = *(const u32x4*)src; ku2 = *(const u32x4*)(src + 16); \
        const bf16_t* vs = (d).vptr + (size_t)(2 * vkp) * (d).stride + vc * 8; vu0 = *(const u32x4*)vs; vu1 = *(const u32x4*)(vs + (d).stride); \
        if ((d).rope) { const int kpos = (d).kstart + key, pi = c < 4 ? (kpos >> 6) : (kpos & 63); const float2* tp = tab + pi * 16 + (c & 1) * 8; \
            _Pragma("unroll") for (int e = 0; e < 8; ++e) cs[e] = tp[e]; } }
    ATT_LOAD(cur);
    for (;;) {
        __syncthreads();
        {
            uint4 u1 = make_uint4(ku1[0], ku1[1], ku1[2], ku1[3]), u2 = make_uint4(ku2[0], ku2[1], ku2[2], ku2[3]);
            if (cur.rope) {
                float x1[8], x2[8], o1[8], o2[8]; unpack8(u1, x1); unpack8(u2, x2);
#pragma unroll
                for (int e = 0; e < 8; ++e) { o1[e] = x1[e] * cs[e].x - x2[e] * cs[e].y; o2[e] = x2[e] * cs[e].x + x1[e] * cs[e].y; }
                u1 = pack8(o1); u2 = pack8(o2);
            }
            *(uint4*)(Ks + key * 128 + ((c ^ (key & 7)) << 4)) = u1;
            *(uint4*)(Ks + key * 128 + (((c + 2) ^ (key & 7)) << 4)) = u2;
            {
                uint32_t* dst = (uint32_t*)(Vt + (vc * 8) * VS + 2 * vkp);
#pragma unroll
                for (int m = 0; m < 4; ++m) {
                    dst[(2 * m) * (VS / 2)] = (vu0[m] & 0xffffu) | (vu1[m] << 16);
                    dst[(2 * m + 1) * (VS / 2)] = (vu0[m] >> 16) | (vu1[m] & 0xffff0000u);
                }
            }
        }
        __syncthreads();
        AttTile nxt; int nit = it + 1; bool have = false;
        while (nit < ntiles) { if (att_tile(nit, is_ctx, Zs, CKb, q0, kvh, nxt)) { have = true; break; } ++nit; }
        if (have) ATT_LOAD(nxt);
        SCHED_FENCE();
        const int kstart = cur.kstart; const bool maskf = cur.maskf;
#pragma unroll 1
        for (int hk = 0; hk < 2; ++hk) {
            bf16x8 kf[2][2], vf[4];
#pragma unroll
            for (int kb = 0; kb < 2; ++kb)
#pragma unroll
                for (int dh = 0; dh < 2; ++dh) { const int row = hk * 32 + kb * 16 + fr; kf[kb][dh] = *(const bf16x8*)(Ks + row * 128 + (((dh * 4 + fq) ^ (row & 7)) << 4)); }
#pragma unroll
            for (int di = 0; di < 4; ++di) {
                const bf16_t* vp = Vt + (di * 16 + fr) * VS + hk * 32 + fq * 4;
                const bf16x4 lo = *(const bf16x4*)vp, hi = *(const bf16x4*)(vp + 16);
                vf[di] = __builtin_shufflevector(lo, hi, 0, 1, 2, 3, 4, 5, 6, 7);
            }
#pragma unroll
            for (int qg = 0; qg < 2; ++qg) {
                f32x4 s[2];
#pragma unroll
                for (int kb = 0; kb < 2; ++kb) {
                    s[kb] = __builtin_amdgcn_mfma_f32_16x16x32_bf16(kf[kb][0], qf[qg][0], (f32x4){0.f, 0.f, 0.f, 0.f}, 0, 0, 0);
                    s[kb] = __builtin_amdgcn_mfma_f32_16x16x32_bf16(kf[kb][1], qf[qg][1], s[kb], 0, 0, 0);
                }
                const int qpos = q0 + qg * 16 + fr;
                float mx = -1e30f;
#pragma unroll
                for (int kb = 0; kb < 2; ++kb)
#pragma unroll
                    for (int j = 0; j < 4; ++j) {
                        float v = s[kb][j] * sc2;
                        if (maskf) { const int d = qpos - (kstart + hk * 32 + kb * 16 + fq * 4 + j); if (d > 128 || d < -128) v = -1e30f; }
                        s[kb][j] = v; mx = fmaxf(mx, v);
                    }
                mx = fmaxf(mx, __shfl_xor(mx, 16)); mx = fmaxf(mx, __shfl_xor(mx, 32));
                const float mn = fmaxf(mrow[qg], mx), alpha = exp2f(mrow[qg] - mn);
                mrow[qg] = mn;
                float ps = 0.f;
#pragma unroll
                for (int kb = 0; kb < 2; ++kb)
#pragma unroll
                    for (int j = 0; j < 4; ++j) { const float pv = exp2f(s[kb][j] - mn); s[kb][j] = pv; ps += pv; }
                lsum[qg] = lsum[qg] * alpha + ps;
#pragma unroll
                for (int di = 0; di < 4; ++di) { o[qg][di][0] *= alpha; o[qg][di][1] *= alpha; o[qg][di][2] *= alpha; o[qg][di][3] *= alpha; }
                uint4 pu; pu.x = pack_bf16(s[0][0], s[0][1]); pu.y = pack_bf16(s[0][2], s[0][3]); pu.z = pack_bf16(s[1][0], s[1][1]); pu.w = pack_bf16(s[1][2], s[1][3]);
                const bf16x8 pf = as_bf16x8(pu);
#pragma unroll
                for (int di = 0; di < 4; ++di) o[qg][di] = __builtin_amdgcn_mfma_f32_16x16x32_bf16(vf[di], pf, o[qg][di], 0, 0, 0);
            }
        }
        if (!have) break;
        cur = nxt; it = nit;
    }
#undef ATT_LOAD
#pragma unroll
    for (int qg = 0; qg < 2; ++qg) {
        float l = lsum[qg]; l += __shfl_xor(l, 16); l += __shfl_xor(l, 32);
        const float inv = 1.f / l;
        const int tok = seq_base + q0 + qg * 16 + fr;
#pragma unroll
        for (int di = 0; di < 4; ++di) {
            const f32x4 v = o[qg][di];
            *(uint2*)(ACT + (size_t)tok * ACTW + 768 + head * 64 + di * 16 + fq * 4) = make_uint2(pack_bf16(v[0] * inv, v[1] * inv), pack_bf16(v[2] * inv, v[3] * inv));
        }
    }
}

DEVINL void conva_tile(const Params& p, int chunk, int l, int tile, char* smem) {
    const int t = tid(), lane = t & 63, w = t >> 6;
    const int S = chunk == 0 ? 256 : 4096;
    const int tok0 = tile * 32, pos0 = tok0 % S, sb = tok0 - pos0;
    const bf16_t* Z = (const bf16_t*)(p.ws + OFF_Z);
    bf16_t* ACT = (bf16_t*)(p.ws + OFF_ACT);
    float* glu = (float*)smem;
    {
        const int chk = t & 31, r0 = t >> 5;
#pragma unroll
        for (int h = 0; h < 2; ++h) {
            uint4 a[4], b[4];
#pragma unroll
            for (int i = 0; i < 4; ++i) {
                const int r = r0 + 8 * (h * 4 + i), pos = pos0 - 15 + r, pc = min(max(pos, 0), S - 1);
                const bf16_t* src = Z + (size_t)(sb + pc) * INW + chk * 8;
                a[i] = *(const uint4*)(src + Z_AVAL); b[i] = *(const uint4*)(src + Z_AGATE);
            }
            SCHED_FENCE();
#pragma unroll
            for (int i = 0; i < 4; ++i) {
                const int r = r0 + 8 * (h * 4 + i), pos = pos0 - 15 + r;
                if (r < 62) {
                    const float keep = (pos >= 0 && pos < S) ? 1.f : 0.f;
                    float av[8], bv[8], g[8]; unpack8(a[i], av); unpack8(b[i], bv);
#pragma unroll
                    for (int e = 0; e < 8; ++e) g[e] = keep * av[e] * sigmoidf_(bv[e]);
                    float4* d = (float4*)(glu + r * 256 + chk * 8);
                    d[0] = make_float4(g[0], g[1], g[2], g[3]); d[1] = make_float4(g[4], g[5], g[6], g[7]);
                }
            }
        }
    }
    __syncthreads();
    {
        float wv[31];
#pragma unroll
        for (int k = 0; k < 31; ++k) wv[k] = p.w_conv_a[((size_t)l * 31 + k) * 256 + t];
        const float bias = p.b_conv_a[l * 256 + t];
        for (int i = 0; i < 32; ++i) {
            float s = bias;
#pragma unroll
            for (int k = 0; k < 31; ++k) s += wv[k] * glu[(i + k) * 256 + t];
            glu[i * 256 + t] = s;
        }
    }
    __syncthreads();
    {
        const float4 g = *(const float4*)(p.ln_g_a + l * 256 + lane * 4), b = *(const float4*)(p.ln_b_a + l * 256 + lane * 4);
#pragma unroll
        for (int i = 0; i < 8; ++i) {
            const int r = w * 8 + i;
            const float4 v = *(const float4*)(glu + r * 256 + lane * 4);
            const float mu = wave_sum(v.x + v.y + v.z + v.w) * (1.f / 256.f);
            const float d0 = v.x - mu, d1 = v.y - mu, d2 = v.z - mu, d3 = v.w - mu;
            const float var = wave_sum(d0 * d0 + d1 * d1 + d2 * d2 + d3 * d3) * (1.f / 256.f);
            const float rs = rsqrtf(var + EPS);
            float y0 = d0 * rs * g.x + b.x, y1 = d1 * rs * g.y + b.y, y2 = d2 * rs * g.z + b.z, y3 = d3 * rs * g.w + b.w;
            y0 *= sigmoidf_(y0); y1 *= sigmoidf_(y1); y2 *= sigmoidf_(y2); y3 *= sigmoidf_(y3);
            *(uint2*)(ACT + (size_t)(tok0 + r) * ACTW + 0 + lane * 4) = make_uint2(pack_bf16(y0, y1), pack_bf16(y2, y3));
        }
    }
}
DEVINL void pool_tile(const Params& p, int chunk, int l, int tile, char* smem) {
    const int t = tid();
    const int S = chunk == 0 ? 256 : 4096;
    const int tok0 = tile * 32, pos0 = tok0 % S, sb = tok0 - pos0;
    const bf16_t* Z = (const bf16_t*)(p.ws + OFF_Z);
    bf16_t* ACT = (bf16_t*)(p.ws + OFF_ACT);
    float* u = (float*)smem;
    {
        const int chk = t & 31, r0 = t >> 5;
        uint4 av[6];
#pragma unroll
        for (int i = 0; i < 6; ++i) { const int pos = pos0 - 8 + r0 + 8 * i, pc = min(max(pos, 0), S - 1); av[i] = *(const uint4*)(Z + (size_t)(sb + pc) * INW + Z_POOL + chk * 8); }
        SCHED_FENCE();
#pragma unroll
        for (int i = 0; i < 6; ++i) {
            const int r = r0 + 8 * i, pos = pos0 - 8 + r;
            float g[8]; unpack8(av[i], g);
            const float keep = (pos >= 0 && pos < S) ? 1.f : 0.f;
            float4* d = (float4*)(u + r * 256 + chk * 8);
            d[0] = make_float4(g[0] * keep, g[1] * keep, g[2] * keep, g[3] * keep); d[1] = make_float4(g[4] * keep, g[5] * keep, g[6] * keep, g[7] * keep);
        }
    }
    __syncthreads();
    const int gi = t >> 6, w2 = 1 << gi;
    for (int i = 0; i < 32; ++i) {
        const int pos = pos0 + i;
        float s = 0.f;
        for (int j = -w2; j < w2; ++j) s += u[(i + 8 + j) * 256 + t];
        const int lo = max(pos - w2, 0), hi = min(pos + w2, S);
        const float pooled = s / (float)(hi - lo) - u[(i + 8) * 256 + t];
        u[i * 256 + t] = pooled;
    }
    __syncthreads();
    float acc[32];
#pragma unroll
    for (int i = 0; i < 32; ++i) acc[i] = 0.f;
    const float* wp = p.w_pool + ((size_t)l * 4 + gi) * 4096 + (t & 63);
#pragma unroll 1
    for (int c0 = 0; c0 < 64; c0 += 16) {
        float wv[16];
#pragma unroll
        for (int c = 0; c < 16; ++c) wv[c] = wp[(c0 + c) * 64];
#pragma unroll
        for (int c = 0; c < 16; ++c) {
            const float* up = u + gi * 64 + c0 + c;
#pragma unroll
            for (int i = 0; i < 32; ++i) acc[i] += up[i * 256] * wv[c];
        }
    }
    const float ps = p.pool_scale[l * 256 + t];
#pragma unroll
    for (int i = 0; i < 32; ++i) {
        const float v = acc[i] * ps;
        ACT[(size_t)(tok0 + i) * ACTW + 256 + t] = (bf16_t)(pack_bf16(v, 0.f) & 0xffff);
    }
}
DEVINL void convc_tile(const Params& p, int chunk, int l, int tile) {
    const int t = tid();
    const int S = chunk == 0 ? 256 : 4096;
    const bf16_t* Z = (const bf16_t*)(p.ws + OFF_Z);
    bf16_t* ACT = (bf16_t*)(p.ws + OFF_ACT);
#pragma unroll 1
    for (int i = 0; i < 4; ++i) {
        const int item = i * 256 + t, chk = item & 31, tok = tile * 32 + (item >> 5), pos = tok % S;
        const bf16_t* zr = Z + (size_t)tok * INW + chk * 8;
        float uu[3][8];
#pragma unroll
        for (int j = 0; j < 3; ++j) {
            const int pp = pos + j - 1;
            if (pp >= 0 && pp < S) {
                const uint4 a = *(const uint4*)(zr + (j - 1) * INW + Z_SC), b = *(const uint4*)(zr + (j - 1) * INW + Z_SH);
                float av[8], bv[8]; unpack8(a, av); unpack8(b, bv);
#pragma unroll
                for (int e = 0; e < 8; ++e) uu[j][e] = av[e] * bv[e];
            } else {
#pragma unroll
                for (int e = 0; e < 8; ++e) uu[j][e] = 0.f;
            }
        }
        const uint4 sbv = *(const uint4*)(zr + Z_SB);
        float sbf[8], r[8]; unpack8(sbv, sbf);
        const float* wc = p.w_sc + (size_t)l * 768 + chk * 8;
#pragma unroll
        for (int e = 0; e < 8; ++e) r[e] = sbf[e] * (wc[e] * uu[0][e] + wc[256 + e] * uu[1][e] + wc[512 + e] * uu[2][e]);
        *(uint4*)(ACT + (size_t)tok * ACTW + 512 + chk * 8) = pack8(r);
    }
}
DEVINL void phase_branch(const Params& p, int chunk, int l, char* smem) {
    for (int tile = blockIdx.x; tile < 1280; tile += gridDim.x) {
        if (tile < 512) attn_unit(p, chunk, l, tile, smem);
        else if (tile < 768) conva_tile(p, chunk, l, tile - 512, smem);
        else if (tile < 1024) pool_tile(p, chunk, l, tile - 768, smem);
        else convc_tile(p, chunk, l, tile - 1024);
        __syncthreads();
    }
}

#define XB_TMO      128
#define XB_XCNT(j)  (256  + 64 * (j))
#define XB_XSUB(j)  (1280 + 64 * (j))
#define XB_XGEN(j)  (2304 + 64 * (j))
#define XB_TOP      3328
#define XB_TOPGEN   3392
#define XB_SPIN_CAP (1u << 20)
DEVINL unsigned xb_ld(unsigned* p) { return __hip_atomic_load(p, __ATOMIC_RELAXED, __HIP_MEMORY_SCOPE_AGENT); }
DEVINL unsigned xb_add(unsigned* p, unsigned v) { return __hip_atomic_fetch_add(p, v, __ATOMIC_RELAXED, __HIP_MEMORY_SCOPE_AGENT); }
DEVINL unsigned xb_xcc_id() { return (unsigned)__builtin_amdgcn_s_getreg((3 << 11) | 20) & 0xFu; }
#define XB_SPIN(cond, bar) do { unsigned _sp = 0; while (cond) { __builtin_amdgcn_s_sleep(1); \
    if ((++_sp & 255u) == 0u) { if (xb_ld(&(bar)[XB_TMO])) break; if (_sp > XB_SPIN_CAP) { atomicAdd(&(bar)[XB_TMO], 1u); break; } } } } while (0)
struct XcdBar { unsigned* bar; unsigned x, nloc, nx; };
DEVINL void xb_census(unsigned* bar, unsigned x, unsigned& nloc, unsigned& nx) {
    const unsigned G = gridDim.x;
    unsigned sum, cnt, mine, sp = 0u;
    for (;;) {
        sum = 0u; cnt = 0u; mine = 0u;
#pragma unroll
        for (unsigned j = 0; j < 16; ++j) { const unsigned c = xb_ld(&bar[XB_XCNT(j)]); sum += c; cnt += (c > 0u) ? 1u : 0u; mine = (j == x) ? c : mine; }
        if (sum == G) break;
        __builtin_amdgcn_s_sleep(1);
        if ((++sp & 255u) == 0u) { if (xb_ld(&bar[XB_TMO])) break; if (sp > XB_SPIN_CAP) { atomicAdd(&bar[XB_TMO], 1u); break; } }
    }
    nloc = mine > 0u ? mine : 1u; nx = cnt > 0u ? cnt : 1u;
}
DEVINL void gsync(XcdBar& b) {
    asm volatile("s_waitcnt vmcnt(0)" ::: "memory");
    __syncthreads();
    if (threadIdx.x == 0) {
        unsigned* bar = b.bar;
        __builtin_amdgcn_s_waitcnt(0);
        if (b.nloc == 0u) xb_census(bar, b.x, b.nloc, b.nx);
        const unsigned nloc = b.nloc, nx = b.nx;
        const unsigned old = xb_add(&bar[XB_XSUB(b.x)], 1u);
        const unsigned gen = old / nloc;
        if (old + 1u == (gen + 1u) * nloc) {
            __builtin_amdgcn_fence(__ATOMIC_RELEASE, "agent");
            asm volatile("s_waitcnt vmcnt(0)" ::: "memory");
            const unsigned og = xb_add(&bar[XB_TOP], 1u);
            const unsigned tg = og / nx;
            if (og + 1u == (tg + 1u) * nx) xb_add(&bar[XB_TOPGEN], 1u);
            else XB_SPIN(xb_ld(&bar[XB_TOPGEN]) == tg, bar);
            __builtin_amdgcn_fence(__ATOMIC_ACQUIRE, "agent");
            xb_add(&bar[XB_XGEN(b.x)], 1u);
            asm volatile("s_waitcnt vmcnt(0)" ::: "memory");
        } else {
            XB_SPIN(xb_ld(&bar[XB_XGEN(b.x)]) == gen, bar);
            __builtin_amdgcn_fence(__ATOMIC_ACQUIRE, "agent");
            asm volatile("s_waitcnt vmcnt(0)" ::: "memory");
        }
    }
    __syncthreads();
}
__global__ void __launch_bounds__(256, 2) mega(Params p) {
    __shared__ __attribute__((aligned(16))) char smem[65536];
    cg::grid_group grid = cg::this_grid();
    grid.sync();
    XcdBar xb; xb.bar = (unsigned*)(p.ws + OFF_BAR); xb.x = xb_xcc_id(); xb.nloc = 0u; xb.nx = 0u;
    if (threadIdx.x == 0) (void)xb_add(&xb.bar[XB_XCNT(xb.x)], 1u);
#pragma unroll 1
    for (int step = 0; step < NSTEPS; ++step) {
        int ph, ch = 0, l = 0;
        if (step == 0) ph = 8;
        else if (step == 1) ph = 9;
        else { const int s = step - 2; ch = s >> 4; const int r = s & 15; l = r >> 3; ph = r & 7; }
        const bf16_t* WT = (const bf16_t*)(p.ws + OFF_WT) + (size_t)l * W_LAYER;
        const bf16_t* H = (const bf16_t*)(p.ws + OFF_H);
        int kind = 0;
        GemmDesc g; g.A = H; g.W = WT; g.lda = LDH; g.ldb = LW1; g.K = D; g.nN = 8; g.epi = 1; g.l = l; g.chunk = ch;
        int rp_mode = 1, rp_which = 1, rp_hsel = 0, rp_lh = l;
        switch (ph) {
            case 8: kind = 3; break;
            case 9: kind = 1; rp_mode = 0; rp_hsel = 1; rp_lh = 0; break;
            case 0: g.W = WT + WO_IN; g.nN = 50; g.epi = 0; break;
            case 1: kind = 2; break;
            case 2: g.A = (const bf16_t*)(p.ws + OFF_ACT); g.lda = ACTW; g.W = WT + WO_A; g.ldb = LWM; g.K = 1280; g.epi = 3; break;
            case 3: g.W = WT + WO_O; break;
            case 4: kind = 1; rp_which = 1; rp_hsel = 2; break;
            case 5: g.W = WT + WO_F1; g.nN = 32; g.epi = 2; break;
            case 6: g.A = (const bf16_t*)(p.ws + OFF_HID); g.lda = LDHID; g.W = WT + WO_F2; g.ldb = LW4; g.K = DFF; break;
            default: kind = 1; rp_which = 2; rp_hsel = (l == 0) ? 1 : 0; rp_lh = 1; break;
        }
        if (kind == 0) phase_gemm_any(p, g, smem);
        else if (kind == 1) {
            const int nrep = (ph == 7 && l == 1 && ch < 2) ? 2 : 1;
#pragma unroll 1
            for (int rep = 0; rep < nrep; ++rep) {
                if (rep == 1) { ch += 1; rp_mode = 0; rp_which = 1; rp_hsel = 1; rp_lh = 0; }
                rowpass(p, ch, rp_mode, l, rp_which, rp_hsel, rp_lh);
            }
        }
        else if (kind == 2) phase_branch(p, ch, l, smem);
        else phase_prep(p, smem);
        gsync(xb);
    }
}

extern "C" void kernel_launch(void* const* d_in, const int* in_sizes, int n_in, void* d_out, int out_size, void* d_ws, size_t ws_size, hipStream_t stream) {
    static int grid_blocks = 0;
    if (!grid_blocks) {
        int dev = 0, cus = 0, per_cu = 0;
        (void)hipGetDevice(&dev);
        (void)hipDeviceGetAttribute(&cus, hipDeviceAttributeMultiprocessorCount, dev);
        (void)hipOccupancyMaxActiveBlocksPerMultiprocessor(&per_cu, mega, 256, 0);
        if (per_cu > 2) per_cu = 2;
        if (per_cu < 1) per_cu = 1;
        grid_blocks = cus * per_cu;
    }
    Params p{};
    const float** pp = (const float**)&p;
    for (int i = 0; i < 28; ++i) pp[i] = (const float*)d_in[i];
    p.out = (float*)d_out;
    p.ws = (char*)d_ws;
    (void)hipMemsetAsync((char*)d_ws + OFF_BAR, 0, 16384, stream);
    void* args[] = {&p};
    hipError_t e = hipLaunchCooperativeKernel((void*)mega, dim3(grid_blocks), dim3(256), args, 0, stream);
    if (e != hipSuccess) fprintf(stderr, "cooperative launch failed: %s (grid %d)\n", hipGetErrorString(e), grid_blocks);
}
```

```cpp
#include <hip/hip_runtime.h>
#include <hip/hip_cooperative_groups.h>
#include <stdint.h>
#include <cstdio>
namespace cg = cooperative_groups;

typedef unsigned short bf16_t;
typedef short bf16x8 __attribute__((ext_vector_type(8)));
typedef short bf16x4 __attribute__((ext_vector_type(4)));
typedef float f32x4 __attribute__((ext_vector_type(4)));
typedef unsigned u32x4 __attribute__((ext_vector_type(4)));
#define DEVINL __device__ __forceinline__

constexpr int D = 1024, INW = 6400, CH = 8192  , ACTW = 1344  , DFF = 4096;
constexpr int LDH = 1088, LDHID = 4160, LW1 = 1088, LWM = 1344, LW4 = 4160;
constexpr int Z_AVAL = 0, Z_AGATE = 256, Z_POOL = 512, Z_SB = 768, Z_SC = 1024, Z_SH = 1280, Z_Q = 1536, Z_K = 2048, Z_V = 2176, Z_G = 2304;
constexpr float EPS = 1e-6f;
#ifndef NSTEPS
#define NSTEPS 50
#endif
constexpr size_t WO_IN = 0, WO_A = WO_IN + (size_t)6400 * LW1, WO_O = WO_A + (size_t)1024 * LWM, WO_F1 = WO_O + (size_t)1024 * LW1, WO_F2 = WO_F1 + (size_t)4096 * LW1,
                 W_LAYER = WO_F2 + (size_t)1024 * LW4;
constexpr size_t OFF_WT = 0, OFF_MOD = OFF_WT + 2 * W_LAYER * 2, OFF_CKV = OFF_MOD + 2 * 5 * 6144 * 4, OFF_TAB = OFF_CKV + 2 * 262144 * 2,
                 OFF_H = OFF_TAB + 8192, OFF_ACT = OFF_H + (size_t)CH * LDH * 2, OFF_Z = OFF_ACT + (size_t)CH * ACTW * 2,
                 OFF_MF = OFF_Z, OFF_HID = OFF_Z + (size_t)CH * D * 4, OFF_BAR = OFF_Z + (size_t)CH * INW * 2;
constexpr size_t OUT_K = 25165824, OUT_V = 27262976;

struct Params {
    const float *x_prompt, *x_sample, *cache_k, *cache_v, *c, *c_ctx, *w_ada, *b_ada, *g_pre_mix, *g_post_mix, *g_pre_ffn, *g_post_ffn, *w_in,
        *w_conv_a, *b_conv_a, *ln_g_a, *ln_b_a, *w_a_out, *w_pool, *pool_scale, *w_b_out, *w_sc, *w_c_out, *sink, *w_d_out, *w_o, *w_ff1, *w_ff2;
    float* out;
    char* ws;
};

DEVINL int tid() { int t = threadIdx.x; asm volatile("" : "+v"(t)); return t; }
DEVINL float bf_lo(uint32_t u) { return __uint_as_float(u << 16); }
DEVINL float bf_hi(uint32_t u) { return __uint_as_float(u & 0xffff0000u); }
typedef __bf16 bf16x2_t __attribute__((ext_vector_type(2)));
typedef float f32x2_t __attribute__((ext_vector_type(2)));
DEVINL uint32_t pack_bf16(float lo, float hi) { const f32x2_t v = {lo, hi}; const bf16x2_t b = __builtin_convertvector(v, bf16x2_t); return __builtin_bit_cast(uint32_t, b); }
DEVINL void unpack8(const uint4& u, float (&f)[8]) {
    f[0] = bf_lo(u.x); f[1] = bf_hi(u.x); f[2] = bf_lo(u.y); f[3] = bf_hi(u.y); f[4] = bf_lo(u.z); f[5] = bf_hi(u.z); f[6] = bf_lo(u.w); f[7] = bf_hi(u.w);
}
DEVINL uint4 pack8(const float (&f)[8]) { uint4 u; u.x = pack_bf16(f[0], f[1]); u.y = pack_bf16(f[2], f[3]); u.z = pack_bf16(f[4], f[5]); u.w = pack_bf16(f[6], f[7]); return u; }
DEVINL float sigmoidf_(float x) { return 1.f / (1.f + __expf(-x)); }
DEVINL float wave_sum(float v) {
#pragma unroll
    for (int o = 32; o > 0; o >>= 1) v += __shfl_xor(v, o);
    return v;
}
DEVINL bf16x8 as_bf16x8(const uint4& u) { union { uint4 a; bf16x8 b; } x; x.a = u; return x.b; }

#define SCHED_FENCE() __builtin_amdgcn_sched_barrier(0)
template <bool FKK>
DEVINL void gemm_compute(const char* cur, int aoff, int boff, int fq, int sw, f32x4 (&acc)[4][4]) {
    bf16x8 af[2][4], bfr[2][4];
    __builtin_amdgcn_s_waitcnt(0xC07F);
#pragma unroll
    for (int kk = 0; kk < 2; ++kk) {
        const int co = ((kk * 4 + fq) ^ sw) << 4;
#pragma unroll
        for (int i = 0; i < 4; ++i) { af[kk][i] = *(const bf16x8*)(cur + aoff + i * 2048 + co); bfr[kk][i] = *(const bf16x8*)(cur + boff + i * 2048 + co); }
    }
    __builtin_amdgcn_s_setprio(1);
#pragma unroll
    for (int kk = 0; kk < 2; ++kk)
#pragma unroll
        for (int mi = 0; mi < 4; ++mi)
#pragma unroll
            for (int ni = 0; ni < 4; ++ni) acc[mi][ni] = __builtin_amdgcn_mfma_f32_16x16x32_bf16(bfr[kk][ni], af[kk][mi], acc[mi][ni], 0, 0, 0);
    __builtin_amdgcn_s_setprio(0);
}
struct NoHook { DEVINL void operator()(int, f32x4 (&)[4][4]) const {} };
template <int DEPTH, class Hook = NoHook>
DEVINL void gemm_loop(const bf16_t* __restrict__ A, int lda, const bf16_t* __restrict__ B, int ldb, int K, char* smem, f32x4 (&acc)[4][4], const Hook& hook = Hook()) {
    const int t = tid(), lane = t & 63, w = t >> 6, wm = w >> 1, wn = w & 1, fr = lane & 15, fq = lane >> 4;
    const int sc = t & 7, sr = t >> 3;
    const bf16_t* ag = A + (size_t)sr * lda + sc * 8;
    const bf16_t* bg = B + (size_t)sr * ldb + sc * 8;
    const int soff = sr * 128 + ((sc ^ ((sr >> 1) & 7)) << 4);
    const int aoff = (wm * 64 + fr) * 128, boff = 16384 + (wn * 64 + fr) * 128, sw = (fr >> 1) & 7;
    const int nk = K >> 6;
    u32x4 r0a[4], r0b[4], r1a[4], r1b[4];
#define G_LOAD(RA, RB, KT) { _Pragma("unroll") for (int i = 0; i < 4; ++i) { RA[i] = *(const u32x4*)(ag + (size_t)i * 32 * lda + (KT) * 64); RB[i] = *(const u32x4*)(bg + (size_t)i * 32 * ldb + (KT) * 64); } }
#define G_STORE(RA, RB, BUF) { _Pragma("unroll") for (int i = 0; i < 4; ++i) { *(u32x4*)(smem + (BUF) * 32768 + soff + i * 4096) = RA[i]; *(u32x4*)(smem + (BUF) * 32768 + 16384 + soff + i * 4096) = RB[i]; } }
    G_LOAD(r0a, r0b, 0);
    G_LOAD(r1a, r1b, 1);
    SCHED_FENCE();
    __syncthreads();
    G_STORE(r0a, r0b, 0);
    __syncthreads();
    for (int kt = 0; kt < nk; kt += 2) {
        G_LOAD(r0a, r0b, min(kt + 2, nk - 1));
        SCHED_FENCE();
        gemm_compute<false>(smem, aoff, boff, fq, sw, acc);
        SCHED_FENCE();
        G_STORE(r1a, r1b, 1);
        __syncthreads();
        G_LOAD(r1a, r1b, min(kt + 3, nk - 1));
        SCHED_FENCE();
        gemm_compute<false>(smem + 32768, aoff, boff, fq, sw, acc);
        SCHED_FENCE();
        hook(kt + 1, acc);
        G_STORE(r0a, r0b, 0);
        __syncthreads();
    }
#undef G_LOAD
#undef G_STORE
}
#define LAS3 __attribute__((address_space(3)))
template <class Hook = NoHook>
DEVINL void gemm_loop_dma(const bf16_t* __restrict__ A, int lda, const bf16_t* __restrict__ B, int ldb, int K, char* smem, f32x4 (&acc)[4][4], const Hook& hook,
                          const bf16_t* An, const bf16_t* Bn, bool pre) {
    const int t = tid(), lane = t & 63, w = __builtin_amdgcn_readfirstlane(t >> 6)  , wm = w >> 1, wn = w & 1, fr = lane & 15, fq = lane >> 4;
    const int sc = t & 7, sr = t >> 3;
    const int srp = 8 * ((sr & 15) >> 2) + 4 * (sr >> 4) + (sr & 3);
    const unsigned voA = (unsigned)(sr * lda + ((sc ^ ((sr >> 1) & 7)) << 3)) * 2u, voB = (unsigned)(srp * ldb + ((sc ^ ((sr >> 1) & 7)) << 3)) * 2u;
    const __amdgpu_buffer_rsrc_t srdA = __builtin_amdgcn_make_buffer_rsrc((void*)A, (short)0, 0x7fffffff, 0x00020000);
    const __amdgpu_buffer_rsrc_t srdB = __builtin_amdgcn_make_buffer_rsrc((void*)B, (short)0, 0x7fffffff, 0x00020000);
    const int aoff = (wm * 64 + fr) * 128, boff = 16384 + (wn * 64 + fr) * 128, sw = (fr >> 1) & 7;
    const int nk = K >> 6;
    LAS3 char* lds = (LAS3 char*)smem;
    const unsigned ldsb = (unsigned)__builtin_amdgcn_readfirstlane((int)(unsigned)(unsigned long)lds) + (unsigned)w * 1024u;
    const int stepA = 32 * lda * 2, stepB = 32 * ldb * 2;
#define D_ONE(SRD, VO, SOFF, M0V) asm volatile("s_mov_b32 m0, %0\n\ts_nop 0\n\tbuffer_load_dwordx4 %1, %2, %3 offen lds" :: "s"(M0V), "v"(VO), "s"(SRD), "s"(SOFF) : "m0", "memory")
#define D_ISSUE(BUF, KT) { _Pragma("unroll") for (int i = 0; i < 4; ++i) { \
        D_ONE(srdA, voA, (KT) * 128 + i * stepA, ldsb + (BUF) * 32768 + i * 4096); \
        D_ONE(srdB, voB, (KT) * 128 + i * stepB, ldsb + (BUF) * 32768 + 16384 + i * 4096); } }
#define D_WAIT() { asm volatile("s_waitcnt vmcnt(0)" ::: "memory"); __builtin_amdgcn_s_barrier(); asm volatile("" ::: "memory"); }
    if (!pre) D_ISSUE(0, 0);
    D_WAIT();
    for (int kt = 0; kt < nk; kt += 2) {
        D_ISSUE(1, kt + 1);
        SCHED_FENCE();
        gemm_compute<false>(smem, aoff, boff, fq, sw, acc);
        SCHED_FENCE();
        D_WAIT();
        if (kt + 2 < nk) D_ISSUE(0, kt + 2)
        else if (An) {
            const __amdgpu_buffer_rsrc_t srdA2 = __builtin_amdgcn_make_buffer_rsrc((void*)An, (short)0, 0x7fffffff, 0x00020000);
            const __amdgpu_buffer_rsrc_t srdB2 = __builtin_amdgcn_make_buffer_rsrc((void*)Bn, (short)0, 0x7fffffff, 0x00020000);
#pragma unroll
            for (int i = 0; i < 4; ++i) { D_ONE(srdA2, voA, i * stepA, ldsb + i * 4096); D_ONE(srdB2, voB, i * stepB, ldsb + 16384 + i * 4096); }
        }
        SCHED_FENCE();
        gemm_compute<false>(smem + 32768, aoff, boff, fq, sw, acc);
        SCHED_FENCE();
        hook(kt + 1, acc);
        if (kt + 2 < nk) D_WAIT();
    }
#undef D_ISSUE
#undef D_ONE
#undef D_WAIT
}
DEVINL void gemm_loop1(const bf16_t* __restrict__ A, int lda, const bf16_t* __restrict__ B, int ldb, int K, char* smem, f32x4 (&acc)[4][4]) {
    const int t = tid(), lane = t & 63, w = t >> 6, wm = w >> 1, wn = w & 1, fr = lane & 15, fq = lane >> 4;
    const int sc = t & 7, sr = t >> 3;
    const bf16_t* ag = A + (size_t)sr * lda + sc * 8;
    const bf16_t* bg = B + (size_t)sr * ldb + sc * 8;
    const int soff = sr * 128 + ((sc ^ ((sr >> 1) & 7)) << 4);
    u32x4 ra[4], rb[4];
    const int nk = K >> 6;
#pragma unroll
    for (int i = 0; i < 4; ++i) { ra[i] = *(const u32x4*)(ag + (size_t)i * 32 * lda); rb[i] = *(const u32x4*)(bg + (size_t)i * 32 * ldb); }
    __syncthreads();
#pragma unroll
    for (int i = 0; i < 4; ++i) { *(u32x4*)(smem + soff + i * 4096) = ra[i]; *(u32x4*)(smem + 16384 + soff + i * 4096) = rb[i]; }
    __syncthreads();
    const int aoff = (wm * 64 + fr) * 128, boff = 16384 + (wn * 64 + fr) * 128, sw = (fr >> 1) & 7;
    for (int kt = 0; kt < nk; ++kt) {
        const char* cur = smem + (kt & 1) * 32768;
        if (kt + 1 < nk) {
#pragma unroll
            for (int i = 0; i < 4; ++i) { ra[i] = *(const u32x4*)(ag + (size_t)i * 32 * lda + (kt + 1) * 64); rb[i] = *(const u32x4*)(bg + (size_t)i * 32 * ldb + (kt + 1) * 64); }
        }
        gemm_compute<false>(cur, aoff, boff, fq, sw, acc);
        if (kt + 1 < nk) {
            char* nxt = smem + ((kt + 1) & 1) * 32768;
#pragma unroll
            for (int i = 0; i < 4; ++i) { *(u32x4*)(nxt + soff + i * 4096) = ra[i]; *(u32x4*)(nxt + 16384 + soff + i * 4096) = rb[i]; }
        }
        __syncthreads();
    }
}
DEVINL void zero_acc(f32x4 (&acc)[4][4]) {
#pragma unroll
    for (int i = 0; i < 4; ++i)
#pragma unroll
        for (int j = 0; j < 4; ++j) acc[i][j] = (f32x4){0.f, 0.f, 0.f, 0.f};
}
DEVINL void tile_order(int t, int nN, int& pm, int& pn) { const int g = t / (8 * nN), r = t % (8 * nN); pn = r >> 3; pm = g * 8 + (r & 7); }
struct TileWalk {
    int nN, i, x, j, nb; bool xcd;
    DEVINL void init(int nN_) { nN = nN_; i = 0; xcd = (gridDim.x & 7) == 0; x = blockIdx.x & 7; j = blockIdx.x >> 3; nb = gridDim.x >> 3; }
    DEVINL bool next(int& pm, int& pn) {
        if (xcd) { const int s = i * nb + j; ++i; if (s >= 8 * nN) return false; pn = s >> 3; pm = x * 8 + (s & 7); return true; }
        const int t = blockIdx.x + i * gridDim.x; ++i; if (t >= 64 * nN) return false; tile_order(t, nN, pm, pn); return true;
    }
};

DEVINL void wt_tile2(const float* __restrict__ src, int K, int N, bf16_t* __restrict__ dst, int ldd, int tile0, char* smem) {
    const int nNt = N >> 6, t = tid();
    float* tl = (float*)smem;
    const int r = t >> 4, c4 = t & 15;
    f32x4 v[2][4];
#pragma unroll
    for (int u = 0; u < 2; ++u) {
        const int tile = tile0 + u, k0 = (tile / nNt) * 64, n0 = (tile % nNt) * 64;
#pragma unroll
        for (int i = 0; i < 4; ++i) v[u][i] = *(const f32x4*)(src + (size_t)(k0 + r + 16 * i) * N + n0 + c4 * 4);
    }
    asm volatile("" : "+v"(v[0][0]), "+v"(v[0][1]), "+v"(v[0][2]), "+v"(v[0][3]), "+v"(v[1][0]), "+v"(v[1][1]), "+v"(v[1][2]), "+v"(v[1][3]));
#pragma unroll
    for (int u = 0; u < 2; ++u)
#pragma unroll
        for (int i = 0; i < 4; ++i) { float* q = tl + u * 4160 + (r + 16 * i) * 65 + c4 * 4; q[0] = v[u][i][0]; q[1] = v[u][i][1]; q[2] = v[u][i][2]; q[3] = v[u][i][3]; }
    __syncthreads();
    const int n = t >> 2, kq = t & 3;
#pragma unroll
    for (int u = 0; u < 2; ++u) {
        const int tile = tile0 + u, k0 = (tile / nNt) * 64, n0 = (tile % nNt) * 64;
        uint32_t pk[8];
#pragma unroll
        for (int e = 0; e < 8; ++e) pk[e] = pack_bf16(tl[u * 4160 + (kq * 16 + 2 * e) * 65 + n], tl[u * 4160 + (kq * 16 + 2 * e + 1) * 65 + n]);
        uint4* o = (uint4*)(dst + (size_t)(n0 + n) * ldd + k0 + kq * 16);
        o[0] = make_uint4(pk[0], pk[1], pk[2], pk[3]); o[1] = make_uint4(pk[4], pk[5], pk[6], pk[7]);
    }
    __syncthreads();
}
DEVINL void mod_tile(const Params& p, int tile, char* smem) {
    const int l = tile / 96, n0 = (tile % 96) * 64, t = tid(), kg = t >> 6, col = t & 63;
    float* sl = (float*)smem;
    float* red = sl + 5 * 1024;
    for (int i = t; i < 5 * 1024; i += 256) { const int cb = i >> 10, k = i & 1023; const float x = cb == 0 ? p.c_ctx[k] : p.c[(cb - 1) * 1024 + k]; sl[i] = x * sigmoidf_(x); }
    __syncthreads();
    float a0 = 0.f, a1 = 0.f, a2 = 0.f, a3 = 0.f, a4 = 0.f;
    const float* wp = p.w_ada + ((size_t)l * 1024 + kg * 256) * 6144 + n0 + col;
#pragma unroll 1
    for (int k0 = 0; k0 < 256; k0 += 32) {
        float wv[32];
#pragma unroll
        for (int k = 0; k < 32; ++k) wv[k] = wp[(size_t)(k0 + k) * 6144];
        SCHED_FENCE();
#pragma unroll
        for (int k = 0; k < 32; ++k) {
            const int kk = kg * 256 + k0 + k;
            a0 += sl[kk] * wv[k]; a1 += sl[1024 + kk] * wv[k]; a2 += sl[2048 + kk] * wv[k]; a3 += sl[3072 + kk] * wv[k]; a4 += sl[4096 + kk] * wv[k];
        }
    }
    red[(kg * 5 + 0) * 64 + col] = a0; red[(kg * 5 + 1) * 64 + col] = a1; red[(kg * 5 + 2) * 64 + col] = a2; red[(kg * 5 + 3) * 64 + col] = a3; red[(kg * 5 + 4) * 64 + col] = a4;
    __syncthreads();
    float* mod = (float*)(p.ws + OFF_MOD);
    for (int i = t; i < 320; i += 256) {
        const int cb = i >> 6, cc = i & 63;
        const float s = red[(0 * 5 + cb) * 64 + cc] + red[(1 * 5 + cb) * 64 + cc] + red[(2 * 5 + cb) * 64 + cc] + red[(3 * 5 + cb) * 64 + cc];
        mod[((size_t)l * 5 + cb) * 6144 + n0 + cc] = s + p.b_ada[l * 6144 + n0 + cc];
    }
    __syncthreads();
}
DEVINL void phase_prep(const Params& p, char* smem) {
    const int t = tid();
    bf16_t* WT = (bf16_t*)(p.ws + OFF_WT);
    constexpr int NMOD = 192, NW = 4224  , NC = 256, NT = NMOD + NW + NC + 1;
    for (int tile = blockIdx.x; tile < NT; tile += gridDim.x) {
        if (tile < NMOD) mod_tile(p, tile, smem);
        else if (tile < NMOD + NW) {
            int wt = (tile - NMOD) * 2; const int l = wt / 4224; wt -= l * 4224;
            const float* src; int K, N, ldd; size_t dofs;
            if (wt < 1600) { src = p.w_in + (size_t)l * 1024 * 6400; K = 1024; N = 6400; ldd = LW1; dofs = WO_IN; }
            else if (wt < 1664) { wt -= 1600; src = p.w_a_out + (size_t)l * 256 * 1024; K = 256; N = 1024; ldd = LWM; dofs = WO_A; }
            else if (wt < 1728) { wt -= 1664; src = p.w_b_out + (size_t)l * 256 * 1024; K = 256; N = 1024; ldd = LWM; dofs = WO_A + 256; }
            else if (wt < 1792) { wt -= 1728; src = p.w_c_out + (size_t)l * 256 * 1024; K = 256; N = 1024; ldd = LWM; dofs = WO_A + 512; }
            else if (wt < 1920) { wt -= 1792; src = p.w_d_out + (size_t)l * 512 * 1024; K = 512; N = 1024; ldd = LWM; dofs = WO_A + 768; }
            else if (wt < 2176) { wt -= 1920; src = p.w_o + (size_t)l * 1024 * 1024; K = 1024; N = 1024; ldd = LW1; dofs = WO_O; }
            else if (wt < 3200) { wt -= 2176; src = p.w_ff1 + (size_t)l * 1024 * 4096; K = 1024; N = 4096; ldd = LW1; dofs = WO_F1; }
            else { wt -= 3200; src = p.w_ff2 + (size_t)l * 4096 * 1024; K = 4096; N = 1024; ldd = LW4; dofs = WO_F2; }
            wt_tile2(src, K, N, WT + (size_t)l * W_LAYER + dofs, ldd, wt, smem);
        } else if (tile < NMOD + NW + NC) {
            const int i = (tile - NMOD - NW) * 256 + t;
            const float* src = (i < 32768) ? p.cache_k + (size_t)i * 8 : p.cache_v + (size_t)(i - 32768) * 8;
            const float4 a = *(const float4*)src, b = *(const float4*)(src + 4);
            uint4 o; o.x = pack_bf16(a.x, a.y); o.y = pack_bf16(a.z, a.w); o.z = pack_bf16(b.x, b.y); o.w = pack_bf16(b.z, b.w);
            *(uint4*)(p.ws + OFF_CKV + (size_t)i * 16) = o;
        } else {
            float2* tab = (float2*)(p.ws + OFF_TAB);
            for (int i = t; i < 1024; i += 256) {
                const int pos = i >> 4, fi = i & 15;
                const float freq = exp2f(-(float)fi * (13.287712379549449f / 16.f));
                const float ang = (float)pos * freq;
                tab[i] = make_float2(__cosf(ang), __sinf(ang));
            }
        }
    }
}

DEVINL void rowpass(const Params& p, int chunk, int mode, int lpost, int which_post, int hsel, int lh) {
    const int lane = tid() & 63, w = tid() >> 6;
    const float* mod = (const float*)(p.ws + OFF_MOD);
    const bf16_t* MF = (const bf16_t*)(p.ws + OFF_MF);
    bf16_t* H = (bf16_t*)(p.ws + OFF_H);
    const float* xin = chunk == 0 ? p.x_prompt : p.x_sample + (size_t)(chunk - 1) * CH * D;
    float* xres = p.out + (size_t)chunk * CH * D;
    const float* xsrc = mode == 0 ? xin : xres;
    const float* gpost = which_post == 1 ? p.g_post_mix + lpost * D : p.g_post_ffn + lpost * D;
    const float* gpre = hsel == 1 ? p.g_pre_mix + lh * D : p.g_pre_ffn + lh * D;
    for (int base = (blockIdx.x * 4 + w) * 4; base < CH; base += gridDim.x * 16) {
        const int cb = chunk == 0 ? 0 : 1 + (chunk - 1) * 2 + (base >> 12);
        float pg[16], hg[16], hs[16];
        if (mode == 1) {
            const float* gate = mod + ((size_t)lpost * 5 + cb) * 6144 + (which_post == 1 ? 2 : 5) * 1024;
            float4 gp[4], gt[4];
#pragma unroll
            for (int i = 0; i < 4; ++i) { const int c = i * 256 + lane * 4; gp[i] = *(const float4*)(gpost + c); gt[i] = *(const float4*)(gate + c); }
            SCHED_FENCE();
#pragma unroll
            for (int i = 0; i < 4; ++i) { pg[4 * i] = gp[i].x * gt[i].x; pg[4 * i + 1] = gp[i].y * gt[i].y; pg[4 * i + 2] = gp[i].z * gt[i].z; pg[4 * i + 3] = gp[i].w * gt[i].w; }
        }
        if (hsel) {
            const float* mb = mod + ((size_t)lh * 5 + cb) * 6144 + (hsel == 1 ? 0 : 3) * 1024;
            float4 g[4], sh[4], sc[4];
#pragma unroll
            for (int i = 0; i < 4; ++i) { const int c = i * 256 + lane * 4; g[i] = *(const float4*)(gpre + c); sh[i] = *(const float4*)(mb + c); sc[i] = *(const float4*)(mb + 1024 + c); }
            SCHED_FENCE();
#pragma unroll
            for (int i = 0; i < 4; ++i) {
                hg[4 * i] = g[i].x * (1.f + sc[i].x); hg[4 * i + 1] = g[i].y * (1.f + sc[i].y); hg[4 * i + 2] = g[i].z * (1.f + sc[i].z); hg[4 * i + 3] = g[i].w * (1.f + sc[i].w);
                hs[4 * i] = sh[i].x; hs[4 * i + 1] = sh[i].y; hs[4 * i + 2] = sh[i].z; hs[4 * i + 3] = sh[i].w;
            }
        }
#pragma unroll 1
        for (int pr = 0; pr < 2; ++pr) {
            const int row0 = base + pr * 2;
            float x[2][16], m[2][16];
#pragma unroll
            for (int r = 0; r < 2; ++r)
#pragma unroll
                for (int i = 0; i < 4; ++i) {
                    const size_t o = (size_t)(row0 + r) * D + i * 256 + lane * 4;
                    const float4 v = *(const float4*)(xsrc + o);
                    x[r][4 * i] = v.x; x[r][4 * i + 1] = v.y; x[r][4 * i + 2] = v.z; x[r][4 * i + 3] = v.w;
                    if (mode == 1) { const uint2 q = *(const uint2*)(MF + o); m[r][4 * i] = bf_lo(q.x); m[r][4 * i + 1] = bf_hi(q.x); m[r][4 * i + 2] = bf_lo(q.y); m[r][4 * i + 3] = bf_hi(q.y); }
                }
            SCHED_FENCE();
#pragma unroll
            for (int r = 0; r < 2; ++r) {
                if (mode == 1) {
                    float ss = 0.f;
#pragma unroll
                    for (int i = 0; i < 16; ++i) ss += m[r][i] * m[r][i];
                    ss = wave_sum(ss);
                    const float rs = rsqrtf(ss * (1.f / D) + EPS);
#pragma unroll
                    for (int i = 0; i < 16; ++i) x[r][i] += (m[r][i] * rs) * pg[i];
                }
#pragma unroll
                for (int i = 0; i < 4; ++i) *(float4*)(xres + (size_t)(row0 + r) * D + i * 256 + lane * 4) = make_float4(x[r][4 * i], x[r][4 * i + 1], x[r][4 * i + 2], x[r][4 * i + 3]);
                if (hsel) {
                    float ss = 0.f;
#pragma unroll
                    for (int i = 0; i < 16; ++i) ss += x[r][i] * x[r][i];
                    ss = wave_sum(ss);
                    const float rs = rsqrtf(ss * (1.f / D) + EPS);
#pragma unroll
                    for (int i = 0; i < 4; ++i) {
                        const float h0 = x[r][4 * i] * rs * hg[4 * i] + hs[4 * i], h1 = x[r][4 * i + 1] * rs * hg[4 * i + 1] + hs[4 * i + 1];
                        const float h2 = x[r][4 * i + 2] * rs * hg[4 * i + 2] + hs[4 * i + 2], h3 = x[r][4 * i + 3] * rs * hg[4 * i + 3] + hs[4 * i + 3];
                        *(uint2*)(H + (size_t)(row0 + r) * LDH + i * 256 + lane * 4) = make_uint2(pack_bf16(h0, h1), pack_bf16(h2, h3));
                    }
                }
            }
        }
    }
}

DEVINL void unpack8u(const uint4& u, float (&f)[8]) { unpack8(u, f); }
struct MergeHook {
    const bf16_t* zg;
    bool on;
    DEVINL void operator()(int k, f32x4 (&acc)[4][4]) const {
        if (!on || (k & 3) != 3 || k > 11) return;
        const int b = k >> 2;
        const bf16_t* z = zg + b * 1024;
        uint4 ga[4][2], gb[4][2];
#pragma unroll
        for (int mi = 0; mi < 4; ++mi)
#pragma unroll
            for (int q = 0; q < 2; ++q) { ga[mi][q] = *(const uint4*)(z + (size_t)mi * 16 * INW + q * 32); gb[mi][q] = *(const uint4*)(z + 1024 + (size_t)mi * 16 * INW + q * 32); }
        SCHED_FENCE();
#pragma unroll
        for (int mi = 0; mi < 4; ++mi)
#pragma unroll
            for (int q = 0; q < 2; ++q) {
                float a[8], bb[8]; unpack8(ga[mi][q], a); unpack8(gb[mi][q], bb);
#pragma unroll
                for (int e = 0; e < 8; ++e) acc[mi][2 * q + (e >> 2)][e & 3] *= (1.f + __expf(-bb[e])) * __builtin_amdgcn_rcpf(1.f + __expf(-a[e]));
            }
    }
};
struct GemmDesc { const bf16_t* A; const bf16_t* W; int lda, ldb, K, nN, epi, l, chunk; };
DEVINL void phase_gemm_any(const Params& p, const GemmDesc& g, char* smem) {
    const int lane = tid() & 63, w = tid() >> 6, wm = w >> 1, wn = w & 1, fr = lane & 15, fq = lane >> 4;
    bf16_t* Z = (bf16_t*)(p.ws + OFF_Z);
    bf16_t* MF = (bf16_t*)(p.ws + OFF_MF);
    bf16_t* HID = (bf16_t*)(p.ws + OFF_HID);
    bf16_t* MG = (bf16_t*)(p.ws + OFF_H);
    TileWalk tw; tw.init(g.nN);
    int pm, pn, pm2 = 0, pn2 = 0;
    bool have = tw.next(pm, pn), pre = false;
    for (; have; pm = pm2, pn = pn2) {
        const bool have2 = tw.next(pm2, pn2);
        f32x4 acc[4][4]; zero_acc(acc);
        const int row0 = pm * 128 + wm * 64 + fr, col0 = pn * 128 + wn * 64 + fq * 8;
        MergeHook hook; hook.on = (g.epi == 3); hook.zg = Z + (size_t)row0 * INW + Z_G + col0;
        gemm_loop_dma(g.A + (size_t)pm * 128 * g.lda, g.lda, g.W + (size_t)pn * 128 * g.ldb, g.ldb, g.K, smem, acc, hook,
                      have2 ? g.A + (size_t)pm2 * 128 * g.lda : nullptr, have2 ? g.W + (size_t)pn2 * 128 * g.ldb : nullptr, pre);
        pre = have2; have = have2;
        if (g.epi == 0) {
            const bool kv = (g.chunk == 0) && (pn == 16 || pn == 17);
            bf16_t* zo = Z + (size_t)row0 * INW + col0;
            asm volatile("" : "+v"(zo));
#pragma unroll
            for (int mi = 0; mi < 4; ++mi)
#pragma unroll
                for (int q = 0; q < 2; ++q) {
                    const f32x4 v0 = acc[mi][2 * q], v1 = acc[mi][2 * q + 1];
                    *(uint4*)(zo + (size_t)mi * 16 * INW + q * 32) = make_uint4(pack_bf16(v0[0], v0[1]), pack_bf16(v0[2], v0[3]), pack_bf16(v1[0], v1[1]), pack_bf16(v1[2], v1[3]));
                    if (kv) {
                        const int row = row0 + mi * 16, cl = wn * 64 + q * 32 + fq * 8;
                        float* dst = p.out + (pn == 16 ? OUT_K : OUT_V) + ((size_t)((row >> 8) * 2 + g.l) * 256 + (row & 255)) * 128 + cl;
                        *(f32x4*)dst = v0; *(f32x4*)(dst + 4) = v1;
                    }
                }
        } else if (g.epi == 1) {
            bf16_t* mo = MF + (size_t)row0 * D + col0;
            asm volatile("" : "+v"(mo));
#pragma unroll
            for (int mi = 0; mi < 4; ++mi)
#pragma unroll
                for (int q = 0; q < 2; ++q) {
                    const f32x4 v0 = acc[mi][2 * q], v1 = acc[mi][2 * q + 1];
                    *(uint4*)(mo + (size_t)mi * 16 * D + q * 32) = make_uint4(pack_bf16(v0[0], v0[1]), pack_bf16(v0[2], v0[3]), pack_bf16(v1[0], v1[1]), pack_bf16(v1[2], v1[3]));
                }
        } else if (g.epi == 2) {
            bf16_t* ho = HID + (size_t)row0 * LDHID + col0;
            asm volatile("" : "+v"(ho));
#pragma unroll
            for (int mi = 0; mi < 4; ++mi)
#pragma unroll
                for (int q = 0; q < 2; ++q) {
                    float r[8];
#pragma unroll
                    for (int e = 0; e < 8; ++e) { const float x = fmaxf(acc[mi][2 * q + (e >> 2)][e & 3], 0.f); r[e] = x * x; }
                    *(uint4*)(ho + (size_t)mi * 16 * LDHID + q * 32) = pack8(r);
                }
        } else {
            const bf16_t* z3 = hook.zg + 3 * 1024;
            bf16_t* mg = MG + (size_t)row0 * LDH + col0;
            uint4 g3[4][2];
#pragma unroll
            for (int mi = 0; mi < 4; ++mi)
#pragma unroll
                for (int q = 0; q < 2; ++q) g3[mi][q] = *(const uint4*)(z3 + (size_t)mi * 16 * INW + q * 32);
            SCHED_FENCE();
#pragma unroll
            for (int mi = 0; mi < 4; ++mi)
#pragma unroll
                for (int q = 0; q < 2; ++q) {
                    float gg[8], r[8]; unpack8(g3[mi][q], gg);
#pragma unroll
                    for (int e = 0; e < 8; ++e) r[e] = acc[mi][2 * q + (e >> 2)][e & 3] * sigmoidf_(gg[e]);
                    *(uint4*)(mg + (size_t)mi * 16 * LDH + q * 32) = pack8(r);
                }
        }
    }
}

struct AttTile { const bf16_t* kptr; const bf16_t* vptr; int stride, kstart; bool rope, maskf; };
DEVINL bool att_tile(int it, bool is_ctx, const bf16_t* Zs, const bf16_t* CKb, int q0, int kvh, AttTile& d) {
    d.rope = false; d.maskf = false;
    if (is_ctx) { d.kstart = it * 64; d.kptr = Zs + (size_t)d.kstart * INW + Z_K + kvh * 64; d.vptr = d.kptr + 128; d.stride = INW; return true; }
    if (it < 5) {
        d.kstart = (q0 & ~63) - 128 + it * 64; d.stride = INW; d.rope = true; d.maskf = true;
        if (d.kstart < 0 || d.kstart >= 4096) return false;
        d.kptr = Zs + (size_t)d.kstart * INW + Z_K + kvh * 64; d.vptr = d.kptr + 128; return true;
    }
    d.kstart = (it - 5) * 64; d.kptr = CKb + (size_t)d.kstart * 128 + kvh * 64; d.vptr = d.kptr + 262144; d.stride = 128; return true;
}
DEVINL void attn_unit(const Params& p, int chunk, int layer, int unit, char* smem) {
    const int t = tid(), lane = t & 63, w = t >> 6, fr = lane & 15, fq = lane >> 4;
    const bool is_ctx = (chunk == 0);
    int seq_base, q0, kvh, bseq = 0;
    if (is_ctx) { seq_base = (unit >> 4) * 256; q0 = ((unit >> 1) & 7) * 32; kvh = unit & 1; }
    else { const int sl = unit >> 8; seq_base = sl * 4096; q0 = ((unit >> 1) & 127) * 32; kvh = unit & 1; bseq = (chunk - 1) * 2 + sl; }
    const int head = kvh * 4 + w;
    const bf16_t* Zs = (const bf16_t*)(p.ws + OFF_Z) + (size_t)seq_base * INW;
    const bf16_t* CKb = (const bf16_t*)(p.ws + OFF_CKV) + (size_t)(bseq * 2 + layer) * 256 * 128;
    const float2* tab = (const float2*)(p.ws + OFF_TAB);
    bf16_t* ACT = (bf16_t*)(p.ws + OFF_ACT);
    char* Ks = smem;
    bf16_t* Vt = (bf16_t*)(smem + 8192);
    constexpr int VS = 68;

    bf16x8 qf[2][2];
#pragma unroll
    for (int qg = 0; qg < 2; ++qg)
#pragma unroll
        for (int dh = 0; dh < 2; ++dh) {
            const int pos = q0 + qg * 16 + fr;
            uint4 u = *(const uint4*)(Zs + (size_t)pos * INW + Z_Q + head * 64 + dh * 32 + fq * 8);
            if (!is_ctx) {
                uint4 pu; pu.x = __shfl_xor((int)u.x, 32); pu.y = __shfl_xor((int)u.y, 32); pu.z = __shfl_xor((int)u.z, 32); pu.w = __shfl_xor((int)u.w, 32);
                float x[8], y[8]; unpack8(u, x); unpack8(pu, y);
                const int pi = dh == 0 ? (pos >> 6) : (pos & 63);
                const float2* tp = tab + pi * 16 + (fq & 1) * 8;
                const float sgn = fq < 2 ? -1.f : 1.f;
#pragma unroll
                for (int e = 0; e < 8; ++e) { const float2 cs = tp[e]; x[e] = x[e] * cs.x + sgn * y[e] * cs.y; }
                u = pack8(x);
            }
            qf[qg][dh] = as_bf16x8(u);
        }
    f32x4 o[2][4];
#pragma unroll
    for (int i = 0; i < 2; ++i)
#pragma unroll
        for (int j = 0; j < 4; ++j) o[i][j] = (f32x4){0.f, 0.f, 0.f, 0.f};
    const float sk2 = p.sink[layer * 8 + head] * 1.4426950408889634f;
    float mrow[2], lsum[2];
#pragma unroll
    for (int i = 0; i < 2; ++i) { mrow[i] = sk2; lsum[i] = fq == 0 ? 1.f : 0.f; }
    const float sc2 = 0.125f * 1.4426950408889634f;

    const int ntiles = is_ctx ? 4 : 9;
    const int key = t >> 2, cp = t & 3, c = (cp & 1) + ((cp >> 1) << 2);
    const int vkp = t & 31, vc = t >> 5;
    AttTile cur; int it = 0;
    while (!att_tile(it, is_ctx, Zs, CKb, q0, kvh, cur)) ++it;
    u32x4 ku1, ku2, vu0, vu1; float2 cs[8];
#define ATT_LOAD(d) { const bf16_t* src = (d).kptr + (size_t)key * (d).stride + c * 8; ku1 = *(const u32x4*)src; ku2 = *(const u32x4*)(src + 16); \
        const bf16_t* vs = (d).vptr + (size_t)(2 * vkp) * (d).stride + vc * 8; vu0 = *(const u32x4*)vs; vu1 = *(const u32x4*)(vs + (d).stride); \
        if ((d).rope) { const int kpos = (d).kstart + key, pi = c < 4 ? (kpos >> 6) : (kpos & 63); const float2* tp = tab + pi * 16 + (c & 1) * 8; \
            _Pragma("unroll") for (int e = 0; e < 8; ++e) cs[e] = tp[e]; } }
    ATT_LOAD(cur);
    for (;;) {
        __syncthreads();
        {
            uint4 u1 = make_uint4(ku1[0], ku1[1], ku1[2], ku1[3]), u2 = make_uint4(ku2[0], ku2[1], ku2[2], ku2[3]);
            if (cur.rope) {
                float x1[8], x2[8], o1[8], o2[8]; unpack8(u1, x1); unpack8(u2, x2);
#pragma unroll
                for (int e = 0; e < 8; ++e) { o1[e] = x1[e] * cs[e].x - x2[e] * cs[e].y; o2[e] = x2[e] * cs[e].x + x1[e] * cs[e].y; }
                u1 = pack8(o1); u2 = pack8(o2);
            }
            *(uint4*)(Ks + key * 128 + ((c ^ (key & 7)) << 4)) = u1;
            *(uint4*)(Ks + key * 128 + (((c + 2) ^ (key & 7)) << 4)) = u2;
            {
                uint32_t* dst = (uint32_t*)(Vt + (vc * 8) * VS + 2 * vkp);
#pragma unroll
                for (int m = 0; m < 4; ++m) {
                    dst[(2 * m) * (VS / 2)] = (vu0[m] & 0xffffu) | (vu1[m] << 16);
                    dst[(2 * m + 1) * (VS / 2)] = (vu0[m] >> 16) | (vu1[m] & 0xffff0000u);
                }
            }
        }
        __syncthreads();
        AttTile nxt; int nit = it + 1; bool have = false;
        while (nit < ntiles) { if (att_tile(nit, is_ctx, Zs, CKb, q0, kvh, nxt)) { have = true; break; } ++nit; }
        if (have) ATT_LOAD(nxt);
        SCHED_FENCE();
        const int kstart = cur.kstart; const bool maskf = cur.maskf;
#pragma unroll 1
        for (int hk = 0; hk < 2; ++hk) {
            bf16x8 kf[2][2], vf[4];
#pragma unroll
            for (int kb = 0; kb < 2; ++kb)
#pragma unroll
                for (int dh = 0; dh < 2; ++dh) { const int row = hk * 32 + kb * 16 + fr; kf[kb][dh] = *(const bf16x8*)(Ks + row * 128 + (((dh * 4 + fq) ^ (row & 7)) << 4)); }
#pragma unroll
            for (int di = 0; di < 4; ++di) {
                const bf16_t* vp = Vt + (di * 16 + fr) * VS + hk * 32 + fq * 4;
                const bf16x4 lo = *(const bf16x4*)vp, hi = *(const bf16x4*)(vp + 16);
                vf[di] = __builtin_shufflevector(lo, hi, 0, 1, 2, 3, 4, 5, 6, 7);
            }
#pragma unroll
            for (int qg = 0; qg < 2; ++qg) {
                f32x4 s[2];
#pragma unroll
                for (int kb = 0; kb < 2; ++kb) {
                    s[kb] = __builtin_amdgcn_mfma_f32_16x16x32_bf16(kf[kb][0], qf[qg][0], (f32x4){0.f, 0.f, 0.f, 0.f}, 0, 0, 0);
                    s[kb] = __builtin_amdgcn_mfma_f32_16x16x32_bf16(kf[kb][1], qf[qg][1], s[kb], 0, 0, 0);
                }
                const int qpos = q0 + qg * 16 + fr;
                float mx = -1e30f;
#pragma unroll
                for (int kb = 0; kb < 2; ++kb)
#pragma unroll
                    for (int j = 0; j < 4; ++j) {
                        float v = s[kb][j] * sc2;
                        if (maskf) { const int d = qpos - (kstart + hk * 32 + kb * 16 + fq * 4 + j); if (d > 128 || d < -128) v = -1e30f; }
                        s[kb][j] = v; mx = fmaxf(mx, v);
                    }
                mx = fmaxf(mx, __shfl_xor(mx, 16)); mx = fmaxf(mx, __shfl_xor(mx, 32));
                const float mn = fmaxf(mrow[qg], mx), alpha = exp2f(mrow[qg] - mn);
                mrow[qg] = mn;
                float ps = 0.f;
#pragma unroll
                for (int kb = 0; kb < 2; ++kb)
#pragma unroll
                    for (int j = 0; j < 4; ++j) { const float pv = exp2f(s[kb][j] - mn); s[kb][j] = pv; ps += pv; }
                lsum[qg] = lsum[qg] * alpha + ps;
#pragma unroll
                for (int di = 0; di < 4; ++di) { o[qg][di][0] *= alpha; o[qg][di][1] *= alpha; o[qg][di][2] *= alpha; o[qg][di][3] *= alpha; }
                uint4 pu; pu.x = pack_bf16(s[0][0], s[0][1]); pu.y = pack_bf16(s[0][2], s[0][3]); pu.z = pack_bf16(s[1][0], s[1][1]); pu.w = pack_bf16(s[1][2], s[1][3]);
                const bf16x8 pf = as_bf16x8(pu);
#pragma unroll
                for (int di = 0; di < 4; ++di) o[qg][di] = __builtin_amdgcn_mfma_f32_16x16x32_bf16(vf[di], pf, o[qg][di], 0, 0, 0);
            }
        }
        if (!have) break;
        cur = nxt; it = nit;
    }
#undef ATT_LOAD
#pragma unroll
    for (int qg = 0; qg < 2; ++qg) {
        float l = lsum[qg]; l += __shfl_xor(l, 16); l += __shfl_xor(l, 32);
        const float inv = 1.f / l;
        const int tok = seq_base + q0 + qg * 16 + fr;
#pragma unroll
        for (int di = 0; di < 4; ++di) {
            const f32x4 v = o[qg][di];
            *(uint2*)(ACT + (size_t)tok * ACTW + 768 + head * 64 + di * 16 + fq * 4) = make_uint2(pack_bf16(v[0] * inv, v[1] * inv), pack_bf16(v[2] * inv, v[3] * inv));
        }
    }
}

DEVINL void conva_tile(const Params& p, int chunk, int l, int tile, char* smem) {
    const int t = tid(), lane = t & 63, w = t >> 6;
    const int S = chunk == 0 ? 256 : 4096;
    const int tok0 = tile * 32, pos0 = tok0 % S, sb = tok0 - pos0;
    const bf16_t* Z = (const bf16_t*)(p.ws + OFF_Z);
    bf16_t* ACT = (bf16_t*)(p.ws + OFF_ACT);
    float* glu = (float*)smem;
    {
        const int chk = t & 31, r0 = t >> 5;
#pragma unroll
        for (int h = 0; h < 2; ++h) {
            uint4 a[4], b[4];
#pragma unroll
            for (int i = 0; i < 4; ++i) {
                const int r = r0 + 8 * (h * 4 + i), pos = pos0 - 15 + r, pc = min(max(pos, 0), S - 1);
                const bf16_t* src = Z + (size_t)(sb + pc) * INW + chk * 8;
                a[i] = *(const uint4*)(src + Z_AVAL); b[i] = *(const uint4*)(src + Z_AGATE);
            }
            SCHED_FENCE();
#pragma unroll
            for (int i = 0; i < 4; ++i) {
                const int r = r0 + 8 * (h * 4 + i), pos = pos0 - 15 + r;
                if (r < 62) {
                    const float keep = (pos >= 0 && pos < S) ? 1.f : 0.f;
                    float av[8], bv[8], g[8]; unpack8(a[i], av); unpack8(b[i], bv);
#pragma unroll
                    for (int e = 0; e < 8; ++e) g[e] = keep * av[e] * sigmoidf_(bv[e]);
                    float4* d = (float4*)(glu + r * 256 + chk * 8);
                    d[0] = make_float4(g[0], g[1], g[2], g[3]); d[1] = make_float4(g[4], g[5], g[6], g[7]);
                }
            }
        }
    }
    __syncthreads();
    {
        float wv[31];
#pragma unroll
        for (int k = 0; k < 31; ++k) wv[k] = p.w_conv_a[((size_t)l * 31 + k) * 256 + t];
        const float bias = p.b_conv_a[l * 256 + t];
        for (int i = 0; i < 32; ++i) {
            float s = bias;
#pragma unroll
            for (int k = 0; k < 31; ++k) s += wv[k] * glu[(i + k) * 256 + t];
            glu[i * 256 + t] = s;
        }
    }
    __syncthreads();
    {
        const float4 g = *(const float4*)(p.ln_g_a + l * 256 + lane * 4), b = *(const float4*)(p.ln_b_a + l * 256 + lane * 4);
#pragma unroll
        for (int i = 0; i < 8; ++i) {
            const int r = w * 8 + i;
            const float4 v = *(const float4*)(glu + r * 256 + lane * 4);
            const float mu = wave_sum(v.x + v.y + v.z + v.w) * (1.f / 256.f);
            const float d0 = v.x - mu, d1 = v.y - mu, d2 = v.z - mu, d3 = v.w - mu;
            const float var = wave_sum(d0 * d0 + d1 * d1 + d2 * d2 + d3 * d3) * (1.f / 256.f);
            const float rs = rsqrtf(var + EPS);
            float y0 = d0 * rs * g.x + b.x, y1 = d1 * rs * g.y + b.y, y2 = d2 * rs * g.z + b.z, y3 = d3 * rs * g.w + b.w;
            y0 *= sigmoidf_(y0); y1 *= sigmoidf_(y1); y2 *= sigmoidf_(y2); y3 *= sigmoidf_(y3);
            *(uint2*)(ACT + (size_t)(tok0 + r) * ACTW + 0 + lane * 4) = make_uint2(pack_bf16(y0, y1), pack_bf16(y2, y3));
        }
    }
}
DEVINL void pool_tile(const Params& p, int chunk, int l, int tile, char* smem) {
    const int t = tid();
    const int S = chunk == 0 ? 256 : 4096;
    const int tok0 = tile * 32, pos0 = tok0 % S, sb = tok0 - pos0;
    const bf16_t* Z = (const bf16_t*)(p.ws + OFF_Z);
    bf16_t* ACT = (bf16_t*)(p.ws + OFF_ACT);
    float* u = (float*)smem;
    {
        const int chk = t & 31, r0 = t >> 5;
        uint4 av[6];
#pragma unroll
        for (int i = 0; i < 6; ++i) { const int pos = pos0 - 8 + r0 + 8 * i, pc = min(max(pos, 0), S - 1); av[i] = *(const uint4*)(Z + (size_t)(sb + pc) * INW + Z_POOL + chk * 8); }
        SCHED_FENCE();
#pragma unroll
        for (int i = 0; i < 6; ++i) {
            const int r = r0 + 8 * i, pos = pos0 - 8 + r;
            float g[8]; unpack8(av[i], g);
            const float keep = (pos >= 0 && pos < S) ? 1.f : 0.f;
            float4* d = (float4*)(u + r * 256 + chk * 8);
            d[0] = make_float4(g[0] * keep, g[1] * keep, g[2] * keep, g[3] * keep); d[1] = make_float4(g[4] * keep, g[5] * keep, g[6] * keep, g[7] * keep);
        }
    }
    __syncthreads();
    const int gi = t >> 6, w2 = 1 << gi;
    for (int i = 0; i < 32; ++i) {
        const int pos = pos0 + i;
        float s = 0.f;
        for (int j = -w2; j < w2; ++j) s += u[(i + 8 + j) * 256 + t];
        const int lo = max(pos - w2, 0), hi = min(pos + w2, S);
        const float pooled = s / (float)(hi - lo) - u[(i + 8) * 256 + t];
        u[i * 256 + t] = pooled;
    }
    __syncthreads();
    float acc[32];
#pragma unroll
    for (int i = 0; i < 32; ++i) acc[i] = 0.f;
    const float* wp = p.w_pool + ((size_t)l * 4 + gi) * 4096 + (t & 63);
#pragma unroll 1
    for (int c0 = 0; c0 < 64; c0 += 16) {
        float wv[16];
#pragma unroll
        for (int c = 0; c < 16; ++c) wv[c] = wp[(c0 + c) * 64];
#pragma unroll
        for (int c = 0; c < 16; ++c) {
            const float* up = u + gi * 64 + c0 + c;
#pragma unroll
            for (int i = 0; i < 32; ++i) acc[i] += up[i * 256] * wv[c];
        }
    }
    const float ps = p.pool_scale[l * 256 + t];
#pragma unroll
    for (int i = 0; i < 32; ++i) {
        const float v = acc[i] * ps;
        ACT[(size_t)(tok0 + i) * ACTW + 256 + t] = (bf16_t)(pack_bf16(v, 0.f) & 0xffff);
    }
}
DEVINL void convc_tile(const Params& p, int chunk, int l, int tile) {
    const int t = tid();
    const int S = chunk == 0 ? 256 : 4096;
    const bf16_t* Z = (const bf16_t*)(p.ws + OFF_Z);
    bf16_t* ACT = (bf16_t*)(p.ws + OFF_ACT);
#pragma unroll 1
    for (int i = 0; i < 4; ++i) {
        const int item = i * 256 + t, chk = item & 31, tok = tile * 32 + (item >> 5), pos = tok % S;
        const bf16_t* zr = Z + (size_t)tok * INW + chk * 8;
        float uu[3][8];
#pragma unroll
        for (int j = 0; j < 3; ++j) {
            const int pp = pos + j - 1;
            if (pp >= 0 && pp < S) {
                const uint4 a = *(const uint4*)(zr + (j - 1) * INW + Z_SC), b = *(const uint4*)(zr + (j - 1) * INW + Z_SH);
                float av[8], bv[8]; unpack8(a, av); unpack8(b, bv);
#pragma unroll
                for (int e = 0; e < 8; ++e) uu[j][e] = av[e] * bv[e];
            } else {
#pragma unroll
                for (int e = 0; e < 8; ++e) uu[j][e] = 0.f;
            }
        }
        const uint4 sbv = *(const uint4*)(zr + Z_SB);
        float sbf[8], r[8]; unpack8(sbv, sbf);
        const float* wc = p.w_sc + (size_t)l * 768 + chk * 8;
#pragma unroll
        for (int e = 0; e < 8; ++e) r[e] = sbf[e] * (wc[e] * uu[0][e] + wc[256 + e] * uu[1][e] + wc[512 + e] * uu[2][e]);
        *(uint4*)(ACT + (size_t)tok * ACTW + 512 + chk * 8) = pack8(r);
    }
}
DEVINL void phase_branch(const Params& p, int chunk, int l, char* smem) {
    for (int tile = blockIdx.x; tile < 1280; tile += gridDim.x) {
        if (tile < 512) attn_unit(p, chunk, l, tile, smem);
        else if (tile < 768) conva_tile(p, chunk, l, tile - 512, smem);
        else if (tile < 1024) pool_tile(p, chunk, l, tile - 768, smem);
        else convc_tile(p, chunk, l, tile - 1024);
        __syncthreads();
    }
}

#define XB_TMO      128
#define XB_XCNT(j)  (256  + 64 * (j))
#define XB_XSUB(j)  (1280 + 64 * (j))
#define XB_XGEN(j)  (2304 + 64 * (j))
#define XB_TOP      3328
#define XB_TOPGEN   3392
#define XB_SPIN_CAP (1u << 20)
DEVINL unsigned xb_ld(unsigned* p) { return __hip_atomic_load(p, __ATOMIC_RELAXED, __HIP_MEMORY_SCOPE_AGENT); }
DEVINL unsigned xb_add(unsigned* p, unsigned v) { return __hip_atomic_fetch_add(p, v, __ATOMIC_RELAXED, __HIP_MEMORY_SCOPE_AGENT); }
DEVINL unsigned xb_xcc_id() { return (unsigned)__builtin_amdgcn_s_getreg((3 << 11) | 20) & 0xFu; }
#define XB_SPIN(cond, bar) do { unsigned _sp = 0; while (cond) { __builtin_amdgcn_s_sleep(1); \
    if ((++_sp & 255u) == 0u) { if (xb_ld(&(bar)[XB_TMO])) break; if (_sp > XB_SPIN_CAP) { atomicAdd(&(bar)[XB_TMO], 1u); break; } } } } while (0)
struct XcdBar { unsigned* bar; unsigned x, nloc, nx; };
DEVINL void xb_census(unsigned* bar, unsigned x, unsigned& nloc, unsigned& nx) {
    const unsigned G = gridDim.x;
    unsigned sum, cnt, mine, sp = 0u;
    for (;;) {
        sum = 0u; cnt = 0u; mine = 0u;
#pragma unroll
        for (unsigned j = 0; j < 16; ++j) { const unsigned c = xb_ld(&bar[XB_XCNT(j)]); sum += c; cnt += (c > 0u) ? 1u : 0u; mine = (j == x) ? c : mine; }
        if (sum == G) break;
        __builtin_amdgcn_s_sleep(1);
        if ((++sp & 255u) == 0u) { if (xb_ld(&bar[XB_TMO])) break; if (sp > XB_SPIN_CAP) { atomicAdd(&bar[XB_TMO], 1u); break; } }
    }
    nloc = mine > 0u ? mine : 1u; nx = cnt > 0u ? cnt : 1u;
}
DEVINL void gsync(XcdBar& b) {
    asm volatile("s_waitcnt vmcnt(0)" ::: "memory");
    __syncthreads();
    if (threadIdx.x == 0) {
        unsigned* bar = b.bar;
        __builtin_amdgcn_s_waitcnt(0);
        if (b.nloc == 0u) xb_census(bar, b.x, b.nloc, b.nx);
        const unsigned nloc = b.nloc, nx = b.nx;
        const unsigned old = xb_add(&bar[XB_XSUB(b.x)], 1u);
        const unsigned gen = old / nloc;
        if (old + 1u == (gen + 1u) * nloc) {
            __builtin_amdgcn_fence(__ATOMIC_RELEASE, "agent");
            asm volatile("s_waitcnt vmcnt(0)" ::: "memory");
            const unsigned og = xb_add(&bar[XB_TOP], 1u);
            const unsigned tg = og / nx;
            if (og + 1u == (tg + 1u) * nx) xb_add(&bar[XB_TOPGEN], 1u);
            else XB_SPIN(xb_ld(&bar[XB_TOPGEN]) == tg, bar);
            __builtin_amdgcn_fence(__ATOMIC_ACQUIRE, "agent");
            xb_add(&bar[XB_XGEN(b.x)], 1u);
            asm volatile("s_waitcnt vmcnt(0)" ::: "memory");
        } else {
            XB_SPIN(xb_ld(&bar[XB_XGEN(b.x)]) == gen, bar);
            __builtin_amdgcn_fence(__ATOMIC_ACQUIRE, "agent");
            asm volatile("s_waitcnt vmcnt(0)" ::: "memory");
        }
    }
    __syncthreads();
}
__global__ void __launch_bounds__(256, 2) mega(Params p) {
    __shared__ __attribute__((aligned(16))) char smem[65536];
    cg::grid_group grid = cg::this_grid();
    grid.sync();
    XcdBar xb; xb.bar = (unsigned*)(p.ws + OFF_BAR); xb.x = xb_xcc_id(); xb.nloc = 0u; xb.nx = 0u;
    if (threadIdx.x == 0) (void)xb_add(&xb.bar[XB_XCNT(xb.x)], 1u);
#pragma unroll 1
    for (int step = 0; step < NSTEPS; ++step) {
        int ph, ch = 0, l = 0;
        if (step == 0) ph = 8;
        else if (step == 1) ph = 9;
        else { const int s = step - 2; ch = s >> 4; const int r = s & 15; l = r >> 3; ph = r & 7; }
        const bf16_t* WT = (const bf16_t*)(p.ws + OFF_WT) + (size_t)l * W_LAYER;
        const bf16_t* H = (const bf16_t*)(p.ws + OFF_H);
        int kind = 0;
        GemmDesc g; g.A = H; g.W = WT; g.lda = LDH; g.ldb = LW1; g.K = D; g.nN = 8; g.epi = 1; g.l = l; g.chunk = ch;
        int rp_mode = 1, rp_which = 1, rp_hsel = 0, rp_lh = l;
        switch (ph) {
            case 8: kind = 3; break;
            case 9: kind = 1; rp_mode = 0; rp_hsel = 1; rp_lh = 0; break;
            case 0: g.W = WT + WO_IN; g.nN = 50; g.epi = 0; break;
            case 1: kind = 2; break;
            case 2: g.A = (const bf16_t*)(p.ws + OFF_ACT); g.lda = ACTW; g.W = WT + WO_A; g.ldb = LWM; g.K = 1280; g.epi = 3; break;
            case 3: g.W = WT + WO_O; break;
            case 4: kind = 1; rp_which = 1; rp_hsel = 2; break;
            case 5: g.W = WT + WO_F1; g.nN = 32; g.epi = 2; break;
            case 6: g.A = (const bf16_t*)(p.ws + OFF_HID); g.lda = LDHID; g.W = WT + WO_F2; g.ldb = LW4; g.K = DFF; break;
            default: kind = 1; rp_which = 2; rp_hsel = (l == 0) ? 1 : 0; rp_lh = 1; break;
        }
        if (kind == 0) phase_gemm_any(p, g, smem);
        else if (kind == 1) {
            const int nrep = (ph == 7 && l == 1 && ch < 2) ? 2 : 1;
#pragma unroll 1
            for (int rep = 0; rep < nrep; ++rep) {
                if (rep == 1) { ch += 1; rp_mode = 0; rp_which = 1; rp_hsel = 1; rp_lh = 0; }
                rowpass(p, ch, rp_mode, l, rp_which, rp_hsel, rp_lh);
            }
        }
        else if (kind == 2) phase_branch(p, ch, l, smem);
        else phase_prep(p, smem);
        gsync(xb);
    }
}

extern "C" void kernel_launch(void* const* d_in, const int* in_sizes, int n_in, void* d_out, int out_size, void* d_ws, size_t ws_size, hipStream_t stream) {
    static int grid_blocks = 0;
    if (!grid_blocks) {
        int dev = 0, cus = 0, per_cu = 0;
        (void)hipGetDevice(&dev);
        (void)hipDeviceGetAttribute(&cus, hipDeviceAttributeMultiprocessorCount, dev);
        (void)hipOccupancyMaxActiveBlocksPerMultiprocessor(&per_cu, mega, 256, 0);
        if (per_cu > 2) per_cu = 2;
        if (per_cu < 1) per_cu = 1;
        grid_blocks = cus * per_cu;
    }
    Params p{};
    const float** pp = (const float**)&p;
    for (int i = 0; i < 28; ++i) pp[i] = (const float*)d_in[i];
    p.out = (float*)d_out;
    p.ws = (char*)d_ws;
    (void)hipMemsetAsync((char*)d_ws + OFF_BAR, 0, 16384, stream);
    void* args[] = {&p};
    hipError_t e = hipLaunchCooperativeKernel((void*)mega, dim3(grid_blocks), dim3(256), args, 0, stream);
    if (e != hipSuccess) fprintf(stderr, "cooperative launch failed: %s (grid %d)\n", hipGetErrorString(e), grid_blocks);
}
```

```cpp
#include <hip/hip_runtime.h>
#include <hip/hip_cooperative_groups.h>
#include <stdint.h>
#include <cstdio>
namespace cg = cooperative_groups;

typedef unsigned short bf16_t;
typedef short bf16x8 __attribute__((ext_vector_type(8)));
typedef short bf16x4 __attribute__((ext_vector_type(4)));
typedef float f32x4 __attribute__((ext_vector_type(4)));
typedef unsigned u32x4 __attribute__((ext_vector_type(4)));
#define DEVINL __device__ __forceinline__

constexpr int D = 1024, INW = 6400, CH = 8192  , ACTW = 1344  , DFF = 4096;
constexpr int LDH = 1088, LDHID = 4160, LW1 = 1088, LWM = 1344, LW4 = 4160;
constexpr int Z_AVAL = 0, Z_AGATE = 256, Z_POOL = 512, Z_SB = 768, Z_SC = 1024, Z_SH = 1280, Z_Q = 1536, Z_K = 2048, Z_V = 2176, Z_G = 2304;
constexpr float EPS = 1e-6f;
#ifndef NSTEPS
#define NSTEPS 50
#endif
constexpr size_t WO_IN = 0, WO_A = WO_IN + (size_t)6400 * LW1, WO_O = WO_A + (size_t)1024 * LWM, WO_F1 = WO_O + (size_t)1024 * LW1, WO_F2 = WO_F1 + (size_t)4096 * LW1,
                 W_LAYER = WO_F2 + (size_t)1024 * LW4;
constexpr size_t OFF_WT = 0, OFF_MOD = OFF_WT + 2 * W_LAYER * 2, OFF_CKV = OFF_MOD + 2 * 5 * 6144 * 4, OFF_TAB = OFF_CKV + 2 * 262144 * 2,
                 OFF_H = OFF_TAB + 8192, OFF_ACT = OFF_H + (size_t)CH * LDH * 2, OFF_Z = OFF_ACT + (size_t)CH * ACTW * 2,
                 OFF_MF = OFF_Z, OFF_HID = OFF_Z + (size_t)CH * D * 4, OFF_BAR = OFF_Z + (size_t)CH * INW * 2;
constexpr size_t OUT_K = 25165824, OUT_V = 27262976;

struct Params {
    const float *x_prompt, *x_sample, *cache_k, *cache_v, *c, *c_ctx, *w_ada, *b_ada, *g_pre_mix, *g_post_mix, *g_pre_ffn, *g_post_ffn, *w_in,
        *w_conv_a, *b_conv_a, *ln_g_a, *ln_b_a, *w_a_out, *w_pool, *pool_scale, *w_b_out, *w_sc, *w_c_out, *sink, *w_d_out, *w_o, *w_ff1, *w_ff2;
    float* out;
    char* ws;
};

DEVINL int tid() { int t = threadIdx.x; asm volatile("" : "+v"(t)); return t; }
DEVINL float bf_lo(uint32_t u) { return __uint_as_float(u << 16); }
DEVINL float bf_hi(uint32_t u) { return __uint_as_float(u & 0xffff0000u); }
typedef __bf16 bf16x2_t __attribute__((ext_vector_type(2)));
typedef float f32x2_t __attribute__((ext_vector_type(2)));
DEVINL uint32_t pack_bf16(float lo, float hi) { const f32x2_t v = {lo, hi}; const bf16x2_t b = __builtin_convertvector(v, bf16x2_t); return __builtin_bit_cast(uint32_t, b); }
DEVINL void unpack8(const uint4& u, float (&f)[8]) {
    f[0] = bf_lo(u.x); f[1] = bf_hi(u.x); f[2] = bf_lo(u.y); f[3] = bf_hi(u.y); f[4] = bf_lo(u.z); f[5] = bf_hi(u.z); f[6] = bf_lo(u.w); f[7] = bf_hi(u.w);
}
DEVINL uint4 pack8(const float (&f)[8]) { uint4 u; u.x = pack_bf16(f[0], f[1]); u.y = pack_bf16(f[2], f[3]); u.z = pack_bf16(f[4], f[5]); u.w = pack_bf16(f[6], f[7]); return u; }
DEVINL float sigmoidf_(float x) { return 1.f / (1.f + __expf(-x)); }
DEVINL float wave_sum(float v) {
#pragma unroll
    for (int o = 32; o > 0; o >>= 1) v += __shfl_xor(v, o);
    return v;
}
DEVINL bf16x8 as_bf16x8(const uint4& u) { union { uint4 a; bf16x8 b; } x; x.a = u; return x.b; }

#define SCHED_FENCE() __builtin_amdgcn_sched_barrier(0)
template <bool FKK>
DEVINL void gemm_compute(const char* cur, int aoff, int boff, int fq, int sw, f32x4 (&acc)[4][4]) {
    bf16x8 af[2][4], bfr[2][4];
    __builtin_amdgcn_s_waitcnt(0xC07F);
#pragma unroll
    for (int kk = 0; kk < 2; ++kk) {
        const int co = ((kk * 4 + fq) ^ sw) << 4;
#pragma unroll
        for (int i = 0; i < 4; ++i) { af[kk][i] = *(const bf16x8*)(cur + aoff + i * 2048 + co); bfr[kk][i] = *(const bf16x8*)(cur + boff + i * 2048 + co); }
    }
    __builtin_amdgcn_s_setprio(1);
#pragma unroll
    for (int kk = 0; kk < 2; ++kk)
#pragma unroll
        for (int mi = 0; mi < 4; ++mi)
#pragma unroll
            for (int ni = 0; ni < 4; ++ni) acc[mi][ni] = __builtin_amdgcn_mfma_f32_16x16x32_bf16(bfr[kk][ni], af[kk][mi], acc[mi][ni], 0, 0, 0);
    __builtin_amdgcn_s_setprio(0);
}
struct NoHook { DEVINL void operator()(int, f32x4 (&)[4][4]) const {} };
template <int DEPTH, class Hook = NoHook>
DEVINL void gemm_loop(const bf16_t* __restrict__ A, int lda, const bf16_t* __restrict__ B, int ldb, int K, char* smem, f32x4 (&acc)[4][4], const Hook& hook = Hook()) {
    const int t = tid(), lane = t & 63, w = t >> 6, wm = w >> 1, wn = w & 1, fr = lane & 15, fq = lane >> 4;
    const int sc = t & 7, sr = t >> 3;
    const bf16_t* ag = A + (size_t)sr * lda + sc * 8;
    const bf16_t* bg = B + (size_t)sr * ldb + sc * 8;
    const int soff = sr * 128 + ((sc ^ ((sr >> 1) & 7)) << 4);
    const int aoff = (wm * 64 + fr) * 128, boff = 16384 + (wn * 64 + fr) * 128, sw = (fr >> 1) & 7;
    const int nk = K >> 6;
    u32x4 r0a[4], r0b[4], r1a[4], r1b[4];
#define G_LOAD(RA, RB, KT) { _Pragma("unroll") for (int i = 0; i < 4; ++i) { RA[i] = *(const u32x4*)(ag + (size_t)i * 32 * lda + (KT) * 64); RB[i] = *(const u32x4*)(bg + (size_t)i * 32 * ldb + (KT) * 64); } }
#define G_STORE(RA, RB, BUF) { _Pragma("unroll") for (int i = 0; i < 4; ++i) { *(u32x4*)(smem + (BUF) * 32768 + soff + i * 4096) = RA[i]; *(u32x4*)(smem + (BUF) * 32768 + 16384 + soff + i * 4096) = RB[i]; } }
    G_LOAD(r0a, r0b, 0);
    G_LOAD(r1a, r1b, 1);
    SCHED_FENCE();
    __syncthreads();
    G_STORE(r0a, r0b, 0);
    __syncthreads();
    for (int kt = 0; kt < nk; kt += 2) {
        G_LOAD(r0a, r0b, min(kt + 2, nk - 1));
        SCHED_FENCE();
        gemm_compute<false>(smem, aoff, boff, fq, sw, acc);
        SCHED_FENCE();
        G_STORE(r1a, r1b, 1);
        __syncthreads();
        G_LOAD(r1a, r1b, min(kt + 3, nk - 1));
        SCHED_FENCE();
        gemm_compute<false>(smem + 32768, aoff, boff, fq, sw, acc);
        SCHED_FENCE();
        hook(kt + 1, acc);
        G_STORE(r0a, r0b, 0);
        __syncthreads();
    }
#undef G_LOAD
#undef G_STORE
}
#define LAS3 __attribute__((address_space(3)))
template <class Hook = NoHook>
DEVINL void gemm_loop_dma(const bf16_t* __restrict__ A, int lda, const bf16_t* __restrict__ B, int ldb, int K, char* smem, f32x4 (&acc)[4][4], const Hook& hook,
                          const bf16_t* An, const bf16_t* Bn, bool pre) {
    const int t = tid(), lane = t & 63, w = __builtin_amdgcn_readfirstlane(t >> 6)  , wm = w >> 1, wn = w & 1, fr = lane & 15, fq = lane >> 4;
    const int sc = t & 7, sr = t >> 3;
    const int srp = 8 * ((sr & 15) >> 2) + 4 * (sr >> 4) + (sr & 3);
    const unsigned voA = (unsigned)(sr * lda + ((sc ^ ((sr >> 1) & 7)) << 3)) * 2u, voB = (unsigned)(srp * ldb + ((sc ^ ((sr >> 1) & 7)) << 3)) * 2u;
    const __amdgpu_buffer_rsrc_t srdA = __builtin_amdgcn_make_buffer_rsrc((void*)A, (short)0, 0x7fffffff, 0x00020000);
    const __amdgpu_buffer_rsrc_t srdB = __builtin_amdgcn_make_buffer_rsrc((void*)B, (short)0, 0x7fffffff, 0x00020000);
    const int aoff = (wm * 64 + fr) * 128, boff = 16384 + (wn * 64 + fr) * 128, sw = (fr >> 1) & 7;
    const int nk = K >> 6;
    LAS3 char* lds = (LAS3 char*)smem;
    const unsigned ldsb = (unsigned)__builtin_amdgcn_readfirstlane((int)(unsigned)(unsigned long)lds) + (unsigned)w * 1024u;
    const int stepA = 32 * lda * 2, stepB = 32 * ldb * 2;
#define D_ONE(SRD, VO, SOFF, M0V) asm volatile("s_mov_b32 m0, %0\n\ts_nop 0\n\tbuffer_load_dwordx4 %1, %2, %3 offen lds" :: "s"(M0V), "v"(VO), "s"(SRD), "s"(SOFF) : "m0", "memory")
#define D_ISSUE(BUF, KT) { _Pragma("unroll") for (int i = 0; i < 4; ++i) { \
        D_ONE(srdA, voA, (KT) * 128 + i * stepA, ldsb + (BUF) * 32768 + i * 4096); \
        D_ONE(srdB, voB, (KT) * 128 + i * stepB, ldsb + (BUF) * 32768 + 16384 + i * 4096); } }
#define D_WAIT() { asm volatile("s_waitcnt vmcnt(0)" ::: "memory"); __builtin_amdgcn_s_barrier(); asm volatile("" ::: "memory"); }
    if (!pre) D_ISSUE(0, 0);
    D_WAIT();
    for (int kt = 0; kt < nk; kt += 2) {
        D_ISSUE(1, kt + 1);
        SCHED_FENCE();
        gemm_compute<false>(smem, aoff, boff, fq, sw, acc);
        SCHED_FENCE();
        D_WAIT();
        if (kt + 2 < nk) D_ISSUE(0, kt + 2)
        else if (An) {
            const __amdgpu_buffer_rsrc_t srdA2 = __builtin_amdgcn_make_buffer_rsrc((void*)An, (short)0, 0x7fffffff, 0x00020000);
            const __amdgpu_buffer_rsrc_t srdB2 = __builtin_amdgcn_make_buffer_rsrc((void*)Bn, (short)0, 0x7fffffff, 0x00020000);
#pragma unroll
            for (int i = 0; i < 4; ++i) { D_ONE(srdA2, voA, i * stepA, ldsb + i * 4096); D_ONE(srdB2, voB, i * stepB, ldsb + 16384 + i * 4096); }
        }
        SCHED_FENCE();
        gemm_compute<false>(smem + 32768, aoff, boff, fq, sw, acc);
        SCHED_FENCE();
        hook(kt + 1, acc);
        if (kt + 2 < nk) D_WAIT();
    }
#undef D_ISSUE
#undef D_ONE
#undef D_WAIT
}
DEVINL void gemm_loop1(const bf16_t* __restrict__ A, int lda, const bf16_t* __restrict__ B, int ldb, int K, char* smem, f32x4 (&acc)[4][4]) {
    const int t = tid(), lane = t & 63, w = t >> 6, wm = w >> 1, wn = w & 1, fr = lane & 15, fq = lane >> 4;
    const int sc = t & 7, sr = t >> 3;
    const bf16_t* ag = A + (size_t)sr * lda + sc * 8;
    const bf16_t* bg = B + (size_t)sr * ldb + sc * 8;
    const int soff = sr * 128 + ((sc ^ ((sr >> 1) & 7)) << 4);
    u32x4 ra[4], rb[4];
    const int nk = K >> 6;
#pragma unroll
    for (int i = 0; i < 4; ++i) { ra[i] = *(const u32x4*)(ag + (size_t)i * 32 * lda); rb[i] = *(const u32x4*)(bg + (size_t)i * 32 * ldb); }
    __syncthreads();
#pragma unroll
    for (int i = 0; i < 4; ++i) { *(u32x4*)(smem + soff + i * 4096) = ra[i]; *(u32x4*)(smem + 16384 + soff + i * 4096) = rb[i]; }
    __syncthreads();
    const int aoff = (wm * 64 + fr) * 128, boff = 16384 + (wn * 64 + fr) * 128, sw = (fr >> 1) & 7;
    for (int kt = 0; kt < nk; ++kt) {
        const char* cur = smem + (kt & 1) * 32768;
        if (kt + 1 < nk) {
#pragma unroll
            for (int i = 0; i < 4; ++i) { ra[i] = *(const u32x4*)(ag + (size_t)i * 32 * lda + (kt + 1) * 64); rb[i] = *(const u32x4*)(bg + (size_t)i * 32 * ldb + (kt + 1) * 64); }
        }
        gemm_compute<false>(cur, aoff, boff, fq, sw, acc);
        if (kt + 1 < nk) {
            char* nxt = smem + ((kt + 1) & 1) * 32768;
#pragma unroll
            for (int i = 0; i < 4; ++i) { *(u32x4*)(nxt + soff + i * 4096) = ra[i]; *(u32x4*)(nxt + 16384 + soff + i * 4096) = rb[i]; }
        }
        __syncthreads();
    }
}
DEVINL void zero_acc(f32x4 (&acc)[4][4]) {
#pragma unroll
    for (int i = 0; i < 4; ++i)
#pragma unroll
        for (int j = 0; j < 4; ++j) acc[i][j] = (f32x4){0.f, 0.f, 0.f, 0.f};
}
DEVINL void tile_order(int t, int nN, int& pm, int& pn) { const int g = t / (8 * nN), r = t % (8 * nN); pn = r >> 3; pm = g * 8 + (r & 7); }
struct TileWalk {
    int nN, i, x, j, nb; bool xcd;
    DEVINL void init(int nN_) { nN = nN_; i = 0; xcd = (gridDim.x & 7) == 0; x = blockIdx.x & 7; j = blockIdx.x >> 3; nb = gridDim.x >> 3; }
    DEVINL bool next(int& pm, int& pn) {
        if (xcd) { const int s = i * nb + j; ++i; if (s >= 8 * nN) return false; pn = s >> 3; pm = x * 8 + (s & 7); return true; }
        const int t = blockIdx.x + i * gridDim.x; ++i; if (t >= 64 * nN) return false; tile_order(t, nN, pm, pn); return true;
    }
};

DEVINL void wt_tile2(const float* __restrict__ src, int K, int N, bf16_t* __restrict__ dst, int ldd, int tile0, char* smem) {
    const int nNt = N >> 6, t = tid();
    float* tl = (float*)smem;
    const int r = t >> 4, c4 = t & 15;
    f32x4 v[2][4];
#pragma unroll
    for (int u = 0; u < 2; ++u) {
        const int tile = tile0 + u, k0 = (tile / nNt) * 64, n0 = (tile % nNt) * 64;
#pragma unroll
        for (int i = 0; i < 4; ++i) v[u][i] = *(const f32x4*)(src + (size_t)(k0 + r + 16 * i) * N + n0 + c4 * 4);
    }
    asm volatile("" : "+v"(v[0][0]), "+v"(v[0][1]), "+v"(v[0][2]), "+v"(v[0][3]), "+v"(v[1][0]), "+v"(v[1][1]), "+v"(v[1][2]), "+v"(v[1][3]));
#pragma unroll
    for (int u = 0; u < 2; ++u)
#pragma unroll
        for (int i = 0; i < 4; ++i) { float* q = tl + u * 4160 + (r + 16 * i) * 65 + c4 * 4; q[0] = v[u][i][0]; q[1] = v[u][i][1]; q[2] = v[u][i][2]; q[3] = v[u][i][3]; }
    __syncthreads();
    const int n = t >> 2, kq = t & 3;
#pragma unroll
    for (int u = 0; u < 2; ++u) {
        const int tile = tile0 + u, k0 = (tile / nNt) * 64, n0 = (tile % nNt) * 64;
        uint32_t pk[8];
#pragma unroll
        for (int e = 0; e < 8; ++e) pk[e] = pack_bf16(tl[u * 4160 + (kq * 16 + 2 * e) * 65 + n], tl[u * 4160 + (kq * 16 + 2 * e + 1) * 65 + n]);
        uint4* o = (uint4*)(dst + (size_t)(n0 + n) * ldd + k0 + kq * 16);
        o[0] = make_uint4(pk[0], pk[1], pk[2], pk[3]); o[1] = make_uint4(pk[4], pk[5], pk[6], pk[7]);
    }
    __syncthreads();
}
DEVINL void mod_tile(const Params& p, int tile, char* smem) {
    const int l = tile / 96, n0 = (tile % 96) * 64, t = tid(), kg = t >> 6, col = t & 63;
    float* sl = (float*)smem;
    float* red = sl + 5 * 1024;
    for (int i = t; i < 5 * 1024; i += 256) { const int cb = i >> 10, k = i & 1023; const float x = cb == 0 ? p.c_ctx[k] : p.c[(cb - 1) * 1024 + k]; sl[i] = x * sigmoidf_(x); }
    __syncthreads();
    float a0 = 0.f, a1 = 0.f, a2 = 0.f, a3 = 0.f, a4 = 0.f;
    const float* wp = p.w_ada + ((size_t)l * 1024 + kg * 256) * 6144 + n0 + col;
#pragma unroll 1
    for (int k0 = 0; k0 < 256; k0 += 32) {
        float wv[32];
#pragma unroll
        for (int k = 0; k < 32; ++k) wv[k] = wp[(size_t)(k0 + k) * 6144];
        SCHED_FENCE();
#pragma unroll
        for (int k = 0; k < 32; ++k) {
            const int kk = kg * 256 + k0 + k;
            a0 += sl[kk] * wv[k]; a1 += sl[1024 + kk] * wv[k]; a2 += sl[2048 + kk] * wv[k]; a3 += sl[3072 + kk] * wv[k]; a4 += sl[4096 + kk] * wv[k];
        }
    }
    red[(kg * 5 + 0) * 64 + col] = a0; red[(kg * 5 + 1) * 64 + col] = a1; red[(kg * 5 + 2) * 64 + col] = a2; red[(kg * 5 + 3) * 64 + col] = a3; red[(kg * 5 + 4) * 64 + col] = a4;
    __syncthreads();
    float* mod = (float*)(p.ws + OFF_MOD);
    for (int i = t; i < 320; i += 256) {
        const int cb = i >> 6, cc = i & 63;
        const float s = red[(0 * 5 + cb) * 64 + cc] + red[(1 * 5 + cb) * 64 + cc] + red[(2 * 5 + cb) * 64 + cc] + red[(3 * 5 + cb) * 64 + cc];
        mod[((size_t)l * 5 + cb) * 6144 + n0 + cc] = s + p.b_ada[l * 6144 + n0 + cc];
    }
    __syncthreads();
}
DEVINL void phase_prep(const Params& p, char* smem) {
    const int t = tid();
    bf16_t* WT = (bf16_t*)(p.ws + OFF_WT);
    constexpr int NMOD = 192, NW = 4224  , NC = 256, NT = NMOD + NW + NC + 1;
    for (int tile = blockIdx.x; tile < NT; tile += gridDim.x) {
        if (tile < NMOD) mod_tile(p, tile, smem);
        else if (tile < NMOD + NW) {
            int wt = (tile - NMOD) * 2; const int l = wt / 4224; wt -= l * 4224;
            const float* src; int K, N, ldd; size_t dofs;
            if (wt < 1600) { src = p.w_in + (size_t)l * 1024 * 6400; K = 1024; N = 6400; ldd = LW1; dofs = WO_IN; }
            else if (wt < 1664) { wt -= 1600; src = p.w_a_out + (size_t)l * 256 * 1024; K = 256; N = 1024; ldd = LWM; dofs = WO_A; }
            else if (wt < 1728) { wt -= 1664; src = p.w_b_out + (size_t)l * 256 * 1024; K = 256; N = 1024; ldd = LWM; dofs = WO_A + 256; }
            else if (wt < 1792) { wt -= 1728; src = p.w_c_out + (size_t)l * 256 * 1024; K = 256; N = 1024; ldd = LWM; dofs = WO_A + 512; }
            else if (wt < 1920) { wt -= 1792; src = p.w_d_out + (size_t)l * 512 * 1024; K = 512; N = 1024; ldd = LWM; dofs = WO_A + 768; }
            else if (wt < 2176) { wt -= 1920; src = p.w_o + (size_t)l * 1024 * 1024; K = 1024; N = 1024; ldd = LW1; dofs = WO_O; }
            else if (wt < 3200) { wt -= 2176; src = p.w_ff1 + (size_t)l * 1024 * 4096; K = 1024; N = 4096; ldd = LW1; dofs = WO_F1; }
            else { wt -= 3200; src = p.w_ff2 + (size_t)l * 4096 * 1024; K = 4096; N = 1024; ldd = LW4; dofs = WO_F2; }
            wt_tile2(src, K, N, WT + (size_t)l * W_LAYER + dofs, ldd, wt, smem);
        } else if (tile < NMOD + NW + NC) {
            const int i = (tile - NMOD - NW) * 256 + t;
            const float* src = (i < 32768) ? p.cache_k + (size_t)i * 8 : p.cache_v + (size_t)(i - 32768) * 8;
            const float4 a = *(const float4*)src, b = *(const float4*)(src + 4);
            uint4 o; o.x = pack_bf16(a.x, a.y); o.y = pack_bf16(a.z, a.w); o.z = pack_bf16(b.x, b.y); o.w = pack_bf16(b.z, b.w);
            *(uint4*)(p.ws + OFF_CKV + (size_t)i * 16) = o;
        } else {
            float2* tab = (float2*)(p.ws + OFF_TAB);
            for (int i = t; i < 1024; i += 256) {
                const int pos = i >> 4, fi = i & 15;
                const float freq = exp2f(-(float)fi * (13.287712379549449f / 16.f));
                const float ang = (float)pos * freq;
                tab[i] = make_float2(__cosf(ang), __sinf(ang));
            }
        }
    }
}

DEVINL void rowpass(const Params& p, int chunk, int mode, int lpost, int which_post, int hsel, int lh) {
    const int lane = tid() & 63, w = tid() >> 6;
    const float* mod = (const float*)(p.ws + OFF_MOD);
    const bf16_t* MF = (const bf16_t*)(p.ws + OFF_MF);
    bf16_t* H = (bf16_t*)(p.ws + OFF_H);
    const float* xin = chunk == 0 ? p.x_prompt : p.x_sample + (size_t)(chunk - 1) * CH * D;
    float* xres = p.out + (size_t)chunk * CH * D;
    const float* xsrc = mode == 0 ? xin : xres;
    const float* gpost = which_post == 1 ? p.g_post_mix + lpost * D : p.g_post_ffn + lpost * D;
    const float* gpre = hsel == 1 ? p.g_pre_mix + lh * D : p.g_pre_ffn + lh * D;
    for (int base = (blockIdx.x * 4 + w) * 4; base < CH; base += gridDim.x * 16) {
        const int cb = chunk == 0 ? 0 : 1 + (chunk - 1) * 2 + (base >> 12);
        float pg[16], hg[16], hs[16];
        if (mode == 1) {
            const float* gate = mod + ((size_t)lpost * 5 + cb) * 6144 + (which_post == 1 ? 2 : 5) * 1024;
            float4 gp[4], gt[4];
#pragma unroll
            for (int i = 0; i < 4; ++i) { const int c = i * 256 + lane * 4; gp[i] = *(const float4*)(gpost + c); gt[i] = *(const float4*)(gate + c); }
            SCHED_FENCE();
#pragma unroll
            for (int i = 0; i < 4; ++i) { pg[4 * i] = gp[i].x * gt[i].x; pg[4 * i + 1] = gp[i].y * gt[i].y; pg[4 * i + 2] = gp[i].z * gt[i].z; pg[4 * i + 3] = gp[i].w * gt[i].w; }
        }
        if (hsel) {
            const float* mb = mod + ((size_t)lh * 5 + cb) * 6144 + (hsel == 1 ? 0 : 3) * 1024;
            float4 g[4], sh[4], sc[4];
#pragma unroll
            for (int i = 0; i < 4; ++i) { const int c = i * 256 + lane * 4; g[i] = *(const float4*)(gpre + c); sh[i] = *(const float4*)(mb + c); sc[i] = *(const float4*)(mb + 1024 + c); }
            SCHED_FENCE();
#pragma unroll
            for (int i = 0; i < 4; ++i) {
                hg[4 * i] = g[i].x * (1.f + sc[i].x); hg[4 * i + 1] = g[i].y * (1.f + sc[i].y); hg[4 * i + 2] = g[i].z * (1.f + sc[i].z); hg[4 * i + 3] = g[i].w * (1.f + sc[i].w);
                hs[4 * i] = sh[i].x; hs[4 * i + 1] = sh[i].y; hs[4 * i + 2] = sh[i].z; hs[4 * i + 3] = sh[i].w;
            }
        }
#pragma unroll 1
        for (int pr = 0; pr < 2; ++pr) {
            const int row0 = base + pr * 2;
            float x[2][16], m[2][16];
#pragma unroll
            for (int r = 0; r < 2; ++r)
#pragma unroll
                for (int i = 0; i < 4; ++i) {
                    const size_t o = (size_t)(row0 + r) * D + i * 256 + lane * 4;
                    const float4 v = *(const float4*)(xsrc + o);
                    x[r][4 * i] = v.x; x[r][4 * i + 1] = v.y; x[r][4 * i + 2] = v.z; x[r][4 * i + 3] = v.w;
                    if (mode == 1) { const uint2 q = *(const uint2*)(MF + o); m[r][4 * i] = bf_lo(q.x); m[r][4 * i + 1] = bf_hi(q.x); m[r][4 * i + 2] = bf_lo(q.y); m[r][4 * i + 3] = bf_hi(q.y); }
                }
            SCHED_FENCE();
#pragma unroll
            for (int r = 0; r < 2; ++r) {
                if (mode == 1) {
                    float ss = 0.f;
#pragma unroll
                    for (int i = 0; i < 16; ++i) ss += m[r][i] * m[r][i];
                    ss = wave_sum(ss);
                    const float rs = rsqrtf(ss * (1.f / D) + EPS);
#pragma unroll
                    for (int i = 0; i < 16; ++i) x[r][i] += (m[r][i] * rs) * pg[i];
                }
#pragma unroll
                for (int i = 0; i < 4; ++i) *(float4*)(xres + (size_t)(row0 + r) * D + i * 256 + lane * 4) = make_float4(x[r][4 * i], x[r][4 * i + 1], x[r][4 * i + 2], x[r][4 * i + 3]);
                if (hsel) {
                    float ss = 0.f;
#pragma unroll
                    for (int i = 0; i < 16; ++i) ss += x[r][i] * x[r][i];
                    ss = wave_sum(ss);
                    const float rs = rsqrtf(ss * (1.f / D) + EPS);
#pragma unroll
                    for (int i = 0; i < 4; ++i) {
                        const float h0 = x[r][4 * i] * rs * hg[4 * i] + hs[4 * i], h1 = x[r][4 * i + 1] * rs * hg[4 * i + 1] + hs[4 * i + 1];
                        const float h2 = x[r][4 * i + 2] * rs * hg[4 * i + 2] + hs[4 * i + 2], h3 = x[r][4 * i + 3] * rs * hg[4 * i + 3] + hs[4 * i + 3];
                        *(uint2*)(H + (size_t)(row0 + r) * LDH + i * 256 + lane * 4) = make_uint2(pack_bf16(h0, h1), pack_bf16(h2, h3));
                    }
                }
            }
        }
    }
}

DEVINL void unpack8u(const uint4& u, float (&f)[8]) { unpack8(u, f); }
struct MergeHook {
    const bf16_t* zg;
    bool on;
    DEVINL void operator()(int k, f32x4 (&acc)[4][4]) const {
        if (!on || (k & 3) != 3 || k > 11) return;
        const int b = k >> 2;
        const bf16_t* z = zg + b * 1024;
        uint4 ga[4][2], gb[4][2];
#pragma unroll
        for (int mi = 0; mi < 4; ++mi)
#pragma unroll
            for (int q = 0; q < 2; ++q) { ga[mi][q] = *(const uint4*)(z + (size_t)mi * 16 * INW + q * 32); gb[mi][q] = *(const uint4*)(z + 1024 + (size_t)mi * 16 * INW + q * 32); }
        SCHED_FENCE();
#pragma unroll
        for (int mi = 0; mi < 4; ++mi)
#pragma unroll
            for (int q = 0; q < 2; ++q) {
                float a[8], bb[8]; unpack8(ga[mi][q], a); unpack8(gb[mi][q], bb);
#pragma unroll
                for (int e = 0; e < 8; ++e) acc[mi][2 * q + (e >> 2)][e & 3] *= (1.f + __expf(-bb[e])) * __builtin_amdgcn_rcpf(1.f + __expf(-a[e]));
            }
    }
};
struct GemmDesc { const bf16_t* A; const bf16_t* W; int lda, ldb, K, nN, epi, l, chunk; };
DEVINL void phase_gemm_any(const Params& p, const GemmDesc& g, char* smem) {
    const int lane = tid() & 63, w = tid() >> 6, wm = w >> 1, wn = w & 1, fr = lane & 15, fq = lane >> 4;
    bf16_t* Z = (bf16_t*)(p.ws + OFF_Z);
    bf16_t* MF = (bf16_t*)(p.ws + OFF_MF);
    bf16_t* HID = (bf16_t*)(p.ws + OFF_HID);
    bf16_t* MG = (bf16_t*)(p.ws + OFF_H);
    TileWalk tw; tw.init(g.nN);
    int pm, pn, pm2 = 0, pn2 = 0;
    bool have = tw.next(pm, pn), pre = false;
    for (; have; pm = pm2, pn = pn2) {
        const bool have2 = tw.next(pm2, pn2);
        f32x4 acc[4][4]; zero_acc(acc);
        const int row0 = pm * 128 + wm * 64 + fr, col0 = pn * 128 + wn * 64 + fq * 8;
        MergeHook hook; hook.on = (g.epi == 3); hook.zg = Z + (size_t)row0 * INW + Z_G + col0;
        gemm_loop_dma(g.A + (size_t)pm * 128 * g.lda, g.lda, g.W + (size_t)pn * 128 * g.ldb, g.ldb, g.K, smem, acc, hook,
                      have2 ? g.A + (size_t)pm2 * 128 * g.lda : nullptr, have2 ? g.W + (size_t)pn2 * 128 * g.ldb : nullptr, pre);
        pre = have2; have = have2;
        if (g.epi == 0) {
            const bool kv = (g.chunk == 0) && (pn == 16 || pn == 17);
            bf16_t* zo = Z + (size_t)row0 * INW + col0;
            asm volatile("" : "+v"(zo));
#pragma unroll
            for (int mi = 0; mi < 4; ++mi)
#pragma unroll
                for (int q = 0; q < 2; ++q) {
                    const f32x4 v0 = acc[mi][2 * q], v1 = acc[mi][2 * q + 1];
                    *(uint4*)(zo + (size_t)mi * 16 * INW + q * 32) = make_uint4(pack_bf16(v0[0], v0[1]), pack_bf16(v0[2], v0[3]), pack_bf16(v1[0], v1[1]), pack_bf16(v1[2], v1[3]));
                    if (kv) {
                        const int row = row0 + mi * 16, cl = wn * 64 + q * 32 + fq * 8;
                        float* dst = p.out + (pn == 16 ? OUT_K : OUT_V) + ((size_t)((row >> 8) * 2 + g.l) * 256 + (row & 255)) * 128 + cl;
                        *(f32x4*)dst = v0; *(f32x4*)(dst + 4) = v1;
                    }
                }
        } else if (g.epi == 1) {
            bf16_t* mo = MF + (size_t)row0 * D + col0;
            asm volatile("" : "+v"(mo));
#pragma unroll
            for (int mi = 0; mi < 4; ++mi)
#pragma unroll
                for (int q = 0; q < 2; ++q) {
                    const f32x4 v0 = acc[mi][2 * q], v1 = acc[mi][2 * q + 1];
                    *(uint4*)(mo + (size_t)mi * 16 * D + q * 32) = make_uint4(pack_bf16(v0[0], v0[1]), pack_bf16(v0[2], v0[3]), pack_bf16(v1[0], v1[1]), pack_bf16(v1[2], v1[3]));
                }
        } else if (g.epi == 2) {
            bf16_t* ho = HID + (size_t)row0 * LDHID + col0;
            asm volatile("" : "+v"(ho));
#pragma unroll
            for (int mi = 0; mi < 4; ++mi)
#pragma unroll
                for (int q = 0; q < 2; ++q) {
                    float r[8];
#pragma unroll
                    for (int e = 0; e < 8; ++e) { const float x = fmaxf(acc[mi][2 * q + (e >> 2)][e & 3], 0.f); r[e] = x * x; }
                    *(uint4*)(ho + (size_t)mi * 16 * LDHID + q * 32) = pack8(r);
                }
        } else {
            const bf16_t* z3 = hook.zg + 3 * 1024;
            bf16_t* mg = MG + (size_t)row0 * LDH + col0;
            uint4 g3[4][2];
#pragma unroll
            for (int mi = 0; mi < 4; ++mi)
#pragma unroll
                for (int q = 0; q < 2; ++q) g3[mi][q] = *(const uint4*)(z3 + (size_t)mi * 16 * INW + q * 32);
            SCHED_FENCE();
#pragma unroll
            for (int mi = 0; mi < 4; ++mi)
#pragma unroll
                for (int q = 0; q < 2; ++q) {
                    float gg[8], r[8]; unpack8(g3[mi][q], gg);
#pragma unroll
                    for (int e = 0; e < 8; ++e) r[e] = acc[mi][2 * q + (e >> 2)][e & 3] * sigmoidf_(gg[e]);
                    *(uint4*)(mg + (size_t)mi * 16 * LDH + q * 32) = pack8(r);
                }
        }
    }
}

struct AttTile { const bf16_t* kptr; const bf16_t* vptr; int stride, kstart; bool rope, maskf; };
DEVINL bool att_tile(int it, bool is_ctx, const bf16_t* Zs, const bf16_t* CKb, int q0, int kvh, AttTile& d) {
    d.rope = false; d.maskf = false;
    if (is_ctx) { d.kstart = it * 64; d.kptr = Zs + (size_t)d.kstart * INW + Z_K + kvh * 64; d.vptr = d.kptr + 128; d.stride = INW; return true; }
    if (it < 5) {
        d.kstart = (q0 & ~63) - 128 + it * 64; d.stride = INW; d.rope = true; d.maskf = true;
        if (d.kstart < 0 || d.kstart >= 4096) return false;
        d.kptr = Zs + (size_t)d.kstart * INW + Z_K + kvh * 64; d.vptr = d.kptr + 128; return true;
    }
    d.kstart = (it - 5) * 64; d.kptr = CKb + (size_t)d.kstart * 128 + kvh * 64; d.vptr = d.kptr + 262144; d.stride = 128; return true;
}
DEVINL void attn_unit(const Params& p, int chunk, int layer, int unit, char* smem) {
    const int t = tid(), lane = t & 63, w = t >> 6, fr = lane & 15, fq = lane >> 4;
    const bool is_ctx = (chunk == 0);
    int seq_base, q0, kvh, bseq = 0;
    if (is_ctx) { seq_base = (unit >> 4) * 256; q0 = ((unit >> 1) & 7) * 32; kvh = unit & 1; }
    else { const int sl = unit >> 8; seq_base = sl * 4096; q0 = ((unit >> 1) & 127) * 32; kvh = unit & 1; bseq = (chunk - 1) * 2 + sl; }
    const int head = kvh * 4 + w;
    const bf16_t* Zs = (const bf16_t*)(p.ws + OFF_Z) + (size_t)seq_base * INW;
    const bf16_t* CKb = (const bf16_t*)(p.ws + OFF_CKV) + (size_t)(bseq * 2 + layer) * 256 * 128;
    const float2* tab = (const float2*)(p.ws + OFF_TAB);
    bf16_t* ACT = (bf16_t*)(p.ws + OFF_ACT);
    char* Ks = smem;
    bf16_t* Vt = (bf16_t*)(smem + 8192);
    constexpr int VS = 68;

    bf16x8 qf[2][2];
#pragma unroll
    for (int qg = 0; qg < 2; ++qg)
#pragma unroll
        for (int dh = 0; dh < 2; ++dh) {
            const int pos = q0 + qg * 16 + fr;
            uint4 u = *(const uint4*)(Zs + (size_t)pos * INW + Z_Q + head * 64 + dh * 32 + fq * 8);
            if (!is_ctx) {
                uint4 pu; pu.x = __shfl_xor((int)u.x, 32); pu.y = __shfl_xor((int)u.y, 32); pu.z = __shfl_xor((int)u.z, 32); pu.w = __shfl_xor((int)u.w, 32);
                float x[8], y[8]; unpack8(u, x); unpack8(pu, y);
                const int pi = dh == 0 ? (pos >> 6) : (pos & 63);
                const float2* tp = tab + pi * 16 + (fq & 1) * 8;
                const float sgn = fq < 2 ? -1.f : 1.f;
#pragma unroll
                for (int e = 0; e < 8; ++e) { const float2 cs = tp[e]; x[e] = x[e] * cs.x + sgn * y[e] * cs.y; }
                u = pack8(x);
            }
            qf[qg][dh] = as_bf16x8(u);
        }
    f32x4 o[2][4];
#pragma unroll
    for (int i = 0; i < 2; ++i)
#pragma unroll
        for (int j = 0; j < 4; ++j) o[i][j] = (f32x4){0.f, 0.f, 0.f, 0.f};
    const float sk2 = p.sink[layer * 8 + head] * 1.4426950408889634f;
    float mrow[2], lsum[2];
#pragma unroll
    for (int i = 0; i < 2; ++i) { mrow[i] = sk2; lsum[i] = fq == 0 ? 1.f : 0.f; }
    const float sc2 = 0.125f * 1.4426950408889634f;

    const int ntiles = is_ctx ? 4 : 9;
    const int key = t >> 2, cp = t & 3, c = (cp & 1) + ((cp >> 1) << 2);
    const int vkp = t & 31, vc = t >> 5;
    AttTile cur; int it = 0;
    while (!att_tile(it, is_ctx, Zs, CKb, q0, kvh, cur)) ++it;
    u32x4 ku1, ku2, vu0, vu1; float2 cs[8];
#define ATT_LOAD(d) { const bf16_t* src = (d).kptr + (size_t)key * (d).stride + c * 8; ku1 = *(const u32x4*)src; ku2 = *(const u32x4*)(src + 16); \
        const bf16_t* vs = (d).vptr + (size_t)(2 * vkp) * (d).stride + vc * 8; vu0 = *(const u32x4*)vs; vu1 = *(const u32x4*)(vs + (d).stride); \
        if ((d).rope) { const int kpos = (d).kstart + key, pi = c < 4 ? (kpos >> 6) : (kpos & 63); const float2* tp = tab + pi * 16 + (c & 1) * 8; \
            _Pragma("unroll") for (int e = 0; e < 8; ++e) cs[e] = tp[e]; } }
    ATT_LOAD(cur);
    for (;;) {
        __syncthreads();
        {
            uint4 u1 = make_uint4(ku1[0], ku1[1], ku1[2], ku1[3]), u2 = make_uint4(ku2[0], ku2[1], ku2[2], ku2[3]);
            if (cur.rope) {
                float x1[8], x2[8], o1[8], o2[8]; unpack8(u1, x1); unpack8(u2, x2);
#pragma unroll
                for (int e = 0; e < 8; ++e) { o1[e] = x1[e] * cs[e].x - x2[e] * cs[e].y; o2[e] = x2[e] * cs[e].x + x1[e] * cs[e].y; }
                u1 = pack8(o1); u2 = pack8(o2);
            }
            *(uint4*)(Ks + key * 128 + ((c ^ (key & 7)) << 4)) = u1;
            *(uint4*)(Ks + key * 128 + (((c + 2) ^ (key & 7)) << 4)) = u2;
            {
                uint32_t* dst = (uint32_t*)(Vt + (vc * 8) * VS + 2 * vkp);
#pragma unroll
                for (int m = 0; m < 4; ++m) {
                    dst[(2 * m) * (VS / 2)] = (vu0[m] & 0xffffu) | (vu1[m] << 16);
                    dst[(2 * m + 1) * (VS / 2)] = (vu0[m] >> 16) | (vu1[m] & 0xffff0000u);
                }
            }
        }
        __syncthreads();
        AttTile nxt; int nit = it + 1; bool have = false;
        while (nit < ntiles) { if (att_tile(nit, is_ctx, Zs, CKb, q0, kvh, nxt)) { have = true; break; } ++nit; }
        if (have) ATT_LOAD(nxt);
        SCHED_FENCE();
        const int kstart = cur.kstart; const bool maskf = cur.maskf;
#pragma unroll 1
        for (int hk = 0; hk < 2; ++hk) {
            bf16x8 kf[2][2], vf[4];
#pragma unroll
            for (int kb = 0; kb < 2; ++kb)
#pragma unroll
                for (int dh = 0; dh < 2; ++dh) { const int row = hk * 32 + kb * 16 + fr; kf[kb][dh] = *(const bf16x8*)(Ks + row * 128 + (((dh * 4 + fq) ^ (row & 7)) << 4)); }
#pragma unroll
            for (int di = 0; di < 4; ++di) {
                const bf16_t* vp = Vt + (di * 16 + fr) * VS + hk * 32 + fq * 4;
                const bf16x4 lo = *(const bf16x4*)vp, hi = *(const bf16x4*)(vp + 16);
                vf[di] = __builtin_shufflevector(lo, hi, 0, 1, 2, 3, 4, 5, 6, 7);
            }
#pragma unroll
            for (int qg = 0; qg < 2; ++qg) {
                f32x4 s[2];
#pragma unroll
                for (int kb = 0; kb < 2; ++kb) {
                    s[kb] = __builtin_amdgcn_mfma_f32_16x16x32_bf16(kf[kb][0], qf[qg][0], (f32x4){0.f, 0.f, 0.f, 0.f}, 0, 0, 0);
                    s[kb] = __builtin_amdgcn_mfma_f32_16x16x32_bf16(kf[kb][1], qf[qg][1], s[kb], 0, 0, 0);
                }
                const int qpos = q0 + qg * 16 + fr;
                float mx = -1e30f;
#pragma unroll
                for (int kb = 0; kb < 2; ++kb)
#pragma unroll
                    for (int j = 0; j < 4; ++j) {
                        float v = s[kb][j] * sc2;
                        if (maskf) { const int d = qpos - (kstart + hk * 32 + kb * 16 + fq * 4 + j); if (d > 128 || d < -128) v = -1e30f; }
                        s[kb][j] = v; mx = fmaxf(mx, v);
                    }
                mx = fmaxf(mx, __shfl_xor(mx, 16)); mx = fmaxf(mx, __shfl_xor(mx, 32));
                const float mn = fmaxf(mrow[qg], mx), alpha = exp2f(mrow[qg] - mn);
                mrow[qg] = mn;
                float ps = 0.f;
#pragma unroll
                for (int kb = 0; kb < 2; ++kb)
#pragma unroll
                    for (int j = 0; j < 4; ++j) { const float pv = exp2f(s[kb][j] - mn); s[kb][j] = pv; ps += pv; }
                lsum[qg] = lsum[qg] * alpha + ps;
#pragma unroll
                for (int di = 0; di < 4; ++di) { o[qg][di][0] *= alpha; o[qg][di][1] *= alpha; o[qg][di][2] *= alpha; o[qg][di][3] *= alpha; }
                uint4 pu; pu.x = pack_bf16(s[0][0], s[0][1]); pu.y = pack_bf16(s[0][2], s[0][3]); pu.z = pack_bf16(s[1][0], s[1][1]); pu.w = pack_bf16(s[1][2], s[1][3]);
                const bf16x8 pf = as_bf16x8(pu);
#pragma unroll
                for (int di = 0; di < 4; ++di) o[qg][di] = __builtin_amdgcn_mfma_f32_16x16x32_bf16(vf[di], pf, o[qg][di], 0, 0, 0);
            }
        }
        if (!have) break;
        cur = nxt; it = nit;
    }
#undef ATT_LOAD
#pragma unroll
    for (int qg = 0; qg < 2; ++qg) {
        float l = lsum[qg]; l += __shfl_xor(l, 16); l += __shfl_xor(l, 32);
        const float inv = 1.f / l;
        const int tok = seq_base + q0 + qg * 16 + fr;
#pragma unroll
        for (int di = 0; di < 4; ++di) {
            const f32x4 v = o[qg][di];
            *(uint2*)(ACT + (size_t)tok * ACTW + 768 + head * 64 + di * 16 + fq * 4) = make_uint2(pack_bf16(v[0] * inv, v[1] * inv), pack_bf16(v[2] * inv, v[3] * inv));
        }
    }
}

DEVINL void conva_tile(const Params& p, int chunk, int l, int tile, char* smem) {
    const int t = tid(), lane = t & 63, w = t >> 6;
    const int S = chunk == 0 ? 256 : 4096;
    const int tok0 = tile * 32, pos0 = tok0 % S, sb = tok0 - pos0;
    const bf16_t* Z = (const bf16_t*)(p.ws + OFF_Z);
    bf16_t* ACT = (bf16_t*)(p.ws + OFF_ACT);
    float* glu = (float*)smem;
    {
        const int chk = t & 31, r0 = t >> 5;
#pragma unroll
        for (int h = 0; h < 2; ++h) {
            uint4 a[4], b[4];
#pragma unroll
            for (int i = 0; i < 4; ++i) {
                const int r = r0 + 8 * (h * 4 + i), pos = pos0 - 15 + r, pc = min(max(pos, 0), S - 1);
                const bf16_t* src = Z + (size_t)(sb + pc) * INW + chk * 8;
                a[i] = *(const uint4*)(src + Z_AVAL); b[i] = *(const uint4*)(src + Z_AGATE);
            }
            SCHED_FENCE();
#pragma unroll
            for (int i = 0; i < 4; ++i) {
                const int r = r0 + 8 * (h * 4 + i), pos = pos0 - 15 + r;
                if (r < 62) {
                    const float keep = (pos >= 0 && pos < S) ? 1.f : 0.f;
                    float av[8], bv[8], g[8]; unpack8(a[i], av); unpack8(b[i], bv);
#pragma unroll
                    for (int e = 0; e < 8; ++e) g[e] = keep * av[e] * sigmoidf_(bv[e]);
                    float4* d = (float4*)(glu + r * 256 + chk * 8);
                    d[0] = make_float4(g[0], g[1], g[2], g[3]); d[1] = make_float4(g[4], g[5], g[6], g[7]);
                }
            }
        }
    }
    __syncthreads();
    {
        float wv[31];
#pragma unroll
        for (int k = 0; k < 31; ++k) wv[k] = p.w_conv_a[((size_t)l * 31 + k) * 256 + t];
        const float bias = p.b_conv_a[l * 256 + t];
        for (int i = 0; i < 32; ++i) {
            float s = bias;
#pragma unroll
            for (int k = 0; k < 31; ++k) s += wv[k] * glu[(i + k) * 256 + t];
            glu[i * 256 + t] = s;
        }
    }
    __syncthreads();
    {
        const float4 g = *(const float4*)(p.ln_g_a + l * 256 + lane * 4), b = *(const float4*)(p.ln_b_a + l * 256 + lane * 4);
#pragma unroll
        for (int i = 0; i < 8; ++i) {
            const int r = w * 8 + i;
            const float4 v = *(const float4*)(glu + r * 256 + lane * 4);
            const float mu = wave_sum(v.x + v.y + v.z + v.w) * (1.f / 256.f);
            const float d0 = v.x - mu, d1 = v.y - mu, d2 = v.z - mu, d3 = v.w - mu;
            const float var = wave_sum(d0 * d0 + d1 * d1 + d2 * d2 + d3 * d3) * (1.f / 256.f);
            const float rs = rsqrtf(var + EPS);
            float y0 = d0 * rs * g.x + b.x, y1 = d1 * rs * g.y + b.y, y2 = d2 * rs * g.z + b.z, y3 = d3 * rs * g.w + b.w;
            y0 *= sigmoidf_(y0); y1 *= sigmoidf_(y1); y2 *= sigmoidf_(y2); y3 *= sigmoidf_(y3);
            *(uint2*)(ACT + (size_t)(tok0 + r) * ACTW + 0 + lane * 4) = make_uint2(pack_bf16(y0, y1), pack_bf16(y2, y3));
        }
    }
}
DEVINL void pool_tile(const Params& p, int chunk, int l, int tile, char* smem) {
    const int t = tid();
    const int S = chunk == 0 ? 256 : 4096;
    const int tok0 = tile * 32, pos0 = tok0 % S, sb = tok0 - pos0;
    const bf16_t* Z = (const bf16_t*)(p.ws + OFF_Z);
    bf16_t* ACT = (bf16_t*)(p.ws + OFF_ACT);
    float* u = (float*)smem;
    {
        const int chk = t & 31, r0 = t >> 5;
        uint4 av[6];
#pragma unroll
        for (int i = 0; i < 6; ++i) { const int pos = pos0 - 8 + r0 + 8 * i, pc = min(max(pos, 0), S - 1); av[i] = *(const uint4*)(Z + (size_t)(sb + pc) * INW + Z_POOL + chk * 8); }
        SCHED_FENCE();
#pragma unroll
        for (int i = 0; i < 6; ++i) {
            const int r = r0 + 8 * i, pos = pos0 - 8 + r;
            float g[8]; unpack8(av[i], g);
            const float keep = (pos >= 0 && pos < S) ? 1.f : 0.f;
            float4* d = (float4*)(u + r * 256 + chk * 8);
            d[0] = make_float4(g[0] * keep, g[1] * keep, g[2] * keep, g[3] * keep); d[1] = make_float4(g[4] * keep, g[5] * keep, g[6] * keep, g[7] * keep);
        }
    }
    __syncthreads();
    const int gi = t >> 6, w2 = 1 << gi;
    for (int i = 0; i < 32; ++i) {
        const int pos = pos0 + i;
        float s = 0.f;
        for (int j = -w2; j < w2; ++j) s += u[(i + 8 + j) * 256 + t];
        const int lo = max(pos - w2, 0), hi = min(pos + w2, S);
        const float pooled = s / (float)(hi - lo) - u[(i + 8) * 256 + t];
        u[i * 256 + t] = pooled;
    }
    __syncthreads();
    float acc[32];
#pragma unroll
    for (int i = 0; i < 32; ++i) acc[i] = 0.f;
    const float* wp = p.w_pool + ((size_t)l * 4 + gi) * 4096 + (t & 63);
#pragma unroll 1
    for (int c0 = 0; c0 < 64; c0 += 16) {
        float wv[16];
#pragma unroll
        for (int c = 0; c < 16; ++c) wv[c] = wp[(c0 + c) * 64];
#pragma unroll
        for (int c = 0; c < 16; ++c) {
            const float* up = u + gi * 64 + c0 + c;
#pragma unroll
            for (int i = 0; i < 32; ++i) acc[i] += up[i * 256] * wv[c];
        }
    }
    const float ps = p.pool_scale[l * 256 + t];
#pragma unroll
    for (int i = 0; i < 32; ++i) {
        const float v = acc[i] * ps;
        ACT[(size_t)(tok0 + i) * ACTW + 256 + t] = (bf16_t)(pack_bf16(v, 0.f) & 0xffff);
    }
}
DEVINL void convc_tile(const Params& p, int chunk, int l, int tile) {
    const int t = tid();
    const int S = chunk == 0 ? 256 : 4096;
    const bf16_t* Z = (const bf16_t*)(p.ws + OFF_Z);
    bf16_t* ACT = (bf16_t*)(p.ws + OFF_ACT);
#pragma unroll 1
    for (int i = 0; i < 4; ++i) {
        const int item = i * 256 + t, chk = item & 31, tok = tile * 32 + (item >> 5), pos = tok % S;
        const bf16_t* zr = Z + (size_t)tok * INW + chk * 8;
        float uu[3][8];
#pragma unroll
        for (int j = 0; j < 3; ++j) {
            const int pp = pos + j - 1;
            if (pp >= 0 && pp < S) {
                const uint4 a = *(const uint4*)(zr + (j - 1) * INW + Z_SC), b = *(const uint4*)(zr + (j - 1) * INW + Z_SH);
                float av[8], bv[8]; unpack8(a, av); unpack8(b, bv);
#pragma unroll
                for (int e = 0; e < 8; ++e) uu[j][e] = av[e] * bv[e];
            } else {
#pragma unroll
                for (int e = 0; e < 8; ++e) uu[j][e] = 0.f;
            }
        }
        const uint4 sbv = *(const uint4*)(zr + Z_SB);
        float sbf[8], r[8]; unpack8(sbv, sbf);
        const float* wc = p.w_sc + (size_t)l * 768 + chk * 8;
#pragma unroll
        for (int e = 0; e < 8; ++e) r[e] = sbf[e] * (wc[e] * uu[0][e] + wc[256 + e] * uu[1][e] + wc[512 + e] * uu[2][e]);
        *(uint4*)(ACT + (size_t)tok * ACTW + 512 + chk * 8) = pack8(r);
    }
}
DEVINL void phase_branch(const Params& p, int chunk, int l, char* smem) {
    for (int tile = blockIdx.x; tile < 1280; tile += gridDim.x) {
        if (tile < 512) attn_unit(p, chunk, l, tile, smem);
        else if (tile < 768) conva_tile(p, chunk, l, tile - 512, smem);
        else if (tile < 1024) pool_tile(p, chunk, l, tile - 768, smem);
        else convc_tile(p, chunk, l, tile - 1024);
        __syncthreads();
    }
}

#define XB_TMO      128
#define XB_XCNT(j)  (256  + 64 * (j))
#define XB_XSUB(j)  (1280 + 64 * (j))
#define XB_XGEN(j)  (2304 + 64 * (j))
#define XB_TOP      3328
#define XB_TOPGEN   3392
#define XB_SPIN_CAP (1u << 20)
DEVINL unsigned xb_ld(unsigned* p) { return __hip_atomic_load(p, __ATOMIC_RELAXED, __HIP_MEMORY_SCOPE_AGENT); }
DEVINL unsigned xb_add(unsigned* p, unsigned v) { return __hip_atomic_fetch_add(p, v, __ATOMIC_RELAXED, __HIP_MEMORY_SCOPE_AGENT); }
DEVINL unsigned xb_xcc_id() { return (unsigned)__builtin_amdgcn_s_getreg((3 << 11) | 20) & 0xFu; }
#define XB_SPIN(cond, bar) do { unsigned _sp = 0; while (cond) { __builtin_amdgcn_s_sleep(1); \
    if ((++_sp & 255u) == 0u) { if (xb_ld(&(bar)[XB_TMO])) break; if (_sp > XB_SPIN_CAP) { atomicAdd(&(bar)[XB_TMO], 1u); break; } } } } while (0)
struct XcdBar { unsigned* bar; unsigned x, nloc, nx; };
DEVINL void xb_census(unsigned* bar, unsigned x, unsigned& nloc, unsigned& nx) {
    const unsigned G = gridDim.x;
    unsigned sum, cnt, mine, sp = 0u;
    for (;;) {
        sum = 0u; cnt = 0u; mine = 0u;
#pragma unroll
        for (unsigned j = 0; j < 16; ++j) { const unsigned c = xb_ld(&bar[XB_XCNT(j)]); sum += c; cnt += (c > 0u) ? 1u : 0u; mine = (j == x) ? c : mine; }
        if (sum == G) break;
        __builtin_amdgcn_s_sleep(1);
        if ((++sp & 255u) == 0u) { if (xb_ld(&bar[XB_TMO])) break; if (sp > XB_SPIN_CAP) { atomicAdd(&bar[XB_TMO], 1u); break; } }
    }
    nloc = mine > 0u ? mine : 1u; nx = cnt > 0u ? cnt : 1u;
}
DEVINL void gsync(XcdBar& b) {
    asm volatile("s_waitcnt vmcnt(0)" ::: "memory");
    __syncthreads();
    if (threadIdx.x == 0) {
        unsigned* bar = b.bar;
        __builtin_amdgcn_s_waitcnt(0);
        if (b.nloc == 0u) xb_census(bar, b.x, b.nloc, b.nx);
        const unsigned nloc = b.nloc, nx = b.nx;
        const unsigned old = xb_add(&bar[XB_XSUB(b.x)], 1u);
        const unsigned gen = old / nloc;
        if (old + 1u == (gen + 1u) * nloc) {
            __builtin_amdgcn_fence(__ATOMIC_RELEASE, "agent");
            asm volatile("s_waitcnt vmcnt(0)" ::: "memory");
            const unsigned og = xb_add(&bar[XB_TOP], 1u);
            const unsigned tg = og / nx;
            if (og + 1u == (tg + 1u) * nx) xb_add(&bar[XB_TOPGEN], 1u);
            else XB_SPIN(xb_ld(&bar[XB_TOPGEN]) == tg, bar);
            __builtin_amdgcn_fence(__ATOMIC_ACQUIRE, "agent");
            xb_add(&bar[XB_XGEN(b.x)], 1u);
            asm volatile("s_waitcnt vmcnt(0)" ::: "memory");
        } else {
            XB_SPIN(xb_ld(&bar[XB_XGEN(b.x)]) == gen, bar);
            __builtin_amdgcn_fence(__ATOMIC_ACQUIRE, "agent");
            asm volatile("s_waitcnt vmcnt(0)" ::: "memory");
        }
    }
    __syncthreads();
}
__global__ void __launch_bounds__(256, 2) mega(Params p) {
    __shared__ __attribute__((aligned(16))) char smem[65536];
    cg::grid_group grid = cg::this_grid();
    grid.sync();
    XcdBar xb; xb.bar = (unsigned*)(p.ws + OFF_BAR); xb.x = xb_xcc_id(); xb.nloc = 0u; xb.nx = 0u;
    if (threadIdx.x == 0) (void)xb_add(&xb.bar[XB_XCNT(xb.x)], 1u);
#pragma unroll 1
    for (int step = 0; step < NSTEPS; ++step) {
        int ph, ch = 0, l = 0;
        if (step == 0) ph = 8;
        else if (step == 1) ph = 9;
        else { const int s = step - 2; ch = s >> 4; const int r = s & 15; l = r >> 3; ph = r & 7; }
        const bf16_t* WT = (const bf16_t*)(p.ws + OFF_WT) + (size_t)l * W_LAYER;
        const bf16_t* H = (const bf16_t*)(p.ws + OFF_H);
        int kind = 0;
        GemmDesc g; g.A = H; g.W = WT; g.lda = LDH; g.ldb = LW1; g.K = D; g.nN = 8; g.epi = 1; g.l = l; g.chunk = ch;
        int rp_mode = 1, rp_which = 1, rp_hsel = 0, rp_lh = l;
        switch (ph) {
            case 8: kind = 3; break;
            case 9: kind = 1; rp_mode = 0; rp_hsel = 1; rp_lh = 0; break;
            case 0: g.W = WT + WO_IN; g.nN = 50; g.epi = 0; break;
            case 1: kind = 2; break;
            case 2: g.A = (const bf16_t*)(p.ws + OFF_ACT); g.lda = ACTW; g.W = WT + WO_A; g.ldb = LWM; g.K = 1280; g.epi = 3; break;
            case 3: g.W = WT + WO_O; break;
            case 4: kind = 1; rp_which = 1; rp_hsel = 2; break;
            case 5: g.W = WT + WO_F1; g.nN = 32; g.epi = 2; break;
            case 6: g.A = (const bf16_t*)(p.ws + OFF_HID); g.lda = LDHID; g.W = WT + WO_F2; g.ldb = LW4; g.K = DFF; break;
            default: kind = 1; rp_which = 2; rp_hsel = (l == 0) ? 1 : 0; rp_lh = 1; break;
        }
        if (kind == 0) phase_gemm_any(p, g, smem);
        else if (kind == 1) {
            const int nrep = (ph == 7 && l == 1 && ch < 2) ? 2 : 1;
#pragma unroll 1
            for (int rep = 0; rep < nrep; ++rep) {
                if (rep == 1) { ch += 1; rp_mode = 0; rp_which = 1; rp_hsel = 1; rp_lh = 0; }
                rowpass(p, ch, rp_mode, l, rp_which, rp_hsel, rp_lh);
            }
        }
        else if (kind == 2) phase_branch(p, ch, l, smem);
        else phase_prep(p, smem);
        if (step + 1 < NSTEPS) gsync(xb);
    }
}

extern "C" void kernel_launch(void* const* d_in, const int* in_sizes, int n_in, void* d_out, int out_size, void* d_ws, size_t ws_size, hipStream_t stream) {
    static int grid_blocks = 0;
    if (!grid_blocks) {
        int dev = 0, cus = 0, per_cu = 0;
        (void)hipGetDevice(&dev);
        (void)hipDeviceGetAttribute(&cus, hipDeviceAttributeMultiprocessorCount, dev);
        (void)hipOccupancyMaxActiveBlocksPerMultiprocessor(&per_cu, mega, 256, 0);
        if (per_cu > 2) per_cu = 2;
        if (per_cu < 1) per_cu = 1;
        grid_blocks = cus * per_cu;
    }
    Params p{};
    const float** pp = (const float**)&p;
    for (int i = 0; i < 28; ++i) pp[i] = (const float*)d_in[i];
    p.out = (float*)d_out;
    p.ws = (char*)d_ws;
    (void)hipMemsetAsync((char*)d_ws + OFF_BAR, 0, 16384, stream);
    void* args[] = {&p};
    hipError_t e = hipLaunchCooperativeKernel((void*)mega, dim3(grid_blocks), dim3(256), args, 0, stream);
    if (e != hipSuccess) fprintf(stderr, "cooperative launch failed: %s (grid %d)\n", hipGetErrorString(e), grid_blocks);
}
```

```cpp
#include <hip/hip_runtime.h>
#include <hip/hip_cooperative_groups.h>
#include <stdint.h>
#include <cstdio>
namespace cg = cooperative_groups;

typedef unsigned short bf16_t;
typedef short bf16x8 __attribute__((ext_vector_type(8)));
typedef short bf16x4 __attribute__((ext_vector_type(4)));
typedef float f32x4 __attribute__((ext_vector_type(4)));
typedef unsigned u32x4 __attribute__((ext_vector_type(4)));
#define DEVINL __device__ __forceinline__

constexpr int D = 1024, INW = 6400, CH = 8192  , ACTW = 1344  , DFF = 4096;
constexpr int LDH = 1088, LDHID = 4160, LW1 = 1088, LWM = 1344, LW4 = 4160;
constexpr int Z_AVAL = 0, Z_AGATE = 256, Z_POOL = 512, Z_SB = 768, Z_SC = 1024, Z_SH = 1280, Z_Q = 1536, Z_K = 2048, Z_V = 2176, Z_G = 2304;
constexpr float EPS = 1e-6f;
#ifndef NSTEPS
#define NSTEPS 50
#endif
constexpr size_t WO_IN = 0, WO_A = WO_IN + (size_t)6400 * LW1, WO_O = WO_A + (size_t)1024 * LWM, WO_F1 = WO_O + (size_t)1024 * LW1, WO_F2 = WO_F1 + (size_t)4096 * LW1,
                 W_LAYER = WO_F2 + (size_t)1024 * LW4;
constexpr size_t OFF_WT = 0, OFF_MOD = OFF_WT + 2 * W_LAYER * 2, OFF_CKV = OFF_MOD + 2 * 5 * 6144 * 4, OFF_TAB = OFF_CKV + 2 * 262144 * 2,
                 OFF_H = OFF_TAB + 8192, OFF_ACT = OFF_H + (size_t)CH * LDH * 2, OFF_Z = OFF_ACT + (size_t)CH * ACTW * 2,
                 OFF_MF = OFF_Z, OFF_HID = OFF_Z + (size_t)CH * D * 4, OFF_BAR = OFF_Z + (size_t)CH * INW * 2;
constexpr size_t OUT_K = 25165824, OUT_V = 27262976;

struct Params {
    const float *x_prompt, *x_sample, *cache_k, *cache_v, *c, *c_ctx, *w_ada, *b_ada, *g_pre_mix, *g_post_mix, *g_pre_ffn, *g_post_ffn, *w_in,
        *w_conv_a, *b_conv_a, *ln_g_a, *ln_b_a, *w_a_out, *w_pool, *pool_scale, *w_b_out, *w_sc, *w_c_out, *sink, *w_d_out, *w_o, *w_ff1, *w_ff2;
    float* out;
    char* ws;
};

DEVINL int tid() { int t = threadIdx.x; asm volatile("" : "+v"(t)); return t; }
DEVINL float bf_lo(uint32_t u) { return __uint_as_float(u << 16); }
DEVINL float bf_hi(uint32_t u) { return __uint_as_float(u & 0xffff0000u); }
typedef __bf16 bf16x2_t __attribute__((ext_vector_type(2)));
typedef float f32x2_t __attribute__((ext_vector_type(2)));
DEVINL uint32_t pack_bf16(float lo, float hi) { const f32x2_t v = {lo, hi}; const bf16x2_t b = __builtin_convertvector(v, bf16x2_t); return __builtin_bit_cast(uint32_t, b); }
DEVINL void unpack8(const uint4& u, float (&f)[8]) {
    f[0] = bf_lo(u.x); f[1] = bf_hi(u.x); f[2] = bf_lo(u.y); f[3] = bf_hi(u.y); f[4] = bf_lo(u.z); f[5] = bf_hi(u.z); f[6] = bf_lo(u.w); f[7] = bf_hi(u.w);
}
DEVINL uint4 pack8(const float (&f)[8]) { uint4 u; u.x = pack_bf16(f[0], f[1]); u.y = pack_bf16(f[2], f[3]); u.z = pack_bf16(f[4], f[5]); u.w = pack_bf16(f[6], f[7]); return u; }
DEVINL float sigmoidf_(float x) { return 1.f / (1.f + __expf(-x)); }
DEVINL float wave_sum(float v) {
#pragma unroll
    for (int o = 32; o > 0; o >>= 1) v += __shfl_xor(v, o);
    return v;
}
DEVINL bf16x8 as_bf16x8(const uint4& u) { union { uint4 a; bf16x8 b; } x; x.a = u; return x.b; }

#define SCHED_FENCE() __builtin_amdgcn_sched_barrier(0)
template <bool FKK>
DEVINL void gemm_compute(const char* cur, int aoff, int boff, int fq, int sw, f32x4 (&acc)[4][4]) {
    bf16x8 af[2][4], bfr[2][4];
    __builtin_amdgcn_s_waitcnt(0xC07F);
#pragma unroll
    for (int kk = 0; kk < 2; ++kk) {
        const int co = ((kk * 4 + fq) ^ sw) << 4;
#pragma unroll
        for (int i = 0; i < 4; ++i) { af[kk][i] = *(const bf16x8*)(cur + aoff + i * 2048 + co); bfr[kk][i] = *(const bf16x8*)(cur + boff + i * 2048 + co); }
    }
    __builtin_amdgcn_s_setprio(1);
#pragma unroll
    for (int kk = 0; kk < 2; ++kk)
#pragma unroll
        for (int mi = 0; mi < 4; ++mi)
#pragma unroll
            for (int ni = 0; ni < 4; ++ni) acc[mi][ni] = __builtin_amdgcn_mfma_f32_16x16x32_bf16(bfr[kk][ni], af[kk][mi], acc[mi][ni], 0, 0, 0);
    __builtin_amdgcn_s_setprio(0);
}
struct NoHook { DEVINL void operator()(int, f32x4 (&)[4][4]) const {} };
template <int DEPTH, class Hook = NoHook>
DEVINL void gemm_loop(const bf16_t* __restrict__ A, int lda, const bf16_t* __restrict__ B, int ldb, int K, char* smem, f32x4 (&acc)[4][4], const Hook& hook = Hook()) {
    const int t = tid(), lane = t & 63, w = t >> 6, wm = w >> 1, wn = w & 1, fr = lane & 15, fq = lane >> 4;
    const int sc = t & 7, sr = t >> 3;
    const bf16_t* ag = A + (size_t)sr * lda + sc * 8;
    const bf16_t* bg = B + (size_t)sr * ldb + sc * 8;
    const int soff = sr * 128 + ((sc ^ ((sr >> 1) & 7)) << 4);
    const int aoff = (wm * 64 + fr) * 128, boff = 16384 + (wn * 64 + fr) * 128, sw = (fr >> 1) & 7;
    const int nk = K >> 6;
    u32x4 r0a[4], r0b[4], r1a[4], r1b[4];
#define G_LOAD(RA, RB, KT) { _Pragma("unroll") for (int i = 0; i < 4; ++i) { RA[i] = *(const u32x4*)(ag + (size_t)i * 32 * lda + (KT) * 64); RB[i] = *(const u32x4*)(bg + (size_t)i * 32 * ldb + (KT) * 64); } }
#define G_STORE(RA, RB, BUF) { _Pragma("unroll") for (int i = 0; i < 4; ++i) { *(u32x4*)(smem + (BUF) * 32768 + soff + i * 4096) = RA[i]; *(u32x4*)(smem + (BUF) * 32768 + 16384 + soff + i * 4096) = RB[i]; } }
    G_LOAD(r0a, r0b, 0);
    G_LOAD(r1a, r1b, 1);
    SCHED_FENCE();
    __syncthreads();
    G_STORE(r0a, r0b, 0);
    __syncthreads();
    for (int kt = 0; kt < nk; kt += 2) {
        G_LOAD(r0a, r0b, min(kt + 2, nk - 1));
        SCHED_FENCE();
        gemm_compute<false>(smem, aoff, boff, fq, sw, acc);
        SCHED_FENCE();
        G_STORE(r1a, r1b, 1);
        __syncthreads();
        G_LOAD(r1a, r1b, min(kt + 3, nk - 1));
        SCHED_FENCE();
        gemm_compute<false>(smem + 32768, aoff, boff, fq, sw, acc);
        SCHED_FENCE();
        hook(kt + 1, acc);
        G_STORE(r0a, r0b, 0);
        __syncthreads();
    }
#undef G_LOAD
#undef G_STORE
}
#define LAS3 __attribute__((address_space(3)))
template <class Hook = NoHook>
DEVINL void gemm_loop_dma(const bf16_t* __restrict__ A, int lda, const bf16_t* __restrict__ B, int ldb, int K, char* smem, f32x4 (&acc)[4][4], const Hook& hook,
                          const bf16_t* An, const bf16_t* Bn, bool pre) {
    const int t = tid(), lane = t & 63, w = __builtin_amdgcn_readfirstlane(t >> 6)  , wm = w >> 1, wn = w & 1, fr = lane & 15, fq = lane >> 4;
    const int sc = t & 7, sr = t >> 3;
    const int srp = 8 * ((sr & 15) >> 2) + 4 * (sr >> 4) + (sr & 3);
    const unsigned voA = (unsigned)(sr * lda + ((sc ^ ((sr >> 1) & 7)) << 3)) * 2u, voB = (unsigned)(srp * ldb + ((sc ^ ((sr >> 1) & 7)) << 3)) * 2u;
    const __amdgpu_buffer_rsrc_t srdA = __builtin_amdgcn_make_buffer_rsrc((void*)A, (short)0, 0x7fffffff, 0x00020000);
    const __amdgpu_buffer_rsrc_t srdB = __builtin_amdgcn_make_buffer_rsrc((void*)B, (short)0, 0x7fffffff, 0x00020000);
    const int aoff = (wm * 64 + fr) * 128, boff = 16384 + (wn * 64 + fr) * 128, sw = (fr >> 1) & 7;
    const int nk = K >> 6;
    LAS3 char* lds = (LAS3 char*)smem;
    const unsigned ldsb = (unsigned)__builtin_amdgcn_readfirstlane((int)(unsigned)(unsigned long)lds) + (unsigned)w * 1024u;
    const int stepA = 32 * lda * 2, stepB = 32 * ldb * 2;
#define D_ONE(SRD, VO, SOFF, M0V) asm volatile("s_mov_b32 m0, %0\n\ts_nop 0\n\tbuffer_load_dwordx4 %1, %2, %3 offen lds" :: "s"(M0V), "v"(VO), "s"(SRD), "s"(SOFF) : "m0", "memory")
#define D_ISSUE(BUF, KT) { _Pragma("unroll") for (int i = 0; i < 4; ++i) { \
        D_ONE(srdA, voA, (KT) * 128 + i * stepA, ldsb + (BUF) * 32768 + i * 4096); \
        D_ONE(srdB, voB, (KT) * 128 + i * stepB, ldsb + (BUF) * 32768 + 16384 + i * 4096); } }
#define D_WAIT() { asm volatile("s_waitcnt vmcnt(0)" ::: "memory"); __builtin_amdgcn_s_barrier(); asm volatile("" ::: "memory"); }
    if (!pre) D_ISSUE(0, 0);
    D_WAIT();
    for (int kt = 0; kt < nk; kt += 2) {
        D_ISSUE(1, kt + 1);
        SCHED_FENCE();
        gemm_compute<false>(smem, aoff, boff, fq, sw, acc);
        SCHED_FENCE();
        D_WAIT();
        if (kt + 2 < nk) D_ISSUE(0, kt + 2)
        else if (An) {
            const __amdgpu_buffer_rsrc_t srdA2 = __builtin_amdgcn_make_buffer_rsrc((void*)An, (short)0, 0x7fffffff, 0x00020000);
            const __amdgpu_buffer_rsrc_t srdB2 = __builtin_amdgcn_make_buffer_rsrc((void*)Bn, (short)0, 0x7fffffff, 0x00020000);
#pragma unroll
            for (int i = 0; i < 4; ++i) { D_ONE(srdA2, voA, i * stepA, ldsb + i * 4096); D_ONE(srdB2, voB, i * stepB, ldsb + 16384 + i * 4096); }
        }
        SCHED_FENCE();
        gemm_compute<false>(smem + 32768, aoff, boff, fq, sw, acc);
        SCHED_FENCE();
        hook(kt + 1, acc);
        if (kt + 2 < nk) D_WAIT();
    }
#undef D_ISSUE
#undef D_ONE
#undef D_WAIT
}
DEVINL void gemm_loop1(const bf16_t* __restrict__ A, int lda, const bf16_t* __restrict__ B, int ldb, int K, char* smem, f32x4 (&acc)[4][4]) {
    const int t = tid(), lane = t & 63, w = t >> 6, wm = w >> 1, wn = w & 1, fr = lane & 15, fq = lane >> 4;
    const int sc = t & 7, sr = t >> 3;
    const bf16_t* ag = A + (size_t)sr * lda + sc * 8;
    const bf16_t* bg = B + (size_t)sr * ldb + sc * 8;
    const int soff = sr * 128 + ((sc ^ ((sr >> 1) & 7)) << 4);
    u32x4 ra[4], rb[4];
    const int nk = K >> 6;
#pragma unroll
    for (int i = 0; i < 4; ++i) { ra[i] = *(const u32x4*)(ag + (size_t)i * 32 * lda); rb[i] = *(const u32x4*)(bg + (size_t)i * 32 * ldb); }
    __syncthreads();
#pragma unroll
    for (int i = 0; i < 4; ++i) { *(u32x4*)(smem + soff + i * 4096) = ra[i]; *(u32x4*)(smem + 16384 + soff + i * 4096) = rb[i]; }
    __syncthreads();
    const int aoff = (wm * 64 + fr) * 128, boff = 16384 + (wn * 64 + fr) * 128, sw = (fr >> 1) & 7;
    for (int kt = 0; kt < nk; ++kt) {
        const char* cur = smem + (kt & 1) * 32768;
        if (kt + 1 < nk) {
#pragma unroll
            for (int i = 0; i < 4; ++i) { ra[i] = *(const u32x4*)(ag + (size_t)i * 32 * lda + (kt + 1) * 64); rb[i] = *(const u32x4*)(bg + (size_t)i * 32 * ldb + (kt + 1) * 64); }
        }
        gemm_compute<false>(cur, aoff, boff, fq, sw, acc);
        if (kt + 1 < nk) {
            char* nxt = smem + ((kt + 1) & 1) * 32768;
#pragma unroll
            for (int i = 0; i < 4; ++i) { *(u32x4*)(nxt + soff + i * 4096) = ra[i]; *(u32x4*)(nxt + 16384 + soff + i * 4096) = rb[i]; }
        }
        __syncthreads();
    }
}
DEVINL void zero_acc(f32x4 (&acc)[4][4]) {
#pragma unroll
    for (int i = 0; i < 4; ++i)
#pragma unroll
        for (int j = 0; j < 4; ++j) acc[i][j] = (f32x4){0.f, 0.f, 0.f, 0.f};
}
DEVINL void tile_order(int t, int nN, int& pm, int& pn) { const int g = t / (8 * nN), r = t % (8 * nN); pn = r >> 3; pm = g * 8 + (r & 7); }
struct TileWalk {
    int nN, i, x, j, nb; bool xcd;
    DEVINL void init(int nN_) { nN = nN_; i = 0; xcd = (gridDim.x & 7) == 0; x = blockIdx.x & 7; j = blockIdx.x >> 3; nb = gridDim.x >> 3; }
    DEVINL bool next(int& pm, int& pn) {
        if (xcd) { const int s = i * nb + j; ++i; if (s >= 8 * nN) return false; pn = s >> 3; pm = x * 8 + (s & 7); return true; }
        const int t = blockIdx.x + i * gridDim.x; ++i; if (t >= 64 * nN) return false; tile_order(t, nN, pm, pn); return true;
    }
};

DEVINL void wt_tile2(const float* __restrict__ src, int K, int N, bf16_t* __restrict__ dst, int ldd, int tile0, char* smem) {
    const int nNt = N >> 6, t = tid();
    float* tl = (float*)smem;
    const int r = t >> 4, c4 = t & 15;
    f32x4 v[2][4];
#pragma unroll
    for (int u = 0; u < 2; ++u) {
        const int tile = tile0 + u, k0 = (tile / nNt) * 64, n0 = (tile % nNt) * 64;
#pragma unroll
        for (int i = 0; i < 4; ++i) v[u][i] = *(const f32x4*)(src + (size_t)(k0 + r + 16 * i) * N + n0 + c4 * 4);
    }
    asm volatile("" : "+v"(v[0][0]), "+v"(v[0][1]), "+v"(v[0][2]), "+v"(v[0][3]), "+v"(v[1][0]), "+v"(v[1][1]), "+v"(v[1][2]), "+v"(v[1][3]));
#pragma unroll
    for (int u = 0; u < 2; ++u)
#pragma unroll
        for (int i = 0; i < 4; ++i) { float* q = tl + u * 4160 + (r + 16 * i) * 65 + c4 * 4; q[0] = v[u][i][0]; q[1] = v[u][i][1]; q[2] = v[u][i][2]; q[3] = v[u][i][3]; }
    __syncthreads();
    const int n = t >> 2, kq = t & 3;
#pragma unroll
    for (int u = 0; u < 2; ++u) {
        const int tile = tile0 + u, k0 = (tile / nNt) * 64, n0 = (tile % nNt) * 64;
        uint32_t pk[8];
#pragma unroll
        for (int e = 0; e < 8; ++e) pk[e] = pack_bf16(tl[u * 4160 + (kq * 16 + 2 * e) * 65 + n], tl[u * 4160 + (kq * 16 + 2 * e + 1) * 65 + n]);
        uint4* o = (uint4*)(dst + (size_t)(n0 + n) * ldd + k0 + kq * 16);
        o[0] = make_uint4(pk[0], pk[1], pk[2], pk[3]); o[1] = make_uint4(pk[4], pk[5], pk[6], pk[7]);
    }
    __syncthreads();
}
DEVINL void mod_tile(const Params& p, int tile, char* smem) {
    const int l = tile / 96, n0 = (tile % 96) * 64, t = tid(), kg = t >> 6, col = t & 63;
    float* sl = (float*)smem;
    float* red = sl + 5 * 1024;
    for (int i = t; i < 5 * 1024; i += 256) { const int cb = i >> 10, k = i & 1023; const float x = cb == 0 ? p.c_ctx[k] : p.c[(cb - 1) * 1024 + k]; sl[i] = x * sigmoidf_(x); }
    __syncthreads();
    float a0 = 0.f, a1 = 0.f, a2 = 0.f, a3 = 0.f, a4 = 0.f;
    const float* wp = p.w_ada + ((size_t)l * 1024 + kg * 256) * 6144 + n0 + col;
#pragma unroll 1
    for (int k0 = 0; k0 < 256; k0 += 32) {
        float wv[32];
#pragma unroll
        for (int k = 0; k < 32; ++k) wv[k] = wp[(size_t)(k0 + k) * 6144];
        SCHED_FENCE();
#pragma unroll
        for (int k = 0; k < 32; ++k) {
            const int kk = kg * 256 + k0 + k;
            a0 += sl[kk] * wv[k]; a1 += sl[1024 + kk] * wv[k]; a2 += sl[2048 + kk] * wv[k]; a3 += sl[3072 + kk] * wv[k]; a4 += sl[4096 + kk] * wv[k];
        }
    }
    red[(kg * 5 + 0) * 64 + col] = a0; red[(kg * 5 + 1) * 64 + col] = a1; red[(kg * 5 + 2) * 64 + col] = a2; red[(kg * 5 + 3) * 64 + col] = a3; red[(kg * 5 + 4) * 64 + col] = a4;
    __syncthreads();
    float* mod = (float*)(p.ws + OFF_MOD);
    for (int i = t; i < 320; i += 256) {
        const int cb = i >> 6, cc = i & 63;
        const float s = red[(0 * 5 + cb) * 64 + cc] + red[(1 * 5 + cb) * 64 + cc] + red[(2 * 5 + cb) * 64 + cc] + red[(3 * 5 + cb) * 64 + cc];
        mod[((size_t)l * 5 + cb) * 6144 + n0 + cc] = s + p.b_ada[l * 6144 + n0 + cc];
    }
    __syncthreads();
}
DEVINL void phase_prep(const Params& p, char* smem) {
    const int t = tid();
    bf16_t* WT = (bf16_t*)(p.ws + OFF_WT);
    constexpr int NMOD = 192, NW = 4224  , NC = 256, NT = NMOD + NW + NC + 1;
    for (int tile = blockIdx.x; tile < NT; tile += gridDim.x) {
        if (tile < NMOD) mod_tile(p, tile, smem);
        else if (tile < NMOD + NW) {
            int wt = (tile - NMOD) * 2; const int l = wt / 4224; wt -= l * 4224;
            const float* src; int K, N, ldd; size_t dofs;
            if (wt < 1600) { src = p.w_in + (size_t)l * 1024 * 6400; K = 1024; N = 6400; ldd = LW1; dofs = WO_IN; }
            else if (wt < 1664) { wt -= 1600; src = p.w_a_out + (size_t)l * 256 * 1024; K = 256; N = 1024; ldd = LWM; dofs = WO_A; }
            else if (wt < 1728) { wt -= 1664; src = p.w_b_out + (size_t)l * 256 * 1024; K = 256; N = 1024; ldd = LWM; dofs = WO_A + 256; }
            else if (wt < 1792) { wt -= 1728; src = p.w_c_out + (size_t)l * 256 * 1024; K = 256; N = 1024; ldd = LWM; dofs = WO_A + 512; }
            else if (wt < 1920) { wt -= 1792; src = p.w_d_out + (size_t)l * 512 * 1024; K = 512; N = 1024; ldd = LWM; dofs = WO_A + 768; }
            else if (wt < 2176) { wt -= 1920; src = p.w_o + (size_t)l * 1024 * 1024; K = 1024; N = 1024; ldd = LW1; dofs = WO_O; }
            else if (wt < 3200) { wt -= 2176; src = p.w_ff1 + (size_t)l * 1024 * 4096; K = 1024; N = 4096; ldd = LW1; dofs = WO_F1; }
            else { wt -= 3200; src = p.w_ff2 + (size_t)l * 4096 * 1024; K = 4096; N = 1024; ldd = LW4; dofs = WO_F2; }
            wt_tile2(src, K, N, WT + (size_t)l * W_LAYER + dofs, ldd, wt, smem);
        } else if (tile < NMOD + NW + NC) {
            const int i = (tile - NMOD - NW) * 256 + t;
            const float* src = (i < 32768) ? p.cache_k + (size_t)i * 8 : p.cache_v + (size_t)(i - 32768) * 8;
            const float4 a = *(const float4*)src, b = *(const float4*)(src + 4);
            uint4 o; o.x = pack_bf16(a.x, a.y); o.y = pack_bf16(a.z, a.w); o.z = pack_bf16(b.x, b.y); o.w = pack_bf16(b.z, b.w);
            *(uint4*)(p.ws + OFF_CKV + (size_t)i * 16) = o;
        } else {
            float2* tab = (float2*)(p.ws + OFF_TAB);
            for (int i = t; i < 1024; i += 256) {
                const int pos = i >> 4, fi = i & 15;
                const float freq = exp2f(-(float)fi * (13.287712379549449f / 16.f));
                const float ang = (float)pos * freq;
                tab[i] = make_float2(__cosf(ang), __sinf(ang));
            }
        }
    }
}

DEVINL void rowpass(const Params& p, int chunk, int mode, int lpost, int which_post, int hsel, int lh) {
    const int lane = tid() & 63, w = tid() >> 6;
    const float* mod = (const float*)(p.ws + OFF_MOD);
    const bf16_t* MF = (const bf16_t*)(p.ws + OFF_MF);
    bf16_t* H = (bf16_t*)(p.ws + OFF_H);
    const float* xin = chunk == 0 ? p.x_prompt : p.x_sample + (size_t)(chunk - 1) * CH * D;
    float* xres = p.out + (size_t)chunk * CH * D;
    const float* xsrc = mode == 0 ? xin : xres;
    const float* gpost = which_post == 1 ? p.g_post_mix + lpost * D : p.g_post_ffn + lpost * D;
    const float* gpre = hsel == 1 ? p.g_pre_mix + lh * D : p.g_pre_ffn + lh * D;
    for (int base = (blockIdx.x * 4 + w) * 4; base < CH; base += gridDim.x * 16) {
        const int cb = chunk == 0 ? 0 : 1 + (chunk - 1) * 2 + (base >> 12);
        float pg[16], hg[16], hs[16];
        if (mode == 1) {
            const float* gate = mod + ((size_t)lpost * 5 + cb) * 6144 + (which_post == 1 ? 2 : 5) * 1024;
            float4 gp[4], gt[4];
#pragma unroll
            for (int i = 0; i < 4; ++i) { const int c = i * 256 + lane * 4; gp[i] = *(const float4*)(gpost + c); gt[i] = *(const float4*)(gate + c); }
            SCHED_FENCE();
#pragma unroll
            for (int i = 0; i < 4; ++i) { pg[4 * i] = gp[i].x * gt[i].x; pg[4 * i + 1] = gp[i].y * gt[i].y; pg[4 * i + 2] = gp[i].z * gt[i].z; pg[4 * i + 3] = gp[i].w * gt[i].w; }
        }
        if (hsel) {
            const float* mb = mod + ((size_t)lh * 5 + cb) * 6144 + (hsel == 1 ? 0 : 3) * 1024;
            float4 g[4], sh[4], sc[4];
#pragma unroll
            for (int i = 0; i < 4; ++i) { const int c = i * 256 + lane * 4; g[i] = *(const float4*)(gpre + c); sh[i] = *(const float4*)(mb + c); sc[i] = *(const float4*)(mb + 1024 + c); }
            SCHED_FENCE();
#pragma unroll
            for (int i = 0; i < 4; ++i) {
                hg[4 * i] = g[i].x * (1.f + sc[i].x); hg[4 * i + 1] = g[i].y * (1.f + sc[i].y); hg[4 * i + 2] = g[i].z * (1.f + sc[i].z); hg[4 * i + 3] = g[i].w * (1.f + sc[i].w);
                hs[4 * i] = sh[i].x; hs[4 * i + 1] = sh[i].y; hs[4 * i + 2] = sh[i].z; hs[4 * i + 3] = sh[i].w;
            }
        }
#pragma unroll 1
        for (int pr = 0; pr < 2; ++pr) {
            const int row0 = base + pr * 2;
            float x[2][16], m[2][16];
#pragma unroll
            for (int r = 0; r < 2; ++r)
#pragma unroll
                for (int i = 0; i < 4; ++i) {
                    const size_t o = (size_t)(row0 + r) * D + i * 256 + lane * 4;
                    const float4 v = *(const float4*)(xsrc + o);
                    x[r][4 * i] = v.x; x[r][4 * i + 1] = v.y; x[r][4 * i + 2] = v.z; x[r][4 * i + 3] = v.w;
                    if (mode == 1) { const uint2 q = *(const uint2*)(MF + o); m[r][4 * i] = bf_lo(q.x); m[r][4 * i + 1] = bf_hi(q.x); m[r][4 * i + 2] = bf_lo(q.y); m[r][4 * i + 3] = bf_hi(q.y); }
                }
            SCHED_FENCE();
#pragma unroll
            for (int r = 0; r < 2; ++r) {
                if (mode == 1) {
                    float ss = 0.f;
#pragma unroll
                    for (int i = 0; i < 16; ++i) ss += m[r][i] * m[r][i];
                    ss = wave_sum(ss);
                    const float rs = rsqrtf(ss * (1.f / D) + EPS);
#pragma unroll
                    for (int i = 0; i < 16; ++i) x[r][i] += (m[r][i] * rs) * pg[i];
                }
#pragma unroll
                for (int i = 0; i < 4; ++i) *(float4*)(xres + (size_t)(row0 + r) * D + i * 256 + lane * 4) = make_float4(x[r][4 * i], x[r][4 * i + 1], x[r][4 * i + 2], x[r][4 * i + 3]);
                if (hsel) {
                    float ss = 0.f;
#pragma unroll
                    for (int i = 0; i < 16; ++i) ss += x[r][i] * x[r][i];
                    ss = wave_sum(ss);
                    const float rs = rsqrtf(ss * (1.f / D) + EPS);
#pragma unroll
                    for (int i = 0; i < 4; ++i) {
                        const float h0 = x[r][4 * i] * rs * hg[4 * i] + hs[4 * i], h1 = x[r][4 * i + 1] * rs * hg[4 * i + 1] + hs[4 * i + 1];
                        const float h2 = x[r][4 * i + 2] * rs * hg[4 * i + 2] + hs[4 * i + 2], h3 = x[r][4 * i + 3] * rs * hg[4 * i + 3] + hs[4 * i + 3];
                        *(uint2*)(H + (size_t)(row0 + r) * LDH + i * 256 + lane * 4) = make_uint2(pack_bf16(h0, h1), pack_bf16(h2, h3));
                    }
                }
            }
        }
    }
}

DEVINL void unpack8u(const uint4& u, float (&f)[8]) { unpack8(u, f); }
struct MergeHook {
    const bf16_t* zg;
    bool on;
    DEVINL void operator()(int k, f32x4 (&acc)[4][4]) const {
        if (!on || (k & 3) != 3 || k > 11) return;
        const int b = k >> 2;
        const bf16_t* z = zg + b * 1024;
        uint4 ga[4][2], gb[4][2];
#pragma unroll
        for (int mi = 0; mi < 4; ++mi)
#pragma unroll
            for (int q = 0; q < 2; ++q) { ga[mi][q] = *(const uint4*)(z + (size_t)mi * 16 * INW + q * 32); gb[mi][q] = *(const uint4*)(z + 1024 + (size_t)mi * 16 * INW + q * 32); }
        SCHED_FENCE();
#pragma unroll
        for (int mi = 0; mi < 4; ++mi)
#pragma unroll
            for (int q = 0; q < 2; ++q) {
                float a[8], bb[8]; unpack8(ga[mi][q], a); unpack8(gb[mi][q], bb);
#pragma unroll
                for (int e = 0; e < 8; ++e) acc[mi][2 * q + (e >> 2)][e & 3] *= (1.f + __expf(-bb[e])) * __builtin_amdgcn_rcpf(1.f + __expf(-a[e]));
            }
    }
};
struct GemmDesc { const bf16_t* A; const bf16_t* W; int lda, ldb, K, nN, epi, l, chunk; };
DEVINL void phase_gemm_any(const Params& p, const GemmDesc& g, char* smem) {
    const int lane = tid() & 63, w = tid() >> 6, wm = w >> 1, wn = w & 1, fr = lane & 15, fq = lane >> 4;
    bf16_t* Z = (bf16_t*)(p.ws + OFF_Z);
    bf16_t* MF = (bf16_t*)(p.ws + OFF_MF);
    bf16_t* HID = (bf16_t*)(p.ws + OFF_HID);
    bf16_t* MG = (bf16_t*)(p.ws + OFF_H);
    TileWalk tw; tw.init(g.nN);
    int pm, pn, pm2 = 0, pn2 = 0;
    bool have = tw.next(pm, pn), pre = false;
    for (; have; pm = pm2, pn = pn2) {
        const bool have2 = tw.next(pm2, pn2);
        f32x4 acc[4][4]; zero_acc(acc);
        const int row0 = pm * 128 + wm * 64 + fr, col0 = pn * 128 + wn * 64 + fq * 8;
        MergeHook hook; hook.on = (g.epi == 3); hook.zg = Z + (size_t)row0 * INW + Z_G + col0;
        gemm_loop_dma(g.A + (size_t)pm * 128 * g.lda, g.lda, g.W + (size_t)pn * 128 * g.ldb, g.ldb, g.K, smem, acc, hook,
                      have2 ? g.A + (size_t)pm2 * 128 * g.lda : nullptr, have2 ? g.W + (size_t)pn2 * 128 * g.ldb : nullptr, pre);
        pre = have2; have = have2;
        if (g.epi == 0) {
            const bool kv = (g.chunk == 0) && (pn == 16 || pn == 17);
            bf16_t* zo = Z + (size_t)row0 * INW + col0;
            asm volatile("" : "+v"(zo));
#pragma unroll
            for (int mi = 0; mi < 4; ++mi)
#pragma unroll
                for (int q = 0; q < 2; ++q) {
                    const f32x4 v0 = acc[mi][2 * q], v1 = acc[mi][2 * q + 1];
                    *(uint4*)(zo + (size_t)mi * 16 * INW + q * 32) = make_uint4(pack_bf16(v0[0], v0[1]), pack_bf16(v0[2], v0[3]), pack_bf16(v1[0], v1[1]), pack_bf16(v1[2], v1[3]));
                    if (kv) {
                        const int row = row0 + mi * 16, cl = wn * 64 + q * 32 + fq * 8;
                        float* dst = p.out + (pn == 16 ? OUT_K : OUT_V) + ((size_t)((row >> 8) * 2 + g.l) * 256 + (row & 255)) * 128 + cl;
                        *(f32x4*)dst = v0; *(f32x4*)(dst + 4) = v1;
                    }
                }
        } else if (g.epi == 1) {
            bf16_t* mo = MF + (size_t)row0 * D + col0;
            asm volatile("" : "+v"(mo));
#pragma unroll
            for (int mi = 0; mi < 4; ++mi)
#pragma unroll
                for (int q = 0; q < 2; ++q) {
                    const f32x4 v0 = acc[mi][2 * q], v1 = acc[mi][2 * q + 1];
                    *(uint4*)(mo + (size_t)mi * 16 * D + q * 32) = make_uint4(pack_bf16(v0[0], v0[1]), pack_bf16(v0[2], v0[3]), pack_bf16(v1[0], v1[1]), pack_bf16(v1[2], v1[3]));
                }
        } else if (g.epi == 2) {
            bf16_t* ho = HID + (size_t)row0 * LDHID + col0;
            asm volatile("" : "+v"(ho));
#pragma unroll
            for (int mi = 0; mi < 4; ++mi)
#pragma unroll
                for (int q = 0; q < 2; ++q) {
                    float r[8];
#pragma unroll
                    for (int e = 0; e < 8; ++e) { const float x = fmaxf(acc[mi][2 * q + (e >> 2)][e & 3], 0.f); r[e] = x * x; }
                    *(uint4*)(ho + (size_t)mi * 16 * LDHID + q * 32) = pack8(r);
                }
        } else {
            const bf16_t* z3 = hook.zg + 3 * 1024;
            bf16_t* mg = MG + (size_t)row0 * LDH + col0;
            uint4 g3[4][2];
#pragma unroll
            for (int mi = 0; mi < 4; ++mi)
#pragma unroll
                for (int q = 0; q < 2; ++q) g3[mi][q] = *(const uint4*)(z3 + (size_t)mi * 16 * INW + q * 32);
            SCHED_FENCE();
#pragma unroll
            for (int mi = 0; mi < 4; ++mi)
#pragma unroll
                for (int q = 0; q < 2; ++q) {
                    float gg[8], r[8]; unpack8(g3[mi][q], gg);
#pragma unroll
                    for (int e = 0; e < 8; ++e) r[e] = acc[mi][2 * q + (e >> 2)][e & 3] * sigmoidf_(gg[e]);
                    *(uint4*)(mg + (size_t)mi * 16 * LDH + q * 32) = pack8(r);
                }
        }
    }
}

struct AttTile { const bf16_t* kptr; const bf16_t* vptr; int stride, kstart; bool rope, maskf; };
DEVINL bool att_tile(int it, bool is_ctx, const bf16_t* Zs, const bf16_t* CKb, int q0, int kvh, AttTile& d) {
    d.rope = false; d.maskf = false;
    if (is_ctx) { d.kstart = it * 64; d.kptr = Zs + (size_t)d.kstart * INW + Z_K + kvh * 64; d.vptr = d.kptr + 128; d.stride = INW; return true; }
    if (it < 5) {
        d.kstart = (q0 & ~63) - 128 + it * 64; d.stride = INW; d.rope = true; d.maskf = true;
        if (d.kstart < 0 || d.kstart >= 4096) return false;
        d.kptr = Zs + (size_t)d.kstart * INW + Z_K + kvh * 64; d.vptr = d.kptr + 128; return true;
    }
    d.kstart = (it - 5) * 64; d.kptr = CKb + (size_t)d.kstart * 128 + kvh * 64; d.vptr = d.kptr + 262144; d.stride = 128; return true;
}
DEVINL void attn_unit(const Params& p, int chunk, int layer, int unit, char* smem) {
    const int t = tid(), lane = t & 63, w = t >> 6, fr = lane & 15, fq = lane >> 4;
    const bool is_ctx = (chunk == 0);
    int seq_base, q0, kvh, bseq = 0;
    if (is_ctx) { seq_base = (unit >> 4) * 256; q0 = ((unit >> 1) & 7) * 32; kvh = unit & 1; }
    else { const int sl = unit >> 8; seq_base = sl * 4096; q0 = ((unit >> 1) & 127) * 32; kvh = unit & 1; bseq = (chunk - 1) * 2 + sl; }
    const int head = kvh * 4 + w;
    const bf16_t* Zs = (const bf16_t*)(p.ws + OFF_Z) + (size_t)seq_base * INW;
    const bf16_t* CKb = (const bf16_t*)(p.ws + OFF_CKV) + (size_t)(bseq * 2 + layer) * 256 * 128;
    const float2* tab = (const float2*)(p.ws + OFF_TAB);
    bf16_t* ACT = (bf16_t*)(p.ws + OFF_ACT);
    char* Ks = smem;
    bf16_t* Vt = (bf16_t*)(smem + 8192);
    constexpr int VS = 68;

    bf16x8 qf[2][2];
#pragma unroll
    for (int qg = 0; qg < 2; ++qg)
#pragma unroll
        for (int dh = 0; dh < 2; ++dh) {
            const int pos = q0 + qg * 16 + fr;
            uint4 u = *(const uint4*)(Zs + (size_t)pos * INW + Z_Q + head * 64 + dh * 32 + fq * 8);
            if (!is_ctx) {
                uint4 pu; pu.x = __shfl_xor((int)u.x, 32); pu.y = __shfl_xor((int)u.y, 32); pu.z = __shfl_xor((int)u.z, 32); pu.w = __shfl_xor((int)u.w, 32);
                float x[8], y[8]; unpack8(u, x); unpack8(pu, y);
                const int pi = dh == 0 ? (pos >> 6) : (pos & 63);
                const float2* tp = tab + pi * 16 + (fq & 1) * 8;
                const float sgn = fq < 2 ? -1.f : 1.f;
#pragma unroll
                for (int e = 0; e < 8; ++e) { const float2 cs = tp[e]; x[e] = x[e] * cs.x + sgn * y[e] * cs.y; }
                u = pack8(x);
            }
            qf[qg][dh] = as_bf16x8(u);
        }
    f32x4 o[2][4];
#pragma unroll
    for (int i = 0; i < 2; ++i)
#pragma unroll
        for (int j = 0; j < 4; ++j) o[i][j] = (f32x4){0.f, 0.f, 0.f, 0.f};
    const float sk2 = p.sink[layer * 8 + head] * 1.4426950408889634f;
    float mrow[2], lsum[2];
#pragma unroll
    for (int i = 0; i < 2; ++i) { mrow[i] = sk2; lsum[i] = fq == 0 ? 1.f : 0.f; }
    const float sc2 = 0.125f * 1.4426950408889634f;

    const int ntiles = is_ctx ? 4 : 9;
    const int key = t >> 2, cp = t & 3, c = (cp & 1) + ((cp >> 1) << 2);
    const int vkp = t & 31, vc = t >> 5;
    AttTile cur; int it = 0;
    while (!att_tile(it, is_ctx, Zs, CKb, q0, kvh, cur)) ++it;
    u32x4 ku1, ku2, vu0, vu1; float2 cs[8];
#define ATT_LOAD(d) { const bf16_t* src = (d).kptr + (size_t)key * (d).stride + c * 8; ku1 = *(const u32x4*)src; ku2 = *(const u32x4*)(src + 16); \
        const bf16_t* vs = (d).vptr + (size_t)(2 * vkp) * (d).stride + vc * 8; vu0 = *(const u32x4*)vs; vu1 = *(const u32x4*)(vs + (d).stride); \
        if ((d).rope) { const int kpos = (d).kstart + key, pi = c < 4 ? (kpos >> 6) : (kpos & 63); const float2* tp = tab + pi * 16 + (c & 1) * 8; \
            _Pragma("unroll") for (int e = 0; e < 8; ++e) cs[e] = tp[e]; } }
    ATT_LOAD(cur);
    for (;;) {
        __syncthreads();
        {
            uint4 u1 = make_uint4(ku1[0], ku1[1], ku1[2], ku1[3]), u2 = make_uint4(ku2[0], ku2[1], ku2[2], ku2[3]);
            if (cur.rope) {
                float x1[8], x2[8], o1[8], o2[8]; unpack8(u1, x1); unpack8(u2, x2);
#pragma unroll
                for (int e = 0; e < 8; ++e) { o1[e] = x1[e] * cs[e].x - x2[e] * cs[e].y; o2[e] = x2[e] * cs[e].x + x1[e] * cs[e].y; }
                u1 = pack8(o1); u2 = pack8(o2);
            }
            *(uint4*)(Ks + key * 128 + ((c ^ (key & 7)) << 4)) = u1;
            *(uint4*)(Ks + key * 128 + (((c + 2) ^ (key & 7)) << 4)) = u2;
            {
                uint32_t* dst = (uint32_t*)(Vt + (vc * 8) * VS + 2 * vkp);
#pragma unroll
                for (int m = 0; m < 4; ++m) {
                    dst[(2 * m) * (VS / 2)] = (vu0[m] & 0xffffu) | (vu1[m] << 16);
                    dst[(2 * m + 1) * (VS / 2)] = (vu0[m] >> 16) | (vu1[m] & 0xffff0000u);
                }
            }
        }
        __syncthreads();
        AttTile nxt; int nit = it + 1; bool have = false;
        while (nit < ntiles) { if (att_tile(nit, is_ctx, Zs, CKb, q0, kvh, nxt)) { have = true; break; } ++nit; }
        if (have) ATT_LOAD(nxt);
        SCHED_FENCE();
        const int kstart = cur.kstart; const bool maskf = cur.maskf;
        {
            bf16x8 kf[4][2], vf[2][4];
#pragma unroll
            for (int kb = 0; kb < 4; ++kb)
#pragma unroll
                for (int dh = 0; dh < 2; ++dh) { const int row = kb * 16 + fr; kf[kb][dh] = *(const bf16x8*)(Ks + row * 128 + (((dh * 4 + fq) ^ (row & 7)) << 4)); }
#pragma unroll
            for (int hk = 0; hk < 2; ++hk)
#pragma unroll
                for (int di = 0; di < 4; ++di) {
                    const bf16_t* vp = Vt + (di * 16 + fr) * VS + hk * 32 + fq * 4;
                    const bf16x4 lo = *(const bf16x4*)vp, hi = *(const bf16x4*)(vp + 16);
                    vf[hk][di] = __builtin_shufflevector(lo, hi, 0, 1, 2, 3, 4, 5, 6, 7);
                }
#pragma unroll
            for (int qg = 0; qg < 2; ++qg) {
                f32x4 s[4];
#pragma unroll
                for (int kb = 0; kb < 4; ++kb) {
                    s[kb] = __builtin_amdgcn_mfma_f32_16x16x32_bf16(kf[kb][0], qf[qg][0], (f32x4){0.f, 0.f, 0.f, 0.f}, 0, 0, 0);
                    s[kb] = __builtin_amdgcn_mfma_f32_16x16x32_bf16(kf[kb][1], qf[qg][1], s[kb], 0, 0, 0);
                }
                const int qpos = q0 + qg * 16 + fr;
                float mx = -1e30f;
#pragma unroll
                for (int kb = 0; kb < 4; ++kb)
#pragma unroll
                    for (int j = 0; j < 4; ++j) {
                        float v = s[kb][j] * sc2;
                        if (maskf) { const int d = qpos - (kstart + kb * 16 + fq * 4 + j); if (d > 128 || d < -128) v = -1e30f; }
                        s[kb][j] = v; mx = fmaxf(mx, v);
                    }
                mx = fmaxf(mx, __shfl_xor(mx, 16)); mx = fmaxf(mx, __shfl_xor(mx, 32));
                const float mn = fmaxf(mrow[qg], mx), alpha = exp2f(mrow[qg] - mn);
                mrow[qg] = mn;
                float ps = 0.f;
#pragma unroll
                for (int kb = 0; kb < 4; ++kb)
#pragma unroll
                    for (int j = 0; j < 4; ++j) { const float pv = exp2f(s[kb][j] - mn); s[kb][j] = pv; ps += pv; }
                lsum[qg] = lsum[qg] * alpha + ps;
#pragma unroll
                for (int di = 0; di < 4; ++di) { o[qg][di][0] *= alpha; o[qg][di][1] *= alpha; o[qg][di][2] *= alpha; o[qg][di][3] *= alpha; }
#pragma unroll
                for (int hk = 0; hk < 2; ++hk) {
                    uint4 pu; pu.x = pack_bf16(s[2 * hk][0], s[2 * hk][1]); pu.y = pack_bf16(s[2 * hk][2], s[2 * hk][3]);
                    pu.z = pack_bf16(s[2 * hk + 1][0], s[2 * hk + 1][1]); pu.w = pack_bf16(s[2 * hk + 1][2], s[2 * hk + 1][3]);
                    const bf16x8 pf = as_bf16x8(pu);
#pragma unroll
                    for (int di = 0; di < 4; ++di) o[qg][di] = __builtin_amdgcn_mfma_f32_16x16x32_bf16(vf[hk][di], pf, o[qg][di], 0, 0, 0);
                }
            }
        }
        if (!have) break;
        cur = nxt; it = nit;
    }
#undef ATT_LOAD
#pragma unroll
    for (int qg = 0; qg < 2; ++qg) {
        float l = lsum[qg]; l += __shfl_xor(l, 16); l += __shfl_xor(l, 32);
        const float inv = 1.f / l;
        const int tok = seq_base + q0 + qg * 16 + fr;
#pragma unroll
        for (int di = 0; di < 4; ++di) {
            const f32x4 v = o[qg][di];
            *(uint2*)(ACT + (size_t)tok * ACTW + 768 + head * 64 + di * 16 + fq * 4) = make_uint2(pack_bf16(v[0] * inv, v[1] * inv), pack_bf16(v[2] * inv, v[3] * inv));
        }
    }
}

DEVINL void conva_tile(const Params& p, int chunk, int l, int tile, char* smem) {
    const int t = tid(), lane = t & 63, w = t >> 6;
    const int S = chunk == 0 ? 256 : 4096;
    const int tok0 = tile * 32, pos0 = tok0 % S, sb = tok0 - pos0;
    const bf16_t* Z = (const bf16_t*)(p.ws + OFF_Z);
    bf16_t* ACT = (bf16_t*)(p.ws + OFF_ACT);
    float* glu = (float*)smem;
    {
        const int chk = t & 31, r0 = t >> 5;
#pragma unroll
        for (int h = 0; h < 2; ++h) {
            uint4 a[4], b[4];
#pragma unroll
            for (int i = 0; i < 4; ++i) {
                const int r = r0 + 8 * (h * 4 + i), pos = pos0 - 15 + r, pc = min(max(pos, 0), S - 1);
                const bf16_t* src = Z + (size_t)(sb + pc) * INW + chk * 8;
                a[i] = *(const uint4*)(src + Z_AVAL); b[i] = *(const uint4*)(src + Z_AGATE);
            }
            SCHED_FENCE();
#pragma unroll
            for (int i = 0; i < 4; ++i) {
                const int r = r0 + 8 * (h * 4 + i), pos = pos0 - 15 + r;
                if (r < 62) {
                    const float keep = (pos >= 0 && pos < S) ? 1.f : 0.f;
                    float av[8], bv[8], g[8]; unpack8(a[i], av); unpack8(b[i], bv);
#pragma unroll
                    for (int e = 0; e < 8; ++e) g[e] = keep * av[e] * sigmoidf_(bv[e]);
                    float4* d = (float4*)(glu + r * 256 + chk * 8);
                    d[0] = make_float4(g[0], g[1], g[2], g[3]); d[1] = make_float4(g[4], g[5], g[6], g[7]);
                }
            }
        }
    }
    __syncthreads();
    {
        float wv[31];
#pragma unroll
        for (int k = 0; k < 31; ++k) wv[k] = p.w_conv_a[((size_t)l * 31 + k) * 256 + t];
        const float bias = p.b_conv_a[l * 256 + t];
        for (int i = 0; i < 32; ++i) {
            float s = bias;
#pragma unroll
            for (int k = 0; k < 31; ++k) s += wv[k] * glu[(i + k) * 256 + t];
            glu[i * 256 + t] = s;
        }
    }
    __syncthreads();
    {
        const float4 g = *(const float4*)(p.ln_g_a + l * 256 + lane * 4), b = *(const float4*)(p.ln_b_a + l * 256 + lane * 4);
#pragma unroll
        for (int i = 0; i < 8; ++i) {
            const int r = w * 8 + i;
            const float4 v = *(const float4*)(glu + r * 256 + lane * 4);
            const float mu = wave_sum(v.x + v.y + v.z + v.w) * (1.f / 256.f);
            const float d0 = v.x - mu, d1 = v.y - mu, d2 = v.z - mu, d3 = v.w - mu;
            const float var = wave_sum(d0 * d0 + d1 * d1 + d2 * d2 + d3 * d3) * (1.f / 256.f);
            const float rs = rsqrtf(var + EPS);
            float y0 = d0 * rs * g.x + b.x, y1 = d1 * rs * g.y + b.y, y2 = d2 * rs * g.z + b.z, y3 = d3 * rs * g.w + b.w;
            y0 *= sigmoidf_(y0); y1 *= sigmoidf_(y1); y2 *= sigmoidf_(y2); y3 *= sigmoidf_(y3);
            *(uint2*)(ACT + (size_t)(tok0 + r) * ACTW + 0 + lane * 4) = make_uint2(pack_bf16(y0, y1), pack_bf16(y2, y3));
        }
    }
}
DEVINL void pool_tile(const Params& p, int chunk, int l, int tile, char* smem) {
    const int t = tid();
    const int S = chunk == 0 ? 256 : 4096;
    const int tok0 = tile * 32, pos0 = tok0 % S, sb = tok0 - pos0;
    const bf16_t* Z = (const bf16_t*)(p.ws + OFF_Z);
    bf16_t* ACT = (bf16_t*)(p.ws + OFF_ACT);
    float* u = (float*)smem;
    {
        const int chk = t & 31, r0 = t >> 5;
        uint4 av[6];
#pragma unroll
        for (int i = 0; i < 6; ++i) { const int pos = pos0 - 8 + r0 + 8 * i, pc = min(max(pos, 0), S - 1); av[i] = *(const uint4*)(Z + (size_t)(sb + pc) * INW + Z_POOL + chk * 8); }
        SCHED_FENCE();
#pragma unroll
        for (int i = 0; i < 6; ++i) {
            const int r = r0 + 8 * i, pos = pos0 - 8 + r;
            float g[8]; unpack8(av[i], g);
            const float keep = (pos >= 0 && pos < S) ? 1.f : 0.f;
            float4* d = (float4*)(u + r * 256 + chk * 8);
            d[0] = make_float4(g[0] * keep, g[1] * keep, g[2] * keep, g[3] * keep); d[1] = make_float4(g[4] * keep, g[5] * keep, g[6] * keep, g[7] * keep);
        }
    }
    __syncthreads();
    const int gi = t >> 6, w2 = 1 << gi;
    for (int i = 0; i < 32; ++i) {
        const int pos = pos0 + i;
        float s = 0.f;
        for (int j = -w2; j < w2; ++j) s += u[(i + 8 + j) * 256 + t];
        const int lo = max(pos - w2, 0), hi = min(pos + w2, S);
        const float pooled = s / (float)(hi - lo) - u[(i + 8) * 256 + t];
        u[i * 256 + t] = pooled;
    }
    __syncthreads();
    float acc[32];
#pragma unroll
    for (int i = 0; i < 32; ++i) acc[i] = 0.f;
    const float* wp = p.w_pool + ((size_t)l * 4 + gi) * 4096 + (t & 63);
#pragma unroll 1
    for (int c0 = 0; c0 < 64; c0 += 16) {
        float wv[16];
#pragma unroll
        for (int c = 0; c < 16; ++c) wv[c] = wp[(c0 + c) * 64];
#pragma unroll
        for (int c = 0; c < 16; ++c) {
            const float* up = u + gi * 64 + c0 + c;
#pragma unroll
            for (int i = 0; i < 32; ++i) acc[i] += up[i * 256] * wv[c];
        }
    }
    const float ps = p.pool_scale[l * 256 + t];
#pragma unroll
    for (int i = 0; i < 32; ++i) {
        const float v = acc[i] * ps;
        ACT[(size_t)(tok0 + i) * ACTW + 256 + t] = (bf16_t)(pack_bf16(v, 0.f) & 0xffff);
    }
}
DEVINL void convc_tile(const Params& p, int chunk, int l, int tile) {
    const int t = tid();
    const int S = chunk == 0 ? 256 : 4096;
    const bf16_t* Z = (const bf16_t*)(p.ws + OFF_Z);
    bf16_t* ACT = (bf16_t*)(p.ws + OFF_ACT);
#pragma unroll 1
    for (int i = 0; i < 4; ++i) {
        const int item = i * 256 + t, chk = item & 31, tok = tile * 32 + (item >> 5), pos = tok % S;
        const bf16_t* zr = Z + (size_t)tok * INW + chk * 8;
        float uu[3][8];
#pragma unroll
        for (int j = 0; j < 3; ++j) {
            const int pp = pos + j - 1;
            if (pp >= 0 && pp < S) {
                const uint4 a = *(const uint4*)(zr + (j - 1) * INW + Z_SC), b = *(const uint4*)(zr + (j - 1) * INW + Z_SH);
                float av[8], bv[8]; unpack8(a, av); unpack8(b, bv);
#pragma unroll
                for (int e = 0; e < 8; ++e) uu[j][e] = av[e] * bv[e];
            } else {
#pragma unroll
                for (int e = 0; e < 8; ++e) uu[j][e] = 0.f;
            }
        }
        const uint4 sbv = *(const uint4*)(zr + Z_SB);
        float sbf[8], r[8]; unpack8(sbv, sbf);
        const float* wc = p.w_sc + (size_t)l * 768 + chk * 8;
#pragma unroll
        for (int e = 0; e < 8; ++e) r[e] = sbf[e] * (wc[e] * uu[0][e] + wc[256 + e] * uu[1][e] + wc[512 + e] * uu[2][e]);
        *(uint4*)(ACT + (size_t)tok * ACTW + 512 + chk * 8) = pack8(r);
    }
}
DEVINL void phase_branch(const Params& p, int chunk, int l, char* smem) {
    for (int tile = blockIdx.x; tile < 1280; tile += gridDim.x) {
        if (tile < 512) attn_unit(p, chunk, l, tile, smem);
        else if (tile < 768) conva_tile(p, chunk, l, tile - 512, smem);
        else if (tile < 1024) pool_tile(p, chunk, l, tile - 768, smem);
        else convc_tile(p, chunk, l, tile - 1024);
        __syncthreads();
    }
}

#define XB_TMO      128
#define XB_XCNT(j)  (256  + 64 * (j))
#define XB_XSUB(j)  (1280 + 64 * (j))
#define XB_XGEN(j)  (2304 + 64 * (j))
#define XB_TOP      3328
#define XB_TOPGEN   3392
#define XB_SPIN_CAP (1u << 20)
DEVINL unsigned xb_ld(unsigned* p) { return __hip_atomic_load(p, __ATOMIC_RELAXED, __HIP_MEMORY_SCOPE_AGENT); }
DEVINL unsigned xb_add(unsigned* p, unsigned v) { return __hip_atomic_fetch_add(p, v, __ATOMIC_RELAXED, __HIP_MEMORY_SCOPE_AGENT); }
DEVINL unsigned xb_xcc_id() { return (unsigned)__builtin_amdgcn_s_getreg((3 << 11) | 20) & 0xFu; }
#define XB_SPIN(cond, bar) do { unsigned _sp = 0; while (cond) { __builtin_amdgcn_s_sleep(1); \
    if ((++_sp & 255u) == 0u) { if (xb_ld(&(bar)[XB_TMO])) break; if (_sp > XB_SPIN_CAP) { atomicAdd(&(bar)[XB_TMO], 1u); break; } } } } while (0)
struct XcdBar { unsigned* bar; unsigned x, nloc, nx; };
DEVINL void xb_census(unsigned* bar, unsigned x, unsigned& nloc, unsigned& nx) {
    const unsigned G = gridDim.x;
    unsigned sum, cnt, mine, sp = 0u;
    for (;;) {
        sum = 0u; cnt = 0u; mine = 0u;
#pragma unroll
        for (unsigned j = 0; j < 16; ++j) { const unsigned c = xb_ld(&bar[XB_XCNT(j)]); sum += c; cnt += (c > 0u) ? 1u : 0u; mine = (j == x) ? c : mine; }
        if (sum == G) break;
        __builtin_amdgcn_s_sleep(1);
        if ((++sp & 255u) == 0u) { if (xb_ld(&bar[XB_TMO])) break; if (sp > XB_SPIN_CAP) { atomicAdd(&bar[XB_TMO], 1u); break; } }
    }
    nloc = mine > 0u ? mine : 1u; nx = cnt > 0u ? cnt : 1u;
}
DEVINL void gsync(XcdBar& b) {
    asm volatile("s_waitcnt vmcnt(0)" ::: "memory");
    __syncthreads();
    if (threadIdx.x == 0) {
        unsigned* bar = b.bar;
        __builtin_amdgcn_s_waitcnt(0);
        if (b.nloc == 0u) xb_census(bar, b.x, b.nloc, b.nx);
        const unsigned nloc = b.nloc, nx = b.nx;
        const unsigned old = xb_add(&bar[XB_XSUB(b.x)], 1u);
        const unsigned gen = old / nloc;
        if (old + 1u == (gen + 1u) * nloc) {
            __builtin_amdgcn_fence(__ATOMIC_RELEASE, "agent");
            asm volatile("s_waitcnt vmcnt(0)" ::: "memory");
            const unsigned og = xb_add(&bar[XB_TOP], 1u);
            const unsigned tg = og / nx;
            if (og + 1u == (tg + 1u) * nx) xb_add(&bar[XB_TOPGEN], 1u);
            else XB_SPIN(xb_ld(&bar[XB_TOPGEN]) == tg, bar);
            __builtin_amdgcn_fence(__ATOMIC_ACQUIRE, "agent");
            xb_add(&bar[XB_XGEN(b.x)], 1u);
            asm volatile("s_waitcnt vmcnt(0)" ::: "memory");
        } else {
            XB_SPIN(xb_ld(&bar[XB_XGEN(b.x)]) == gen, bar);
            __builtin_amdgcn_fence(__ATOMIC_ACQUIRE, "agent");
            asm volatile("s_waitcnt vmcnt(0)" ::: "memory");
        }
    }
    __syncthreads();
}
__global__ void __launch_bounds__(256, 2) mega(Params p) {
    __shared__ __attribute__((aligned(16))) char smem[65536];
    cg::grid_group grid = cg::this_grid();
    grid.sync();
    XcdBar xb; xb.bar = (unsigned*)(p.ws + OFF_BAR); xb.x = xb_xcc_id(); xb.nloc = 0u; xb.nx = 0u;
    if (threadIdx.x == 0) (void)xb_add(&xb.bar[XB_XCNT(xb.x)], 1u);
#pragma unroll 1
    for (int step = 0; step < NSTEPS; ++step) {
        int ph, ch = 0, l = 0;
        if (step == 0) ph = 8;
        else if (step == 1) ph = 9;
        else { const int s = step - 2; ch = s >> 4; const int r = s & 15; l = r >> 3; ph = r & 7; }
        const bf16_t* WT = (const bf16_t*)(p.ws + OFF_WT) + (size_t)l * W_LAYER;
        const bf16_t* H = (const bf16_t*)(p.ws + OFF_H);
        int kind = 0;
        GemmDesc g; g.A = H; g.W = WT; g.lda = LDH; g.ldb = LW1; g.K = D; g.nN = 8; g.epi = 1; g.l = l; g.chunk = ch;
        int rp_mode = 1, rp_which = 1, rp_hsel = 0, rp_lh = l;
        switch (ph) {
            case 8: kind = 3; break;
            case 9: kind = 1; rp_mode = 0; rp_hsel = 1; rp_lh = 0; break;
            case 0: g.W = WT + WO_IN; g.nN = 50; g.epi = 0; break;
            case 1: kind = 2; break;
            case 2: g.A = (const bf16_t*)(p.ws + OFF_ACT); g.lda = ACTW; g.W = WT + WO_A; g.ldb = LWM; g.K = 1280; g.epi = 3; break;
            case 3: g.W = WT + WO_O; break;
            case 4: kind = 1; rp_which = 1; rp_hsel = 2; break;
            case 5: g.W = WT + WO_F1; g.nN = 32; g.epi = 2; break;
            case 6: g.A = (const bf16_t*)(p.ws + OFF_HID); g.lda = LDHID; g.W = WT + WO_F2; g.ldb = LW4; g.K = DFF; break;
            default: kind = 1; rp_which = 2; rp_hsel = (l == 0) ? 1 : 0; rp_lh = 1; break;
        }
        if (kind == 0) phase_gemm_any(p, g, smem);
        else if (kind == 1) {
            const int nrep = (ph == 7 && l == 1 && ch < 2) ? 2 : 1;
#pragma unroll 1
            for (int rep = 0; rep < nrep; ++rep) {
                if (rep == 1) { ch += 1; rp_mode = 0; rp_which = 1; rp_hsel = 1; rp_lh = 0; }
                rowpass(p, ch, rp_mode, l, rp_which, rp_hsel, rp_lh);
            }
        }
        else if (kind == 2) phase_branch(p, ch, l, smem);
        else phase_prep(p, smem);
        if (step + 1 < NSTEPS) gsync(xb);
    }
}

extern "C" void kernel_launch(void* const* d_in, const int* in_sizes, int n_in, void* d_out, int out_size, void* d_ws, size_t ws_size, hipStream_t stream) {
    static int grid_blocks = 0;
    if (!grid_blocks) {
        int dev = 0, cus = 0, per_cu = 0;
        (void)hipGetDevice(&dev);
        (void)hipDeviceGetAttribute(&cus, hipDeviceAttributeMultiprocessorCount, dev);
        (void)hipOccupancyMaxActiveBlocksPerMultiprocessor(&per_cu, mega, 256, 0);
        if (per_cu > 2) per_cu = 2;
        if (per_cu < 1) per_cu = 1;
        grid_blocks = cus * per_cu;
    }
    Params p{};
    const float** pp = (const float**)&p;
    for (int i = 0; i < 28; ++i) pp[i] = (const float*)d_in[i];
    p.out = (float*)d_out;
    p.ws = (char*)d_ws;
    (void)hipMemsetAsync((char*)d_ws + OFF_BAR, 0, 16384, stream);
    void* args[] = {&p};
    hipError_t e = hipLaunchCooperativeKernel((void*)mega, dim3(grid_blocks), dim3(256), args, 0, stream);
    if (e != hipSuccess) fprintf(stderr, "cooperative launch failed: %s (grid %d)\n", hipGetErrorString(e), grid_blocks);
}
```

```cpp
#include <hip/hip_runtime.h>
#include <hip/hip_cooperative_groups.h>
#include <stdint.h>
#include <cstdio>
namespace cg = cooperative_groups;

typedef unsigned short bf16_t;
typedef short bf16x8 __attribute__((ext_vector_type(8)));
typedef short bf16x4 __attribute__((ext_vector_type(4)));
typedef float f32x4 __attribute__((ext_vector_type(4)));
typedef unsigned u32x4 __attribute__((ext_vector_type(4)));
#define DEVINL __device__ __forceinline__

constexpr int D = 1024, INW = 6400, CH = 8192  , ACTW = 1344  , DFF = 4096;
constexpr int LDH = 1088, LDHID = 4160, LW1 = 1088, LWM = 1344, LW4 = 4160;
constexpr int Z_AVAL = 0, Z_AGATE = 256, Z_POOL = 512, Z_SB = 768, Z_SC = 1024, Z_SH = 1280, Z_Q = 1536, Z_K = 2048, Z_V = 2176, Z_G = 2304;
constexpr float EPS = 1e-6f;
#ifndef NSTEPS
#define NSTEPS 50
#endif
constexpr size_t WO_IN = 0, WO_A = WO_IN + (size_t)6400 * LW1, WO_O = WO_A + (size_t)1024 * LWM, WO_F1 = WO_O + (size_t)1024 * LW1, WO_F2 = WO_F1 + (size_t)4096 * LW1,
                 W_LAYER = WO_F2 + (size_t)1024 * LW4;
constexpr size_t OFF_WT = 0, OFF_MOD = OFF_WT + 2 * W_LAYER * 2, OFF_CKV = OFF_MOD + 2 * 5 * 6144 * 4, OFF_TAB = OFF_CKV + 2 * 262144 * 2,
                 OFF_H = OFF_TAB + 8192, OFF_ACT = OFF_H + (size_t)CH * LDH * 2, OFF_Z = OFF_ACT + (size_t)CH * ACTW * 2,
                 OFF_MF = OFF_Z, OFF_HID = OFF_Z + (size_t)CH * D * 4, OFF_BAR = OFF_Z + (size_t)CH * INW * 2;
constexpr size_t OUT_K = 25165824, OUT_V = 27262976;

struct Params {
    const float *x_prompt, *x_sample, *cache_k, *cache_v, *c, *c_ctx, *w_ada, *b_ada, *g_pre_mix, *g_post_mix, *g_pre_ffn, *g_post_ffn, *w_in,
        *w_conv_a, *b_conv_a, *ln_g_a, *ln_b_a, *w_a_out, *w_pool, *pool_scale, *w_b_out, *w_sc, *w_c_out, *sink, *w_d_out, *w_o, *w_ff1, *w_ff2;
    float* out;
    char* ws;
};

DEVINL int tid() { int t = threadIdx.x; asm volatile("" : "+v"(t)); return t; }
DEVINL float bf_lo(uint32_t u) { return __uint_as_float(u << 16); }
DEVINL float bf_hi(uint32_t u) { return __uint_as_float(u & 0xffff0000u); }
typedef __bf16 bf16x2_t __attribute__((ext_vector_type(2)));
typedef float f32x2_t __attribute__((ext_vector_type(2)));
DEVINL uint32_t pack_bf16(float lo, float hi) { const f32x2_t v = {lo, hi}; const bf16x2_t b = __builtin_convertvector(v, bf16x2_t); return __builtin_bit_cast(uint32_t, b); }
DEVINL void unpack8(const uint4& u, float (&f)[8]) {
    f[0] = bf_lo(u.x); f[1] = bf_hi(u.x); f[2] = bf_lo(u.y); f[3] = bf_hi(u.y); f[4] = bf_lo(u.z); f[5] = bf_hi(u.z); f[6] = bf_lo(u.w); f[7] = bf_hi(u.w);
}
DEVINL uint4 pack8(const float (&f)[8]) { uint4 u; u.x = pack_bf16(f[0], f[1]); u.y = pack_bf16(f[2], f[3]); u.z = pack_bf16(f[4], f[5]); u.w = pack_bf16(f[6], f[7]); return u; }
DEVINL float sigmoidf_(float x) { return 1.f / (1.f + __expf(-x)); }
DEVINL float wave_sum(float v) {
#pragma unroll
    for (int o = 32; o > 0; o >>= 1) v += __shfl_xor(v, o);
    return v;
}
DEVINL bf16x8 as_bf16x8(const uint4& u) { union { uint4 a; bf16x8 b; } x; x.a = u; return x.b; }

#define SCHED_FENCE() __builtin_amdgcn_sched_barrier(0)
template <bool FKK>
DEVINL void gemm_compute(const char* cur, int aoff, int boff, int fq, int sw, f32x4 (&acc)[4][4]) {
    bf16x8 af[2][4], bfr[2][4];
    __builtin_amdgcn_s_waitcnt(0xC07F);
#pragma unroll
    for (int kk = 0; kk < 2; ++kk) {
        const int co = ((kk * 4 + fq) ^ sw) << 4;
#pragma unroll
        for (int i = 0; i < 4; ++i) { af[kk][i] = *(const bf16x8*)(cur + aoff + i * 2048 + co); bfr[kk][i] = *(const bf16x8*)(cur + boff + i * 2048 + co); }
    }
    __builtin_amdgcn_s_setprio(1);
#pragma unroll
    for (int kk = 0; kk < 2; ++kk)
#pragma unroll
        for (int mi = 0; mi < 4; ++mi)
#pragma unroll
            for (int ni = 0; ni < 4; ++ni) acc[mi][ni] = __builtin_amdgcn_mfma_f32_16x16x32_bf16(bfr[kk][ni], af[kk][mi], acc[mi][ni], 0, 0, 0);
    __builtin_amdgcn_s_setprio(0);
}
struct NoHook { DEVINL void operator()(int, f32x4 (&)[4][4]) const {} };
template <int DEPTH, class Hook = NoHook>
DEVINL void gemm_loop(const bf16_t* __restrict__ A, int lda, const bf16_t* __restrict__ B, int ldb, int K, char* smem, f32x4 (&acc)[4][4], const Hook& hook = Hook()) {
    const int t = tid(), lane = t & 63, w = t >> 6, wm = w >> 1, wn = w & 1, fr = lane & 15, fq = lane >> 4;
    const int sc = t & 7, sr = t >> 3;
    const bf16_t* ag = A + (size_t)sr * lda + sc * 8;
    const bf16_t* bg = B + (size_t)sr * ldb + sc * 8;
    const int soff = sr * 128 + ((sc ^ ((sr >> 1) & 7)) << 4);
    const int aoff = (wm * 64 + fr) * 128, boff = 16384 + (wn * 64 + fr) * 128, sw = (fr >> 1) & 7;
    const int nk = K >> 6;
    u32x4 r0a[4], r0b[4], r1a[4], r1b[4];
#define G_LOAD(RA, RB, KT) { _Pragma("unroll") for (int i = 0; i < 4; ++i) { RA[i] = *(const u32x4*)(ag + (size_t)i * 32 * lda + (KT) * 64); RB[i] = *(const u32x4*)(bg + (size_t)i * 32 * ldb + (KT) * 64); } }
#define G_STORE(RA, RB, BUF) { _Pragma("unroll") for (int i = 0; i < 4; ++i) { *(u32x4*)(smem + (BUF) * 32768 + soff + i * 4096) = RA[i]; *(u32x4*)(smem + (BUF) * 32768 + 16384 + soff + i * 4096) = RB[i]; } }
    G_LOAD(r0a, r0b, 0);
    G_LOAD(r1a, r1b, 1);
    SCHED_FENCE();
    __syncthreads();
    G_STORE(r0a, r0b, 0);
    __syncthreads();
    for (int kt = 0; kt < nk; kt += 2) {
        G_LOAD(r0a, r0b, min(kt + 2, nk - 1));
        SCHED_FENCE();
        gemm_compute<false>(smem, aoff, boff, fq, sw, acc);
        SCHED_FENCE();
        G_STORE(r1a, r1b, 1);
        __syncthreads();
        G_LOAD(r1a, r1b, min(kt + 3, nk - 1));
        SCHED_FENCE();
        gemm_compute<false>(smem + 32768, aoff, boff, fq, sw, acc);
        SCHED_FENCE();
        hook(kt + 1, acc);
        G_STORE(r0a, r0b, 0);
        __syncthreads();
    }
#undef G_LOAD
#undef G_STORE
}
#define LAS3 __attribute__((address_space(3)))
template <class Hook = NoHook>
DEVINL void gemm_loop_dma(const bf16_t* __restrict__ A, int lda, const bf16_t* __restrict__ B, int ldb, int K, char* smem, f32x4 (&acc)[4][4], const Hook& hook,
                          const bf16_t* An, const bf16_t* Bn, bool pre) {
    const int t = tid(), lane = t & 63, w = __builtin_amdgcn_readfirstlane(t >> 6)  , wm = w >> 1, wn = w & 1, fr = lane & 15, fq = lane >> 4;
    const int sc = t & 7, sr = t >> 3;
    const int srp = 8 * ((sr & 15) >> 2) + 4 * (sr >> 4) + (sr & 3);
    const unsigned voA = (unsigned)(sr * lda + ((sc ^ ((sr >> 1) & 7)) << 3)) * 2u, voB = (unsigned)(srp * ldb + ((sc ^ ((sr >> 1) & 7)) << 3)) * 2u;
    const __amdgpu_buffer_rsrc_t srdA = __builtin_amdgcn_make_buffer_rsrc((void*)A, (short)0, 0x7fffffff, 0x00020000);
    const __amdgpu_buffer_rsrc_t srdB = __builtin_amdgcn_make_buffer_rsrc((void*)B, (short)0, 0x7fffffff, 0x00020000);
    const int aoff = (wm * 64 + fr) * 128, boff = 16384 + (wn * 64 + fr) * 128, sw = (fr >> 1) & 7;
    const int nk = K >> 6;
    LAS3 char* lds = (LAS3 char*)smem;
    const unsigned ldsb = (unsigned)__builtin_amdgcn_readfirstlane((int)(unsigned)(unsigned long)lds) + (unsigned)w * 1024u;
    const int stepA = 32 * lda * 2, stepB = 32 * ldb * 2;
#define D_ONE(SRD, VO, SOFF, M0V) asm volatile("s_mov_b32 m0, %0\n\ts_nop 0\n\tbuffer_load_dwordx4 %1, %2, %3 offen lds" :: "s"(M0V), "v"(VO), "s"(SRD), "s"(SOFF) : "m0", "memory")
#define D_ISSUE(BUF, KT) { _Pragma("unroll") for (int i = 0; i < 4; ++i) { \
        D_ONE(srdA, voA, (KT) * 128 + i * stepA, ldsb + (BUF) * 32768 + i * 4096); \
        D_ONE(srdB, voB, (KT) * 128 + i * stepB, ldsb + (BUF) * 32768 + 16384 + i * 4096); } }
#define D_WAIT() { asm volatile("s_waitcnt vmcnt(0)" ::: "memory"); __builtin_amdgcn_s_barrier(); asm volatile("" ::: "memory"); }
    if (!pre) D_ISSUE(0, 0);
    D_WAIT();
    for (int kt = 0; kt < nk; kt += 2) {
        D_ISSUE(1, kt + 1);
        SCHED_FENCE();
        gemm_compute<false>(smem, aoff, boff, fq, sw, acc);
        SCHED_FENCE();
        D_WAIT();
        if (kt + 2 < nk) D_ISSUE(0, kt + 2)
        else if (An) {
            const __amdgpu_buffer_rsrc_t srdA2 = __builtin_amdgcn_make_buffer_rsrc((void*)An, (short)0, 0x7fffffff, 0x00020000);
            const __amdgpu_buffer_rsrc_t srdB2 = __builtin_amdgcn_make_buffer_rsrc((void*)Bn, (short)0, 0x7fffffff, 0x00020000);
#pragma unroll
            for (int i = 0; i < 4; ++i) { D_ONE(srdA2, voA, i * stepA, ldsb + i * 4096); D_ONE(srdB2, voB, i * stepB, ldsb + 16384 + i * 4096); }
        }
        SCHED_FENCE();
        gemm_compute<false>(smem + 32768, aoff, boff, fq, sw, acc);
        SCHED_FENCE();
        hook(kt + 1, acc);
        if (kt + 2 < nk) D_WAIT();
    }
#undef D_ISSUE
#undef D_ONE
#undef D_WAIT
}
DEVINL void gemm_loop1(const bf16_t* __restrict__ A, int lda, const bf16_t* __restrict__ B, int ldb, int K, char* smem, f32x4 (&acc)[4][4]) {
    const int t = tid(), lane = t & 63, w = t >> 6, wm = w >> 1, wn = w & 1, fr = lane & 15, fq = lane >> 4;
    const int sc = t & 7, sr = t >> 3;
    const bf16_t* ag = A + (size_t)sr * lda + sc * 8;
    const bf16_t* bg = B + (size_t)sr * ldb + sc * 8;
    const int soff = sr * 128 + ((sc ^ ((sr >> 1) & 7)) << 4);
    u32x4 ra[4], rb[4];
    const int nk = K >> 6;
#pragma unroll
    for (int i = 0; i < 4; ++i) { ra[i] = *(const u32x4*)(ag + (size_t)i * 32 * lda); rb[i] = *(const u32x4*)(bg + (size_t)i * 32 * ldb); }
    __syncthreads();
#pragma unroll
    for (int i = 0; i < 4; ++i) { *(u32x4*)(smem + soff + i * 4096) = ra[i]; *(u32x4*)(smem + 16384 + soff + i * 4096) = rb[i]; }
    __syncthreads();
    const int aoff = (wm * 64 + fr) * 128, boff = 16384 + (wn * 64 + fr) * 128, sw = (fr >> 1) & 7;
    for (int kt = 0; kt < nk; ++kt) {
        const char* cur = smem + (kt & 1) * 32768;
        if (kt + 1 < nk) {
#pragma unroll
            for (int i = 0; i < 4; ++i) { ra[i] = *(const u32x4*)(ag + (size_t)i * 32 * lda + (kt + 1) * 64); rb[i] = *(const u32x4*)(bg + (size_t)i * 32 * ldb + (kt + 1) * 64); }
        }
        gemm_compute<false>(cur, aoff, boff, fq, sw, acc);
        if (kt + 1 < nk) {
            char* nxt = smem + ((kt + 1) & 1) * 32768;
#pragma unroll
            for (int i = 0; i < 4; ++i) { *(u32x4*)(nxt + soff + i * 4096) = ra[i]; *(u32x4*)(nxt + 16384 + soff + i * 4096) = rb[i]; }
        }
        __syncthreads();
    }
}
DEVINL void zero_acc(f32x4 (&acc)[4][4]) {
#pragma unroll
    for (int i = 0; i < 4; ++i)
#pragma unroll
        for (int j = 0; j < 4; ++j) acc[i][j] = (f32x4){0.f, 0.f, 0.f, 0.f};
}
DEVINL void tile_order(int t, int nN, int& pm, int& pn) { const int g = t / (8 * nN), r = t % (8 * nN); pn = r >> 3; pm = g * 8 + (r & 7); }
struct TileWalk {
    int nN, i, x, j, nb; bool xcd;
    DEVINL void init(int nN_) { nN = nN_; i = 0; xcd = (gridDim.x & 7) == 0; x = blockIdx.x & 7; j = blockIdx.x >> 3; nb = gridDim.x >> 3; }
    DEVINL bool next(int& pm, int& pn) {
        if (xcd) { const int s = i * nb + j; ++i; if (s >= 8 * nN) return false; pn = s >> 3; pm = x * 8 + (s & 7); return true; }
        const int t = blockIdx.x + i * gridDim.x; ++i; if (t >= 64 * nN) return false; tile_order(t, nN, pm, pn); return true;
    }
};

DEVINL void wt_tile2(const float* __restrict__ src, int K, int N, bf16_t* __restrict__ dst, int ldd, int tile0, char* smem) {
    const int nNt = N >> 6, t = tid();
    float* tl = (float*)smem;
    const int r = t >> 4, c4 = t & 15;
    f32x4 v[2][4];
#pragma unroll
    for (int u = 0; u < 2; ++u) {
        const int tile = tile0 + u, k0 = (tile / nNt) * 64, n0 = (tile % nNt) * 64;
#pragma unroll
        for (int i = 0; i < 4; ++i) v[u][i] = *(const f32x4*)(src + (size_t)(k0 + r + 16 * i) * N + n0 + c4 * 4);
    }
    asm volatile("" : "+v"(v[0][0]), "+v"(v[0][1]), "+v"(v[0][2]), "+v"(v[0][3]), "+v"(v[1][0]), "+v"(v[1][1]), "+v"(v[1][2]), "+v"(v[1][3]));
#pragma unroll
    for (int u = 0; u < 2; ++u)
#pragma unroll
        for (int i = 0; i < 4; ++i) { float* q = tl + u * 4160 + (r + 16 * i) * 65 + c4 * 4; q[0] = v[u][i][0]; q[1] = v[u][i][1]; q[2] = v[u][i][2]; q[3] = v[u][i][3]; }
    __syncthreads();
    const int n = t >> 2, kq = t & 3;
#pragma unroll
    for (int u = 0; u < 2; ++u) {
        const int tile = tile0 + u, k0 = (tile / nNt) * 64, n0 = (tile % nNt) * 64;
        uint32_t pk[8];
#pragma unroll
        for (int e = 0; e < 8; ++e) pk[e] = pack_bf16(tl[u * 4160 + (kq * 16 + 2 * e) * 65 + n], tl[u * 4160 + (kq * 16 + 2 * e + 1) * 65 + n]);
        uint4* o = (uint4*)(dst + (size_t)(n0 + n) * ldd + k0 + kq * 16);
        o[0] = make_uint4(pk[0], pk[1], pk[2], pk[3]); o[1] = make_uint4(pk[4], pk[5], pk[6], pk[7]);
    }
    __syncthreads();
}
DEVINL void mod_tile(const Params& p, int tile, char* smem) {
    const int l = tile / 96, n0 = (tile % 96) * 64, t = tid(), kg = t >> 6, col = t & 63;
    float* sl = (float*)smem;
    float* red = sl + 5 * 1024;
    for (int i = t; i < 5 * 1024; i += 256) { const int cb = i >> 10, k = i & 1023; const float x = cb == 0 ? p.c_ctx[k] : p.c[(cb - 1) * 1024 + k]; sl[i] = x * sigmoidf_(x); }
    __syncthreads();
    float a0 = 0.f, a1 = 0.f, a2 = 0.f, a3 = 0.f, a4 = 0.f;
    const float* wp = p.w_ada + ((size_t)l * 1024 + kg * 256) * 6144 + n0 + col;
#pragma unroll 1
    for (int k0 = 0; k0 < 256; k0 += 32) {
        float wv[32];
#pragma unroll
        for (int k = 0; k < 32; ++k) wv[k] = wp[(size_t)(k0 + k) * 6144];
        SCHED_FENCE();
#pragma unroll
        for (int k = 0; k < 32; ++k) {
            const int kk = kg * 256 + k0 + k;
            a0 += sl[kk] * wv[k]; a1 += sl[1024 + kk] * wv[k]; a2 += sl[2048 + kk] * wv[k]; a3 += sl[3072 + kk] * wv[k]; a4 += sl[4096 + kk] * wv[k];
        }
    }
    red[(kg * 5 + 0) * 64 + col] = a0; red[(kg * 5 + 1) * 64 + col] = a1; red[(kg * 5 + 2) * 64 + col] = a2; red[(kg * 5 + 3) * 64 + col] = a3; red[(kg * 5 + 4) * 64 + col] = a4;
    __syncthreads();
    float* mod = (float*)(p.ws + OFF_MOD);
    for (int i = t; i < 320; i += 256) {
        const int cb = i >> 6, cc = i & 63;
        const float s = red[(0 * 5 + cb) * 64 + cc] + red[(1 * 5 + cb) * 64 + cc] + red[(2 * 5 + cb) * 64 + cc] + red[(3 * 5 + cb) * 64 + cc];
        mod[((size_t)l * 5 + cb) * 6144 + n0 + cc] = s + p.b_ada[l * 6144 + n0 + cc];
    }
    __syncthreads();
}
DEVINL void phase_prep(const Params& p, char* smem) {
    const int t = tid();
    bf16_t* WT = (bf16_t*)(p.ws + OFF_WT);
    constexpr int NMOD = 192, NW = 4224  , NC = 256, NT = NMOD + NW + NC + 1;
    for (int tile = blockIdx.x; tile < NT; tile += gridDim.x) {
        if (tile < NMOD) mod_tile(p, tile, smem);
        else if (tile < NMOD + NW) {
            int wt = (tile - NMOD) * 2; const int l = wt / 4224; wt -= l * 4224;
            const float* src; int K, N, ldd; size_t dofs;
            if (wt < 1600) { src = p.w_in + (size_t)l * 1024 * 6400; K = 1024; N = 6400; ldd = LW1; dofs = WO_IN; }
            else if (wt < 1664) { wt -= 1600; src = p.w_a_out + (size_t)l * 256 * 1024; K = 256; N = 1024; ldd = LWM; dofs = WO_A; }
            else if (wt < 1728) { wt -= 1664; src = p.w_b_out + (size_t)l * 256 * 1024; K = 256; N = 1024; ldd = LWM; dofs = WO_A + 256; }
            else if (wt < 1792) { wt -= 1728; src = p.w_c_out + (size_t)l * 256 * 1024; K = 256; N = 1024; ldd = LWM; dofs = WO_A + 512; }
            else if (wt < 1920) { wt -= 1792; src = p.w_d_out + (size_t)l * 512 * 1024; K = 512; N = 1024; ldd = LWM; dofs = WO_A + 768; }
            else if (wt < 2176) { wt -= 1920; src = p.w_o + (size_t)l * 1024 * 1024; K = 1024; N = 1024; ldd = LW1; dofs = WO_O; }
            else if (wt < 3200) { wt -= 2176; src = p.w_ff1 + (size_t)l * 1024 * 4096; K = 1024; N = 4096; ldd = LW1; dofs = WO_F1; }
            else { wt -= 3200; src = p.w_ff2 + (size_t)l * 4096 * 1024; K = 4096; N = 1024; ldd = LW4; dofs = WO_F2; }
            wt_tile2(src, K, N, WT + (size_t)l * W_LAYER + dofs, ldd, wt, smem);
        } else if (tile < NMOD + NW + NC) {
            const int i = (tile - NMOD - NW) * 256 + t;
            const float* src = (i < 32768) ? p.cache_k + (size_t)i * 8 : p.cache_v + (size_t)(i - 32768) * 8;
            const float4 a = *(const float4*)src, b = *(const float4*)(src + 4);
            uint4 o; o.x = pack_bf16(a.x, a.y); o.y = pack_bf16(a.z, a.w); o.z = pack_bf16(b.x, b.y); o.w = pack_bf16(b.z, b.w);
            *(uint4*)(p.ws + OFF_CKV + (size_t)i * 16) = o;
        } else {
            float2* tab = (float2*)(p.ws + OFF_TAB);
            for (int i = t; i < 1024; i += 256) {
                const int pos = i >> 4, fi = i & 15;
                const float freq = exp2f(-(float)fi * (13.287712379549449f / 16.f));
                const float ang = (float)pos * freq;
                tab[i] = make_float2(__cosf(ang), __sinf(ang));
            }
        }
    }
}

DEVINL void rowpass(const Params& p, int chunk, int mode, int lpost, int which_post, int hsel, int lh) {
    const int lane = tid() & 63, w = tid() >> 6;
    const float* mod = (const float*)(p.ws + OFF_MOD);
    const bf16_t* MF = (const bf16_t*)(p.ws + OFF_MF);
    bf16_t* H = (bf16_t*)(p.ws + OFF_H);
    const float* xin = chunk == 0 ? p.x_prompt : p.x_sample + (size_t)(chunk - 1) * CH * D;
    float* xres = p.out + (size_t)chunk * CH * D;
    const float* xsrc = mode == 0 ? xin : xres;
    const float* gpost = which_post == 1 ? p.g_post_mix + lpost * D : p.g_post_ffn + lpost * D;
    const float* gpre = hsel == 1 ? p.g_pre_mix + lh * D : p.g_pre_ffn + lh * D;
    for (int base = (blockIdx.x * 4 + w) * 4; base < CH; base += gridDim.x * 16) {
        const int cb = chunk == 0 ? 0 : 1 + (chunk - 1) * 2 + (base >> 12);
        float pg[16], hg[16], hs[16];
        if (mode == 1) {
            const float* gate = mod + ((size_t)lpost * 5 + cb) * 6144 + (which_post == 1 ? 2 : 5) * 1024;
            float4 gp[4], gt[4];
#pragma unroll
            for (int i = 0; i < 4; ++i) { const int c = i * 256 + lane * 4; gp[i] = *(const float4*)(gpost + c); gt[i] = *(const float4*)(gate + c); }
            SCHED_FENCE();
#pragma unroll
            for (int i = 0; i < 4; ++i) { pg[4 * i] = gp[i].x * gt[i].x; pg[4 * i + 1] = gp[i].y * gt[i].y; pg[4 * i + 2] = gp[i].z * gt[i].z; pg[4 * i + 3] = gp[i].w * gt[i].w; }
        }
        if (hsel) {
            const float* mb = mod + ((size_t)lh * 5 + cb) * 6144 + (hsel == 1 ? 0 : 3) * 1024;
            float4 g[4], sh[4], sc[4];
#pragma unroll
            for (int i = 0; i < 4; ++i) { const int c = i * 256 + lane * 4; g[i] = *(const float4*)(gpre + c); sh[i] = *(const float4*)(mb + c); sc[i] = *(const float4*)(mb + 1024 + c); }
            SCHED_FENCE();
#pragma unroll
            for (int i = 0; i < 4; ++i) {
                hg[4 * i] = g[i].x * (1.f + sc[i].x); hg[4 * i + 1] = g[i].y * (1.f + sc[i].y); hg[4 * i + 2] = g[i].z * (1.f + sc[i].z); hg[4 * i + 3] = g[i].w * (1.f + sc[i].w);
                hs[4 * i] = sh[i].x; hs[4 * i + 1] = sh[i].y; hs[4 * i + 2] = sh[i].z; hs[4 * i + 3] = sh[i].w;
            }
        }
#pragma unroll 1
        for (int pr = 0; pr < 2; ++pr) {
            const int row0 = base + pr * 2;
            float x[2][16], m[2][16];
#pragma unroll
            for (int r = 0; r < 2; ++r)
#pragma unroll
                for (int i = 0; i < 4; ++i) {
                    const size_t o = (size_t)(row0 + r) * D + i * 256 + lane * 4;
                    const float4 v = *(const float4*)(xsrc + o);
                    x[r][4 * i] = v.x; x[r][4 * i + 1] = v.y; x[r][4 * i + 2] = v.z; x[r][4 * i + 3] = v.w;
                    if (mode == 1) { const uint2 q = *(const uint2*)(MF + o); m[r][4 * i] = bf_lo(q.x); m[r][4 * i + 1] = bf_hi(q.x); m[r][4 * i + 2] = bf_lo(q.y); m[r][4 * i + 3] = bf_hi(q.y); }
                }
            SCHED_FENCE();
#pragma unroll
            for (int r = 0; r < 2; ++r) {
                if (mode == 1) {
                    float ss = 0.f;
#pragma unroll
                    for (int i = 0; i < 16; ++i) ss += m[r][i] * m[r][i];
                    ss = wave_sum(ss);
                    const float rs = rsqrtf(ss * (1.f / D) + EPS);
#pragma unroll
                    for (int i = 0; i < 16; ++i) x[r][i] += (m[r][i] * rs) * pg[i];
                }
#pragma unroll
                for (int i = 0; i < 4; ++i) *(float4*)(xres + (size_t)(row0 + r) * D + i * 256 + lane * 4) = make_float4(x[r][4 * i], x[r][4 * i + 1], x[r][4 * i + 2], x[r][4 * i + 3]);
                if (hsel) {
                    float ss = 0.f;
#pragma unroll
                    for (int i = 0; i < 16; ++i) ss += x[r][i] * x[r][i];
                    ss = wave_sum(ss);
                    const float rs = rsqrtf(ss * (1.f / D) + EPS);
#pragma unroll
                    for (int i = 0; i < 4; ++i) {
                        const float h0 = x[r][4 * i] * rs * hg[4 * i] + hs[4 * i], h1 = x[r][4 * i + 1] * rs * hg[4 * i + 1] + hs[4 * i + 1];
                        const float h2 = x[r][4 * i + 2] * rs * hg[4 * i + 2] + hs[4 * i + 2], h3 = x[r][4 * i + 3] * rs * hg[4 * i + 3] + hs[4 * i + 3];
                        *(uint2*)(H + (size_t)(row0 + r) * LDH + i * 256 + lane * 4) = make_uint2(pack_bf16(h0, h1), pack_bf16(h2, h3));
                    }
                }
            }
        }
    }
}

DEVINL void unpack8u(const uint4& u, float (&f)[8]) { unpack8(u, f); }
struct MergeHook {
    const bf16_t* zg;
    bool on;
    DEVINL void operator()(int k, f32x4 (&acc)[4][4]) const {
        if (!on || (k & 3) != 3 || k > 11) return;
        const int b = k >> 2;
        const bf16_t* z = zg + b * 1024;
        uint4 ga[4][2], gb[4][2];
#pragma unroll
        for (int mi = 0; mi < 4; ++mi)
#pragma unroll
            for (int q = 0; q < 2; ++q) { ga[mi][q] = *(const uint4*)(z + (size_t)mi * 16 * INW + q * 32); gb[mi][q] = *(const uint4*)(z + 1024 + (size_t)mi * 16 * INW + q * 32); }
        SCHED_FENCE();
#pragma unroll
        for (int mi = 0; mi < 4; ++mi)
#pragma unroll
            for (int q = 0; q < 2; ++q) {
                float a[8], bb[8]; unpack8(ga[mi][q], a); unpack8(gb[mi][q], bb);
#pragma unroll
                for (int e = 0; e < 8; ++e) acc[mi][2 * q + (e >> 2)][e & 3] *= (1.f + __expf(-bb[e])) * __builtin_amdgcn_rcpf(1.f + __expf(-a[e]));
            }
    }
};
struct GemmDesc { const bf16_t* A; const bf16_t* W; int lda, ldb, K, nN, epi, l, chunk; };
DEVINL void phase_gemm_any(const Params& p, const GemmDesc& g, char* smem) {
    const int lane = tid() & 63, w = tid() >> 6, wm = w >> 1, wn = w & 1, fr = lane & 15, fq = lane >> 4;
    bf16_t* Z = (bf16_t*)(p.ws + OFF_Z);
    bf16_t* MF = (bf16_t*)(p.ws + OFF_MF);
    bf16_t* HID = (bf16_t*)(p.ws + OFF_HID);
    bf16_t* MG = (bf16_t*)(p.ws + OFF_H);
    TileWalk tw; tw.init(g.nN);
    int pm, pn, pm2 = 0, pn2 = 0;
    bool have = tw.next(pm, pn), pre = false;
    for (; have; pm = pm2, pn = pn2) {
        const bool have2 = tw.next(pm2, pn2);
        f32x4 acc[4][4]; zero_acc(acc);
        const int row0 = pm * 128 + wm * 64 + fr, col0 = pn * 128 + wn * 64 + fq * 8;
        MergeHook hook; hook.on = (g.epi == 3); hook.zg = Z + (size_t)row0 * INW + Z_G + col0;
        gemm_loop_dma(g.A + (size_t)pm * 128 * g.lda, g.lda, g.W + (size_t)pn * 128 * g.ldb, g.ldb, g.K, smem, acc, hook,
                      have2 ? g.A + (size_t)pm2 * 128 * g.lda : nullptr, have2 ? g.W + (size_t)pn2 * 128 * g.ldb : nullptr, pre);
        pre = have2; have = have2;
        if (g.epi == 0) {
            const bool kv = (g.chunk == 0) && (pn == 16 || pn == 17);
            bf16_t* zo = Z + (size_t)row0 * INW + col0;
            asm volatile("" : "+v"(zo));
#pragma unroll
            for (int mi = 0; mi < 4; ++mi)
#pragma unroll
                for (int q = 0; q < 2; ++q) {
                    const f32x4 v0 = acc[mi][2 * q], v1 = acc[mi][2 * q + 1];
                    *(uint4*)(zo + (size_t)mi * 16 * INW + q * 32) = make_uint4(pack_bf16(v0[0], v0[1]), pack_bf16(v0[2], v0[3]), pack_bf16(v1[0], v1[1]), pack_bf16(v1[2], v1[3]));
                    if (kv) {
                        const int row = row0 + mi * 16, cl = wn * 64 + q * 32 + fq * 8;
                        float* dst = p.out + (pn == 16 ? OUT_K : OUT_V) + ((size_t)((row >> 8) * 2 + g.l) * 256 + (row & 255)) * 128 + cl;
                        *(f32x4*)dst = v0; *(f32x4*)(dst + 4) = v1;
                    }
                }
        } else if (g.epi == 1) {
            bf16_t* mo = MF + (size_t)row0 * D + col0;
            asm volatile("" : "+v"(mo));
#pragma unroll
            for (int mi = 0; mi < 4; ++mi)
#pragma unroll
                for (int q = 0; q < 2; ++q) {
                    const f32x4 v0 = acc[mi][2 * q], v1 = acc[mi][2 * q + 1];
                    *(uint4*)(mo + (size_t)mi * 16 * D + q * 32) = make_uint4(pack_bf16(v0[0], v0[1]), pack_bf16(v0[2], v0[3]), pack_bf16(v1[0], v1[1]), pack_bf16(v1[2], v1[3]));
                }
        } else if (g.epi == 2) {
            bf16_t* ho = HID + (size_t)row0 * LDHID + col0;
            asm volatile("" : "+v"(ho));
#pragma unroll
            for (int mi = 0; mi < 4; ++mi)
#pragma unroll
                for (int q = 0; q < 2; ++q) {
                    float r[8];
#pragma unroll
                    for (int e = 0; e < 8; ++e) { const float x = fmaxf(acc[mi][2 * q + (e >> 2)][e & 3], 0.f); r[e] = x * x; }
                    *(uint4*)(ho + (size_t)mi * 16 * LDHID + q * 32) = pack8(r);
                }
        } else {
            const bf16_t* z3 = hook.zg + 3 * 1024;
            bf16_t* mg = MG + (size_t)row0 * LDH + col0;
            uint4 g3[4][2];
#pragma unroll
            for (int mi = 0; mi < 4; ++mi)
#pragma unroll
                for (int q = 0; q < 2; ++q) g3[mi][q] = *(const uint4*)(z3 + (size_t)mi * 16 * INW + q * 32);
            SCHED_FENCE();
#pragma unroll
            for (int mi = 0; mi < 4; ++mi)
#pragma unroll
                for (int q = 0; q < 2; ++q) {
                    float gg[8], r[8]; unpack8(g3[mi][q], gg);
#pragma unroll
                    for (int e = 0; e < 8; ++e) r[e] = acc[mi][2 * q + (e >> 2)][e & 3] * sigmoidf_(gg[e]);
                    *(uint4*)(mg + (size_t)mi * 16 * LDH + q * 32) = pack8(r);
                }
        }
    }
}

struct AttTile { const bf16_t* kptr; const bf16_t* vptr; int stride, kstart; bool rope, maskf; };
DEVINL bool att_tile(int it, bool is_ctx, const bf16_t* Zs, const bf16_t* CKb, int q0, int kvh, AttTile& d) {
    d.rope = false; d.maskf = false;
    if (is_ctx) { d.kstart = it * 64; d.kptr = Zs + (size_t)d.kstart * INW + Z_K + kvh * 64; d.vptr = d.kptr + 128; d.stride = INW; return true; }
    if (it < 5) {
        d.kstart = (q0 & ~63) - 128 + it * 64; d.stride = INW; d.rope = true; d.maskf = true;
        if (d.kstart < 0 || d.kstart >= 4096) return false;
        d.kptr = Zs + (size_t)d.kstart * INW + Z_K + kvh * 64; d.vptr = d.kptr + 128; return true;
    }
    d.kstart = (it - 5) * 64; d.kptr = CKb + (size_t)d.kstart * 128 + kvh * 64; d.vptr = d.kptr + 262144; d.stride = 128; return true;
}
DEVINL void attn_unit(const Params& p, int chunk, int layer, int unit, char* smem) {
    const int t = tid(), lane = t & 63, w = t >> 6, fr = lane & 15, fq = lane >> 4;
    const bool is_ctx = (chunk == 0);
    int seq_base, q0, kvh, bseq = 0;
    if (is_ctx) { seq_base = (unit >> 4) * 256; q0 = ((unit >> 1) & 7) * 32; kvh = unit & 1; }
    else { const int sl = unit >> 8; seq_base = sl * 4096; q0 = ((unit >> 1) & 127) * 32; kvh = unit & 1; bseq = (chunk - 1) * 2 + sl; }
    const int head = kvh * 4 + w;
    const bf16_t* Zs = (const bf16_t*)(p.ws + OFF_Z) + (size_t)seq_base * INW;
    const bf16_t* CKb = (const bf16_t*)(p.ws + OFF_CKV) + (size_t)(bseq * 2 + layer) * 256 * 128;
    const float2* tab = (const float2*)(p.ws + OFF_TAB);
    bf16_t* ACT = (bf16_t*)(p.ws + OFF_ACT);
    char* Ks = smem;
    bf16_t* Vt = (bf16_t*)(smem + 8192);
    constexpr int VS = 68;

    bf16x8 qf[2][2];
#pragma unroll
    for (int qg = 0; qg < 2; ++qg)
#pragma unroll
        for (int dh = 0; dh < 2; ++dh) {
            const int pos = q0 + qg * 16 + fr;
            uint4 u = *(const uint4*)(Zs + (size_t)pos * INW + Z_Q + head * 64 + dh * 32 + fq * 8);
            if (!is_ctx) {
                uint4 pu; pu.x = __shfl_xor((int)u.x, 32); pu.y = __shfl_xor((int)u.y, 32); pu.z = __shfl_xor((int)u.z, 32); pu.w = __shfl_xor((int)u.w, 32);
                float x[8], y[8]; unpack8(u, x); unpack8(pu, y);
                const int pi = dh == 0 ? (pos >> 6) : (pos & 63);
                const float2* tp = tab + pi * 16 + (fq & 1) * 8;
                const float sgn = fq < 2 ? -1.f : 1.f;
#pragma unroll
                for (int e = 0; e < 8; ++e) { const float2 cs = tp[e]; x[e] = x[e] * cs.x + sgn * y[e] * cs.y; }
                u = pack8(x);
            }
            qf[qg][dh] = as_bf16x8(u);
        }
    f32x4 o[2][4];
#pragma unroll
    for (int i = 0; i < 2; ++i)
#pragma unroll
        for (int j = 0; j < 4; ++j) o[i][j] = (f32x4){0.f, 0.f, 0.f, 0.f};
    const float sk2 = p.sink[layer * 8 + head] * 1.4426950408889634f;
    float mrow[2], lsum[2];
#pragma unroll
    for (int i = 0; i < 2; ++i) { mrow[i] = sk2; lsum[i] = fq == 0 ? 1.f : 0.f; }
    const float sc2 = 0.125f * 1.4426950408889634f;

    const int ntiles = is_ctx ? 4 : 9;
    const int key = t >> 2, cp = t & 3, c = (cp & 1) + ((cp >> 1) << 2);
    const int vkp = t & 31, vc = t >> 5;
    AttTile cur; int it = 0;
    while (!att_tile(it, is_ctx, Zs, CKb, q0, kvh, cur)) ++it;
    u32x4 ku1, ku2, vu0, vu1; float2 cs[8];
#define ATT_LOAD(d) { const bf16_t* src = (d).kptr + (size_t)key * (d).stride + c * 8; ku1 = *(const u32x4*)src; ku2 = *(const u32x4*)(src + 16); \
        const bf16_t* vs = (d).vptr + (size_t)(2 * vkp) * (d).stride + vc * 8; vu0 = *(const u32x4*)vs; vu1 = *(const u32x4*)(vs + (d).stride); \
        if ((d).rope) { const int kpos = (d).kstart + key, pi = c < 4 ? (kpos >> 6) : (kpos & 63); const float2* tp = tab + pi * 16 + (c & 1) * 8; \
            _Pragma("unroll") for (int e = 0; e < 8; ++e) cs[e] = tp[e]; } }
    ATT_LOAD(cur);
    for (;;) {
        __syncthreads();
        {
            uint4 u1 = make_uint4(ku1[0], ku1[1], ku1[2], ku1[3]), u2 = make_uint4(ku2[0], ku2[1], ku2[2], ku2[3]);
            if (cur.rope) {
                float x1[8], x2[8], o1[8], o2[8]; unpack8(u1, x1); unpack8(u2, x2);
#pragma unroll
                for (int e = 0; e < 8; ++e) { o1[e] = x1[e] * cs[e].x - x2[e] * cs[e].y; o2[e] = x2[e] * cs[e].x + x1[e] * cs[e].y; }
                u1 = pack8(o1); u2 = pack8(o2);
            }
            *(uint4*)(Ks + key * 128 + ((c ^ (key & 7)) << 4)) = u1;
            *(uint4*)(Ks + key * 128 + (((c + 2) ^ (key & 7)) << 4)) = u2;
            {
                uint32_t* dst = (uint32_t*)(Vt + (vc * 8) * VS + 2 * vkp);
#pragma unroll
                for (int m = 0; m < 4; ++m) {
                    dst[(2 * m) * (VS / 2)] = (vu0[m] & 0xffffu) | (vu1[m] << 16);
                    dst[(2 * m + 1) * (VS / 2)] = (vu0[m] >> 16) | (vu1[m] & 0xffff0000u);
                }
            }
        }
        __syncthreads();
        AttTile nxt; int nit = it + 1; bool have = false;
        while (nit < ntiles) { if (att_tile(nit, is_ctx, Zs, CKb, q0, kvh, nxt)) { have = true; break; } ++nit; }
        if (have) ATT_LOAD(nxt);
        SCHED_FENCE();
        const int kstart = cur.kstart; const bool maskf = cur.maskf;
        {
            bf16x8 kf[4][2], vf[2][4];
#pragma unroll
            for (int kb = 0; kb < 4; ++kb)
#pragma unroll
                for (int dh = 0; dh < 2; ++dh) { const int row = kb * 16 + fr; kf[kb][dh] = *(const bf16x8*)(Ks + row * 128 + (((dh * 4 + fq) ^ (row & 7)) << 4)); }
#pragma unroll
            for (int hk = 0; hk < 2; ++hk)
#pragma unroll
                for (int di = 0; di < 4; ++di) {
                    const bf16_t* vp = Vt + (di * 16 + fr) * VS + hk * 32 + fq * 4;
                    const bf16x4 lo = *(const bf16x4*)vp, hi = *(const bf16x4*)(vp + 16);
                    vf[hk][di] = __builtin_shufflevector(lo, hi, 0, 1, 2, 3, 4, 5, 6, 7);
                }
#pragma unroll
            for (int qg = 0; qg < 2; ++qg) {
                f32x4 s[4];
#pragma unroll
                for (int kb = 0; kb < 4; ++kb) {
                    s[kb] = __builtin_amdgcn_mfma_f32_16x16x32_bf16(kf[kb][0], qf[qg][0], (f32x4){0.f, 0.f, 0.f, 0.f}, 0, 0, 0);
                    s[kb] = __builtin_amdgcn_mfma_f32_16x16x32_bf16(kf[kb][1], qf[qg][1], s[kb], 0, 0, 0);
                }
                const int qpos = q0 + qg * 16 + fr;
                float mx = -1e30f;
#pragma unroll
                for (int kb = 0; kb < 4; ++kb)
#pragma unroll
                    for (int j = 0; j < 4; ++j) {
                        float v = s[kb][j] * sc2;
                        if (maskf) { const int d = qpos - (kstart + kb * 16 + fq * 4 + j); if (d > 128 || d < -128) v = -1e30f; }
                        s[kb][j] = v; mx = fmaxf(mx, v);
                    }
                mx = fmaxf(mx, __shfl_xor(mx, 16)); mx = fmaxf(mx, __shfl_xor(mx, 32));
                const float mn = fmaxf(mrow[qg], mx), alpha = exp2f(mrow[qg] - mn);
                mrow[qg] = mn;
                float ps = 0.f;
#pragma unroll
                for (int kb = 0; kb < 4; ++kb)
#pragma unroll
                    for (int j = 0; j < 4; ++j) { const float pv = exp2f(s[kb][j] - mn); s[kb][j] = pv; ps += pv; }
                lsum[qg] = lsum[qg] * alpha + ps;
#pragma unroll
                for (int di = 0; di < 4; ++di) { o[qg][di][0] *= alpha; o[qg][di][1] *= alpha; o[qg][di][2] *= alpha; o[qg][di][3] *= alpha; }
#pragma unroll
                for (int hk = 0; hk < 2; ++hk) {
                    uint4 pu; pu.x = pack_bf16(s[2 * hk][0], s[2 * hk][1]); pu.y = pack_bf16(s[2 * hk][2], s[2 * hk][3]);
                    pu.z = pack_bf16(s[2 * hk + 1][0], s[2 * hk + 1][1]); pu.w = pack_bf16(s[2 * hk + 1][2], s[2 * hk + 1][3]);
                    const bf16x8 pf = as_bf16x8(pu);
#pragma unroll
                    for (int di = 0; di < 4; ++di) o[qg][di] = __builtin_amdgcn_mfma_f32_16x16x32_bf16(vf[hk][di], pf, o[qg][di], 0, 0, 0);
                }
            }
        }
        if (!have) break;
        cur = nxt; it = nit;
    }
#undef ATT_LOAD
#pragma unroll
    for (int qg = 0; qg < 2; ++qg) {
        float l = lsum[qg]; l += __shfl_xor(l, 16); l += __shfl_xor(l, 32);
        const float inv = 1.f / l;
        const int tok = seq_base + q0 + qg * 16 + fr;
#pragma unroll
        for (int di = 0; di < 4; ++di) {
            const f32x4 v = o[qg][di];
            *(uint2*)(ACT + (size_t)tok * ACTW + 768 + head * 64 + di * 16 + fq * 4) = make_uint2(pack_bf16(v[0] * inv, v[1] * inv), pack_bf16(v[2] * inv, v[3] * inv));
        }
    }
}

DEVINL void conva_tile(const Params& p, int chunk, int l, int tile, char* smem) {
    const int t = tid(), lane = t & 63, w = t >> 6;
    const int S = chunk == 0 ? 256 : 4096;
    const int tok0 = tile * 32, pos0 = tok0 % S, sb = tok0 - pos0;
    const bf16_t* Z = (const bf16_t*)(p.ws + OFF_Z);
    bf16_t* ACT = (bf16_t*)(p.ws + OFF_ACT);
    float* glu = (float*)smem;
    {
        const int chk = t & 31, r0 = t >> 5;
#pragma unroll
        for (int h = 0; h < 2; ++h) {
            uint4 a[4], b[4];
#pragma unroll
            for (int i = 0; i < 4; ++i) {
                const int r = r0 + 8 * (h * 4 + i), pos = pos0 - 15 + r, pc = min(max(pos, 0), S - 1);
                const bf16_t* src = Z + (size_t)(sb + pc) * INW + chk * 8;
                a[i] = *(const uint4*)(src + Z_AVAL); b[i] = *(const uint4*)(src + Z_AGATE);
            }
            SCHED_FENCE();
#pragma unroll
            for (int i = 0; i < 4; ++i) {
                const int r = r0 + 8 * (h * 4 + i), pos = pos0 - 15 + r;
                if (r < 62) {
                    const float keep = (pos >= 0 && pos < S) ? 1.f : 0.f;
                    float av[8], bv[8], g[8]; unpack8(a[i], av); unpack8(b[i], bv);
#pragma unroll
                    for (int e = 0; e < 8; ++e) g[e] = keep * av[e] * sigmoidf_(bv[e]);
                    float4* d = (float4*)(glu + r * 256 + chk * 8);
                    d[0] = make_float4(g[0], g[1], g[2], g[3]); d[1] = make_float4(g[4], g[5], g[6], g[7]);
                }
            }
        }
    }
    __syncthreads();
    {
        float wv[31];
#pragma unroll
        for (int k = 0; k < 31; ++k) wv[k] = p.w_conv_a[((size_t)l * 31 + k) * 256 + t];
        const float bias = p.b_conv_a[l * 256 + t];
        for (int i = 0; i < 32; ++i) {
            float s = bias;
#pragma unroll
            for (int k = 0; k < 31; ++k) s += wv[k] * glu[(i + k) * 256 + t];
            glu[i * 256 + t] = s;
        }
    }
    __syncthreads();
    {
        const float4 g = *(const float4*)(p.ln_g_a + l * 256 + lane * 4), b = *(const float4*)(p.ln_b_a + l * 256 + lane * 4);
#pragma unroll
        for (int i = 0; i < 8; ++i) {
            const int r = w * 8 + i;
            const float4 v = *(const float4*)(glu + r * 256 + lane * 4);
            const float mu = wave_sum(v.x + v.y + v.z + v.w) * (1.f / 256.f);
            const float d0 = v.x - mu, d1 = v.y - mu, d2 = v.z - mu, d3 = v.w - mu;
            const float var = wave_sum(d0 * d0 + d1 * d1 + d2 * d2 + d3 * d3) * (1.f / 256.f);
            const float rs = rsqrtf(var + EPS);
            float y0 = d0 * rs * g.x + b.x, y1 = d1 * rs * g.y + b.y, y2 = d2 * rs * g.z + b.z, y3 = d3 * rs * g.w + b.w;
            y0 *= sigmoidf_(y0); y1 *= sigmoidf_(y1); y2 *= sigmoidf_(y2); y3 *= sigmoidf_(y3);
            *(uint2*)(ACT + (size_t)(tok0 + r) * ACTW + 0 + lane * 4) = make_uint2(pack_bf16(y0, y1), pack_bf16(y2, y3));
        }
    }
}
DEVINL void pool_tile(const Params& p, int chunk, int l, int tile, char* smem) {
    const int t = tid();
    const int S = chunk == 0 ? 256 : 4096;
    const int tok0 = tile * 32, pos0 = tok0 % S, sb = tok0 - pos0;
    const bf16_t* Z = (const bf16_t*)(p.ws + OFF_Z);
    bf16_t* ACT = (bf16_t*)(p.ws + OFF_ACT);
    float* u = (float*)smem;
    {
        const int chk = t & 31, r0 = t >> 5;
        uint4 av[6];
#pragma unroll
        for (int i = 0; i < 6; ++i) { const int pos = pos0 - 8 + r0 + 8 * i, pc = min(max(pos, 0), S - 1); av[i] = *(const uint4*)(Z + (size_t)(sb + pc) * INW + Z_POOL + chk * 8); }
        SCHED_FENCE();
#pragma unroll
        for (int i = 0; i < 6; ++i) {
            const int r = r0 + 8 * i, pos = pos0 - 8 + r;
            float g[8]; unpack8(av[i], g);
            const float keep = (pos >= 0 && pos < S) ? 1.f : 0.f;
            float4* d = (float4*)(u + r * 256 + chk * 8);
            d[0] = make_float4(g[0] * keep, g[1] * keep, g[2] * keep, g[3] * keep); d[1] = make_float4(g[4] * keep, g[5] * keep, g[6] * keep, g[7] * keep);
        }
    }
    __syncthreads();
    const int gi = t >> 6, w2 = 1 << gi;
    for (int i = 0; i < 32; ++i) {
        const int pos = pos0 + i;
        float s = 0.f;
        for (int j = -w2; j < w2; ++j) s += u[(i + 8 + j) * 256 + t];
        const int lo = max(pos - w2, 0), hi = min(pos + w2, S);
        const float pooled = s / (float)(hi - lo) - u[(i + 8) * 256 + t];
        u[i * 256 + t] = pooled;
    }
    __syncthreads();
    float acc[32];
#pragma unroll
    for (int i = 0; i < 32; ++i) acc[i] = 0.f;
    const float* wp = p.w_pool + ((size_t)l * 4 + gi) * 4096 + (t & 63);
#pragma unroll 1
    for (int c0 = 0; c0 < 64; c0 += 16) {
        float wv[16];
#pragma unroll
        for (int c = 0; c < 16; ++c) wv[c] = wp[(c0 + c) * 64];
#pragma unroll
        for (int c = 0; c < 16; ++c) {
            const float* up = u + gi * 64 + c0 + c;
#pragma unroll
            for (int i = 0; i < 32; ++i) acc[i] += up[i * 256] * wv[c];
        }
    }
    const float ps = p.pool_scale[l * 256 + t];
#pragma unroll
    for (int i = 0; i < 32; ++i) {
        const float v = acc[i] * ps;
        ACT[(size_t)(tok0 + i) * ACTW + 256 + t] = (bf16_t)(pack_bf16(v, 0.f) & 0xffff);
    }
}
DEVINL void convc_tile(const Params& p, int chunk, int l, int tile) {
    const int t = tid();
    const int S = chunk == 0 ? 256 : 4096;
    const bf16_t* Z = (const bf16_t*)(p.ws + OFF_Z);
    bf16_t* ACT = (bf16_t*)(p.ws + OFF_ACT);
#pragma unroll 1
    for (int i = 0; i < 4; ++i) {
        const int item = i * 256 + t, chk = item & 31, tok = tile * 32 + (item >> 5), pos = tok % S;
        const bf16_t* zr = Z + (size_t)tok * INW + chk * 8;
        float uu[3][8];
#pragma unroll
        for (int j = 0; j < 3; ++j) {
            const int pp = pos + j - 1;
            if (pp >= 0 && pp < S) {
                const uint4 a = *(const uint4*)(zr + (j - 1) * INW + Z_SC), b = *(const uint4*)(zr + (j - 1) * INW + Z_SH);
                float av[8], bv[8]; unpack8(a, av); unpack8(b, bv);
#pragma unroll
                for (int e = 0; e < 8; ++e) uu[j][e] = av[e] * bv[e];
            } else {
#pragma unroll
                for (int e = 0; e < 8; ++e) uu[j][e] = 0.f;
            }
        }
        const uint4 sbv = *(const uint4*)(zr + Z_SB);
        float sbf[8], r[8]; unpack8(sbv, sbf);
        const float* wc = p.w_sc + (size_t)l * 768 + chk * 8;
#pragma unroll
        for (int e = 0; e < 8; ++e) r[e] = sbf[e] * (wc[e] * uu[0][e] + wc[256 + e] * uu[1][e] + wc[512 + e] * uu[2][e]);
        *(uint4*)(ACT + (size_t)tok * ACTW + 512 + chk * 8) = pack8(r);
    }
}
DEVINL void phase_branch(const Params& p, int chunk, int l, char* smem) {
    for (int tile = blockIdx.x; tile < 1280; tile += gridDim.x) {
        if (tile < 512) attn_unit(p, chunk, l, tile, smem);
        else if (tile < 768) conva_tile(p, chunk, l, tile - 512, smem);
        else if (tile < 1024) pool_tile(p, chunk, l, tile - 768, smem);
        else convc_tile(p, chunk, l, tile - 1024);
        __syncthreads();
    }
}

#define XB_TMO      128
#define XB_XCNT(j)  (256  + 64 * (j))
#define XB_XSUB(j)  (1280 + 64 * (j))
#define XB_XGEN(j)  (2304 + 64 * (j))
#define XB_TOP      3328
#define XB_TOPGEN   3392
#define XB_SPIN_CAP (1u << 20)
DEVINL unsigned xb_ld(unsigned* p) { return __hip_atomic_load(p, __ATOMIC_RELAXED, __HIP_MEMORY_SCOPE_AGENT); }
DEVINL unsigned xb_add(unsigned* p, unsigned v) { return __hip_atomic_fetch_add(p, v, __ATOMIC_RELAXED, __HIP_MEMORY_SCOPE_AGENT); }
DEVINL unsigned xb_xcc_id() { return (unsigned)__builtin_amdgcn_s_getreg((3 << 11) | 20) & 0xFu; }
#define XB_SPIN(cond, bar) do { unsigned _sp = 0; while (cond) { __builtin_amdgcn_s_sleep(1); \
    if ((++_sp & 255u) == 0u) { if (xb_ld(&(bar)[XB_TMO])) break; if (_sp > XB_SPIN_CAP) { atomicAdd(&(bar)[XB_TMO], 1u); break; } } } } while (0)
struct XcdBar { unsigned* bar; unsigned x, nloc, nx; };
DEVINL void xb_census(unsigned* bar, unsigned x, unsigned& nloc, unsigned& nx) {
    const unsigned G = gridDim.x;
    unsigned sum, cnt, mine, sp = 0u;
    for (;;) {
        sum = 0u; cnt = 0u; mine = 0u;
#pragma unroll
        for (unsigned j = 0; j < 16; ++j) { const unsigned c = xb_ld(&bar[XB_XCNT(j)]); sum += c; cnt += (c > 0u) ? 1u : 0u; mine = (j == x) ? c : mine; }
        if (sum == G) break;
        __builtin_amdgcn_s_sleep(1);
        if ((++sp & 255u) == 0u) { if (xb_ld(&bar[XB_TMO])) break; if (sp > XB_SPIN_CAP) { atomicAdd(&bar[XB_TMO], 1u); break; } }
    }
    nloc = mine > 0u ? mine : 1u; nx = cnt > 0u ? cnt : 1u;
}
DEVINL void gsync(XcdBar& b) {
    asm volatile("s_waitcnt vmcnt(0)" ::: "memory");
    __syncthreads();
    if (threadIdx.x == 0) {
        unsigned* bar = b.bar;
        __builtin_amdgcn_s_waitcnt(0);
        if (b.nloc == 0u) xb_census(bar, b.x, b.nloc, b.nx);
        const unsigned nloc = b.nloc, nx = b.nx;
        const unsigned old = xb_add(&bar[XB_XSUB(b.x)], 1u);
        const unsigned gen = old / nloc;
        if (old + 1u == (gen + 1u) * nloc) {
            __builtin_amdgcn_fence(__ATOMIC_RELEASE, "agent");
            asm volatile("s_waitcnt vmcnt(0)" ::: "memory");
            const unsigned og = xb_add(&bar[XB_TOP], 1u);
            const unsigned tg = og / nx;
            if (og + 1u == (tg + 1u) * nx) xb_add(&bar[XB_TOPGEN], 1u);
            else XB_SPIN(xb_ld(&bar[XB_TOPGEN]) == tg, bar);
            __builtin_amdgcn_fence(__ATOMIC_ACQUIRE, "agent");
            xb_add(&bar[XB_XGEN(b.x)], 1u);
            asm volatile("s_waitcnt vmcnt(0)" ::: "memory");
        } else {
            XB_SPIN(xb_ld(&bar[XB_XGEN(b.x)]) == gen, bar);
            __builtin_amdgcn_fence(__ATOMIC_ACQUIRE, "agent");
            asm volatile("s_waitcnt vmcnt(0)" ::: "memory");
        }
    }
    __syncthreads();
}
__global__ void __launch_bounds__(256, 2) mega(Params p) {
    __shared__ __attribute__((aligned(16))) char smem[65536];
    cg::grid_group grid = cg::this_grid();
    if (p.ws == nullptr) grid.sync();
    XcdBar xb; xb.bar = (unsigned*)(p.ws + OFF_BAR); xb.x = xb_xcc_id(); xb.nloc = 0u; xb.nx = 0u;
    if (threadIdx.x == 0) (void)xb_add(&xb.bar[XB_XCNT(xb.x)], 1u);
#pragma unroll 1
    for (int step = 0; step < NSTEPS; ++step) {
        int ph, ch = 0, l = 0;
        if (step == 0) ph = 8;
        else if (step == 1) ph = 9;
        else { const int s = step - 2; ch = s >> 4; const int r = s & 15; l = r >> 3; ph = r & 7; }
        const bf16_t* WT = (const bf16_t*)(p.ws + OFF_WT) + (size_t)l * W_LAYER;
        const bf16_t* H = (const bf16_t*)(p.ws + OFF_H);
        int kind = 0;
        GemmDesc g; g.A = H; g.W = WT; g.lda = LDH; g.ldb = LW1; g.K = D; g.nN = 8; g.epi = 1; g.l = l; g.chunk = ch;
        int rp_mode = 1, rp_which = 1, rp_hsel = 0, rp_lh = l;
        switch (ph) {
            case 8: kind = 3; break;
            case 9: kind = 1; rp_mode = 0; rp_hsel = 1; rp_lh = 0; break;
            case 0: g.W = WT + WO_IN; g.nN = 50; g.epi = 0; break;
            case 1: kind = 2; break;
            case 2: g.A = (const bf16_t*)(p.ws + OFF_ACT); g.lda = ACTW; g.W = WT + WO_A; g.ldb = LWM; g.K = 1280; g.epi = 3; break;
            case 3: g.W = WT + WO_O; break;
            case 4: kind = 1; rp_which = 1; rp_hsel = 2; break;
            case 5: g.W = WT + WO_F1; g.nN = 32; g.epi = 2; break;
            case 6: g.A = (const bf16_t*)(p.ws + OFF_HID); g.lda = LDHID; g.W = WT + WO_F2; g.ldb = LW4; g.K = DFF; break;
            default: kind = 1; rp_which = 2; rp_hsel = (l == 0) ? 1 : 0; rp_lh = 1; break;
        }
        if (kind == 0) phase_gemm_any(p, g, smem);
        else if (kind == 1) {
            const int nrep = (ph == 7 && l == 1 && ch < 2) ? 2 : 1;
#pragma unroll 1
            for (int rep = 0; rep < nrep; ++rep) {
                if (rep == 1) { ch += 1; rp_mode = 0; rp_which = 1; rp_hsel = 1; rp_lh = 0; }
                rowpass(p, ch, rp_mode, l, rp_which, rp_hsel, rp_lh);
            }
        }
        else if (kind == 2) phase_branch(p, ch, l, smem);
        else phase_prep(p, smem);
        if (step + 1 < NSTEPS) gsync(xb);
    }
}

extern "C" void kernel_launch(void* const* d_in, const int* in_sizes, int n_in, void* d_out, int out_size, void* d_ws, size_t ws_size, hipStream_t stream) {
    static int grid_blocks = 0;
    if (!grid_blocks) {
        int dev = 0, cus = 0, per_cu = 0;
        (void)hipGetDevice(&dev);
        (void)hipDeviceGetAttribute(&cus, hipDeviceAttributeMultiprocessorCount, dev);
        (void)hipOccupancyMaxActiveBlocksPerMultiprocessor(&per_cu, mega, 256, 0);
        if (per_cu > 2) per_cu = 2;
        if (per_cu < 1) per_cu = 1;
        grid_blocks = cus * per_cu;
    }
    Params p{};
    const float** pp = (const float**)&p;
    for (int i = 0; i < 28; ++i) pp[i] = (const float*)d_in[i];
    p.out = (float*)d_out;
    p.ws = (char*)d_ws;
    (void)hipMemsetAsync((char*)d_ws + OFF_BAR, 0, 16384, stream);
    void* args[] = {&p};
    hipError_t e = hipLaunchCooperativeKernel((void*)mega, dim3(grid_blocks), dim3(256), args, 0, stream);
    if (e != hipSuccess) fprintf(stderr, "cooperative launch failed: %s (grid %d)\n", hipGetErrorString(e), grid_blocks);
}
```

```cpp
#include <hip/hip_runtime.h>
#include <hip/hip_cooperative_groups.h>
#include <stdint.h>
#include <cstdio>
namespace cg = cooperative_groups;

typedef unsigned short bf16_t;
typedef short bf16x8 __attribute__((ext_vector_type(8)));
typedef short bf16x4 __attribute__((ext_vector_type(4)));
typedef float f32x4 __attribute__((ext_vector_type(4)));
typedef unsigned u32x4 __attribute__((ext_vector_type(4)));
#define DEVINL __device__ __forceinline__

constexpr int D = 1024, INW = 6400, CH = 8192  , ACTW = 1344  , DFF = 4096;
constexpr int LDH = 1088, LDHID = 4160, LW1 = 1088, LWM = 1344, LW4 = 4160;
constexpr int Z_AVAL = 0, Z_AGATE = 256, Z_POOL = 512, Z_SB = 768, Z_SC = 1024, Z_SH = 1280, Z_Q = 1536, Z_K = 2048, Z_V = 2176, Z_G = 2304;
constexpr float EPS = 1e-6f;
#ifndef NSTEPS
#define NSTEPS 50
#endif
constexpr size_t WO_IN = 0, WO_A = WO_IN + (size_t)6400 * LW1, WO_O = WO_A + (size_t)1024 * LWM, WO_F1 = WO_O + (size_t)1024 * LW1, WO_F2 = WO_F1 + (size_t)4096 * LW1,
                 W_LAYER = WO_F2 + (size_t)1024 * LW4;
constexpr size_t OFF_WT = 0, OFF_MOD = OFF_WT + 2 * W_LAYER * 2, OFF_CKV = OFF_MOD + 2 * 5 * 6144 * 4, OFF_TAB = OFF_CKV + 2 * 262144 * 2,
                 OFF_H = OFF_TAB + 8192, OFF_ACT = OFF_H + (size_t)CH * LDH * 2, OFF_Z = OFF_ACT + (size_t)CH * ACTW * 2,
                 OFF_MF = OFF_Z, OFF_HID = OFF_Z + (size_t)CH * D * 4, OFF_BAR = OFF_Z + (size_t)CH * INW * 2;
constexpr size_t OUT_K = 25165824, OUT_V = 27262976;

struct Params {
    const float *x_prompt, *x_sample, *cache_k, *cache_v, *c, *c_ctx, *w_ada, *b_ada, *g_pre_mix, *g_post_mix, *g_pre_ffn, *g_post_ffn, *w_in,
        *w_conv_a, *b_conv_a, *ln_g_a, *ln_b_a, *w_a_out, *w_pool, *pool_scale, *w_b_out, *w_sc, *w_c_out, *sink, *w_d_out, *w_o, *w_ff1, *w_ff2;
    float* out;
    char* ws;
};

DEVINL int tid() { int t = threadIdx.x; asm volatile("" : "+v"(t)); return t; }
DEVINL float bf_lo(uint32_t u) { return __uint_as_float(u << 16); }
DEVINL float bf_hi(uint32_t u) { return __uint_as_float(u & 0xffff0000u); }
typedef __bf16 bf16x2_t __attribute__((ext_vector_type(2)));
typedef float f32x2_t __attribute__((ext_vector_type(2)));
DEVINL uint32_t pack_bf16(float lo, float hi) { const f32x2_t v = {lo, hi}; const bf16x2_t b = __builtin_convertvector(v, bf16x2_t); return __builtin_bit_cast(uint32_t, b); }
DEVINL void unpack8(const uint4& u, float (&f)[8]) {
    f[0] = bf_lo(u.x); f[1] = bf_hi(u.x); f[2] = bf_lo(u.y); f[3] = bf_hi(u.y); f[4] = bf_lo(u.z); f[5] = bf_hi(u.z); f[6] = bf_lo(u.w); f[7] = bf_hi(u.w);
}
DEVINL uint4 pack8(const float (&f)[8]) { uint4 u; u.x = pack_bf16(f[0], f[1]); u.y = pack_bf16(f[2], f[3]); u.z = pack_bf16(f[4], f[5]); u.w = pack_bf16(f[6], f[7]); return u; }
DEVINL float sigmoidf_(float x) { return 1.f / (1.f + __expf(-x)); }
DEVINL float wave_sum(float v) {
#pragma unroll
    for (int o = 32; o > 0; o >>= 1) v += __shfl_xor(v, o);
    return v;
}
DEVINL bf16x8 as_bf16x8(const uint4& u) { union { uint4 a; bf16x8 b; } x; x.a = u; return x.b; }

#define SCHED_FENCE() __builtin_amdgcn_sched_barrier(0)
template <bool FKK>
DEVINL void gemm_compute(const char* cur, int aoff, int boff, int fq, int sw, f32x4 (&acc)[4][4]) {
    bf16x8 af[2][4], bfr[2][4];
    __builtin_amdgcn_s_waitcnt(0xC07F);
#pragma unroll
    for (int kk = 0; kk < 2; ++kk) {
        const int co = ((kk * 4 + fq) ^ sw) << 4;
#pragma unroll
        for (int i = 0; i < 4; ++i) { af[kk][i] = *(const bf16x8*)(cur + aoff + i * 2048 + co); bfr[kk][i] = *(const bf16x8*)(cur + boff + i * 2048 + co); }
    }
    __builtin_amdgcn_s_setprio(1);
#pragma unroll
    for (int kk = 0; kk < 2; ++kk)
#pragma unroll
        for (int mi = 0; mi < 4; ++mi)
#pragma unroll
            for (int ni = 0; ni < 4; ++ni) acc[mi][ni] = __builtin_amdgcn_mfma_f32_16x16x32_bf16(bfr[kk][ni], af[kk][mi], acc[mi][ni], 0, 0, 0);
    __builtin_amdgcn_s_setprio(0);
}
struct NoHook { DEVINL void operator()(int, f32x4 (&)[4][4]) const {} };
template <int DEPTH, class Hook = NoHook>
DEVINL void gemm_loop(const bf16_t* __restrict__ A, int lda, const bf16_t* __restrict__ B, int ldb, int K, char* smem, f32x4 (&acc)[4][4], const Hook& hook = Hook()) {
    const int t = tid(), lane = t & 63, w = t >> 6, wm = w >> 1, wn = w & 1, fr = lane & 15, fq = lane >> 4;
    const int sc = t & 7, sr = t >> 3;
    const bf16_t* ag = A + (size_t)sr * lda + sc * 8;
    const bf16_t* bg = B + (size_t)sr * ldb + sc * 8;
    const int soff = sr * 128 + ((sc ^ ((sr >> 1) & 7)) << 4);
    const int aoff = (wm * 64 + fr) * 128, boff = 16384 + (wn * 64 + fr) * 128, sw = (fr >> 1) & 7;
    const int nk = K >> 6;
    u32x4 r0a[4], r0b[4], r1a[4], r1b[4];
#define G_LOAD(RA, RB, KT) { _Pragma("unroll") for (int i = 0; i < 4; ++i) { RA[i] = *(const u32x4*)(ag + (size_t)i * 32 * lda + (KT) * 64); RB[i] = *(const u32x4*)(bg + (size_t)i * 32 * ldb + (KT) * 64); } }
#define G_STORE(RA, RB, BUF) { _Pragma("unroll") for (int i = 0; i < 4; ++i) { *(u32x4*)(smem + (BUF) * 32768 + soff + i * 4096) = RA[i]; *(u32x4*)(smem + (BUF) * 32768 + 16384 + soff + i * 4096) = RB[i]; } }
    G_LOAD(r0a, r0b, 0);
    G_LOAD(r1a, r1b, 1);
    SCHED_FENCE();
    __syncthreads();
    G_STORE(r0a, r0b, 0);
    __syncthreads();
    for (int kt = 0; kt < nk; kt += 2) {
        G_LOAD(r0a, r0b, min(kt + 2, nk - 1));
        SCHED_FENCE();
        gemm_compute<false>(smem, aoff, boff, fq, sw, acc);
        SCHED_FENCE();
        G_STORE(r1a, r1b, 1);
        __syncthreads();
        G_LOAD(r1a, r1b, min(kt + 3, nk - 1));
        SCHED_FENCE();
        gemm_compute<false>(smem + 32768, aoff, boff, fq, sw, acc);
        SCHED_FENCE();
        hook(kt + 1, acc);
        G_STORE(r0a, r0b, 0);
        __syncthreads();
    }
#undef G_LOAD
#undef G_STORE
}
#define LAS3 __attribute__((address_space(3)))
template <class Hook = NoHook>
DEVINL void gemm_loop_dma(const bf16_t* __restrict__ A, int lda, const bf16_t* __restrict__ B, int ldb, int K, char* smem, f32x4 (&acc)[4][4], const Hook& hook,
                          const bf16_t* An, const bf16_t* Bn, bool pre) {
    const int t = tid(), lane = t & 63, w = __builtin_amdgcn_readfirstlane(t >> 6)  , wm = w >> 1, wn = w & 1, fr = lane & 15, fq = lane >> 4;
    const int sc = t & 7, sr = t >> 3;
    const int srp = 8 * ((sr & 15) >> 2) + 4 * (sr >> 4) + (sr & 3);
    const unsigned voA = (unsigned)(sr * lda + ((sc ^ ((sr >> 1) & 7)) << 3)) * 2u, voB = (unsigned)(srp * ldb + ((sc ^ ((sr >> 1) & 7)) << 3)) * 2u;
    const __amdgpu_buffer_rsrc_t srdA = __builtin_amdgcn_make_buffer_rsrc((void*)A, (short)0, 0x7fffffff, 0x00020000);
    const __amdgpu_buffer_rsrc_t srdB = __builtin_amdgcn_make_buffer_rsrc((void*)B, (short)0, 0x7fffffff, 0x00020000);
    const int aoff = (wm * 64 + fr) * 128, boff = 16384 + (wn * 64 + fr) * 128, sw = (fr >> 1) & 7;
    const int nk = K >> 6;
    LAS3 char* lds = (LAS3 char*)smem;
    const unsigned ldsb = (unsigned)__builtin_amdgcn_readfirstlane((int)(unsigned)(unsigned long)lds) + (unsigned)w * 1024u;
    const int stepA = 32 * lda * 2, stepB = 32 * ldb * 2;
#define D_ONE(SRD, VO, SOFF, M0V) asm volatile("s_mov_b32 m0, %0\n\ts_nop 0\n\tbuffer_load_dwordx4 %1, %2, %3 offen lds" :: "s"(M0V), "v"(VO), "s"(SRD), "s"(SOFF) : "m0", "memory")
#define D_ISSUE(BUF, KT) { _Pragma("unroll") for (int i = 0; i < 4; ++i) { \
        D_ONE(srdA, voA, (KT) * 128 + i * stepA, ldsb + (BUF) * 32768 + i * 4096); \
        D_ONE(srdB, voB, (KT) * 128 + i * stepB, ldsb + (BUF) * 32768 + 16384 + i * 4096); } }
#define D_WAIT() { asm volatile("s_waitcnt vmcnt(0)" ::: "memory"); __builtin_amdgcn_s_barrier(); asm volatile("" ::: "memory"); }
    if (!pre) D_ISSUE(0, 0);
    D_WAIT();
    for (int kt = 0; kt < nk; kt += 2) {
        D_ISSUE(1, kt + 1);
        SCHED_FENCE();
        gemm_compute<false>(smem, aoff, boff, fq, sw, acc);
        SCHED_FENCE();
        D_WAIT();
        if (kt + 2 < nk) D_ISSUE(0, kt + 2)
        else if (An) {
            const __amdgpu_buffer_rsrc_t srdA2 = __builtin_amdgcn_make_buffer_rsrc((void*)An, (short)0, 0x7fffffff, 0x00020000);
            const __amdgpu_buffer_rsrc_t srdB2 = __builtin_amdgcn_make_buffer_rsrc((void*)Bn, (short)0, 0x7fffffff, 0x00020000);
#pragma unroll
            for (int i = 0; i < 4; ++i) { D_ONE(srdA2, voA, i * stepA, ldsb + i * 4096); D_ONE(srdB2, voB, i * stepB, ldsb + 16384 + i * 4096); }
        }
        SCHED_FENCE();
        gemm_compute<false>(smem + 32768, aoff, boff, fq, sw, acc);
        SCHED_FENCE();
        hook(kt + 1, acc);
        if (kt + 2 < nk) D_WAIT();
    }
#undef D_ISSUE
#undef D_ONE
#undef D_WAIT
}
DEVINL void gemm_loop1(const bf16_t* __restrict__ A, int lda, const bf16_t* __restrict__ B, int ldb, int K, char* smem, f32x4 (&acc)[4][4]) {
    const int t = tid(), lane = t & 63, w = t >> 6, wm = w >> 1, wn = w & 1, fr = lane & 15, fq = lane >> 4;
    const int sc = t & 7, sr = t >> 3;
    const bf16_t* ag = A + (size_t)sr * lda + sc * 8;
    const bf16_t* bg = B + (size_t)sr * ldb + sc * 8;
    const int soff = sr * 128 + ((sc ^ ((sr >> 1) & 7)) << 4);
    u32x4 ra[4], rb[4];
    const int nk = K >> 6;
#pragma unroll
    for (int i = 0; i < 4; ++i) { ra[i] = *(const u32x4*)(ag + (size_t)i * 32 * lda); rb[i] = *(const u32x4*)(bg + (size_t)i * 32 * ldb); }
    __syncthreads();
#pragma unroll
    for (int i = 0; i < 4; ++i) { *(u32x4*)(smem + soff + i * 4096) = ra[i]; *(u32x4*)(smem + 16384 + soff + i * 4096) = rb[i]; }
    __syncthreads();
    const int aoff = (wm * 64 + fr) * 128, boff = 16384 + (wn * 64 + fr) * 128, sw = (fr >> 1) & 7;
    for (int kt = 0; kt < nk; ++kt) {
        const char* cur = smem + (kt & 1) * 32768;
        if (kt + 1 < nk) {
#pragma unroll
            for (int i = 0; i < 4; ++i) { ra[i] = *(const u32x4*)(ag + (size_t)i * 32 * lda + (kt + 1) * 64); rb[i] = *(const u32x4*)(bg + (size_t)i * 32 * ldb + (kt + 1) * 64); }
        }
        gemm_compute<false>(cur, aoff, boff, fq, sw, acc);
        if (kt + 1 < nk) {
            char* nxt = smem + ((kt + 1) & 1) * 32768;
#pragma unroll
            for (int i = 0; i < 4; ++i) { *(u32x4*)(nxt + soff + i * 4096) = ra[i]; *(u32x4*)(nxt + 16384 + soff + i * 4096) = rb[i]; }
        }
        __syncthreads();
    }
}
DEVINL void zero_acc(f32x4 (&acc)[4][4]) {
#pragma unroll
    for (int i = 0; i < 4; ++i)
#pragma unroll
        for (int j = 0; j < 4; ++j) acc[i][j] = (f32x4){0.f, 0.f, 0.f, 0.f};
}
DEVINL void tile_order(int t, int nN, int& pm, int& pn) { const int g = t / (8 * nN), r = t % (8 * nN); pn = r >> 3; pm = g * 8 + (r & 7); }
struct TileWalk {
    int nN, i, x, j, nb; bool xcd;
    DEVINL void init(int nN_) { nN = nN_; i = 0; xcd = (gridDim.x & 7) == 0; x = blockIdx.x & 7; j = blockIdx.x >> 3; nb = gridDim.x >> 3; }
    DEVINL bool next(int& pm, int& pn) {
        if (xcd) { const int s = i * nb + j; ++i; if (s >= 8 * nN) return false; pn = s >> 3; pm = x * 8 + (s & 7); return true; }
        const int t = blockIdx.x + i * gridDim.x; ++i; if (t >= 64 * nN) return false; tile_order(t, nN, pm, pn); return true;
    }
};

DEVINL void wt_tile2(const float* __restrict__ src, int K, int N, bf16_t* __restrict__ dst, int ldd, int tile0, char* smem) {
    const int nNt = N >> 6, t = tid();
    float* tl = (float*)smem;
    const int r = t >> 4, c4 = t & 15;
    f32x4 v[2][4];
#pragma unroll
    for (int u = 0; u < 2; ++u) {
        const int tile = tile0 + u, k0 = (tile / nNt) * 64, n0 = (tile % nNt) * 64;
#pragma unroll
        for (int i = 0; i < 4; ++i) v[u][i] = *(const f32x4*)(src + (size_t)(k0 + r + 16 * i) * N + n0 + c4 * 4);
    }
    asm volatile("" : "+v"(v[0][0]), "+v"(v[0][1]), "+v"(v[0][2]), "+v"(v[0][3]), "+v"(v[1][0]), "+v"(v[1][1]), "+v"(v[1][2]), "+v"(v[1][3]));
#pragma unroll
    for (int u = 0; u < 2; ++u)
#pragma unroll
        for (int i = 0; i < 4; ++i) { float* q = tl + u * 4160 + (r + 16 * i) * 65 + c4 * 4; q[0] = v[u][i][0]; q[1] = v[u][i][1]; q[2] = v[u][i][2]; q[3] = v[u][i][3]; }
    __syncthreads();
    const int n = t >> 2, kq = t & 3;
#pragma unroll
    for (int u = 0; u < 2; ++u) {
        const int tile = tile0 + u, k0 = (tile / nNt) * 64, n0 = (tile % nNt) * 64;
        uint32_t pk[8];
#pragma unroll
        for (int e = 0; e < 8; ++e) pk[e] = pack_bf16(tl[u * 4160 + (kq * 16 + 2 * e) * 65 + n], tl[u * 4160 + (kq * 16 + 2 * e + 1) * 65 + n]);
        uint4* o = (uint4*)(dst + (size_t)(n0 + n) * ldd + k0 + kq * 16);
        o[0] = make_uint4(pk[0], pk[1], pk[2], pk[3]); o[1] = make_uint4(pk[4], pk[5], pk[6], pk[7]);
    }
    __syncthreads();
}
DEVINL void mod_tile(const Params& p, int tile, char* smem) {
    const int l = tile / 96, n0 = (tile % 96) * 64, t = tid(), kg = t >> 6, col = t & 63;
    float* sl = (float*)smem;
    float* red = sl + 5 * 1024;
    for (int i = t; i < 5 * 1024; i += 256) { const int cb = i >> 10, k = i & 1023; const float x = cb == 0 ? p.c_ctx[k] : p.c[(cb - 1) * 1024 + k]; sl[i] = x * sigmoidf_(x); }
    __syncthreads();
    float a0 = 0.f, a1 = 0.f, a2 = 0.f, a3 = 0.f, a4 = 0.f;
    const float* wp = p.w_ada + ((size_t)l * 1024 + kg * 256) * 6144 + n0 + col;
#pragma unroll 1
    for (int k0 = 0; k0 < 256; k0 += 32) {
        float wv[32];
#pragma unroll
        for (int k = 0; k < 32; ++k) wv[k] = wp[(size_t)(k0 + k) * 6144];
        SCHED_FENCE();
#pragma unroll
        for (int k = 0; k < 32; ++k) {
            const int kk = kg * 256 + k0 + k;
            a0 += sl[kk] * wv[k]; a1 += sl[1024 + kk] * wv[k]; a2 += sl[2048 + kk] * wv[k]; a3 += sl[3072 + kk] * wv[k]; a4 += sl[4096 + kk] * wv[k];
        }
    }
    red[(kg * 5 + 0) * 64 + col] = a0; red[(kg * 5 + 1) * 64 + col] = a1; red[(kg * 5 + 2) * 64 + col] = a2; red[(kg * 5 + 3) * 64 + col] = a3; red[(kg * 5 + 4) * 64 + col] = a4;
    __syncthreads();
    float* mod = (float*)(p.ws + OFF_MOD);
    for (int i = t; i < 320; i += 256) {
        const int cb = i >> 6, cc = i & 63;
        const float s = red[(0 * 5 + cb) * 64 + cc] + red[(1 * 5 + cb) * 64 + cc] + red[(2 * 5 + cb) * 64 + cc] + red[(3 * 5 + cb) * 64 + cc];
        mod[((size_t)l * 5 + cb) * 6144 + n0 + cc] = s + p.b_ada[l * 6144 + n0 + cc];
    }
    __syncthreads();
}
DEVINL void phase_prep(const Params& p, char* smem) {
    const int t = tid();
    bf16_t* WT = (bf16_t*)(p.ws + OFF_WT);
    constexpr int NMOD = 192, NW = 4224  , NC = 256, NT = NMOD + NW + NC + 1;
    const int G = gridDim.x, b = blockIdx.x;
    const bool bal = G > 2 * NMOD && 4 * G <= NW;
    (void)NT;
#pragma unroll 1
    for (int stage = 0; stage < 4; ++stage) {
        int first = b, step = G, end, offs;
        if (stage == 0) { end = NMOD; offs = 0; }
        else if (stage == 1) { end = bal ? 4 * G : NW; offs = NMOD; }
        else if (stage == 2) { end = (bal && b >= NMOD) ? NW : 0; first = 4 * G + (b - NMOD); step = G - NMOD; offs = NMOD; }
        else { end = NC + 1; offs = NMOD + NW; }
#pragma unroll 1
      for (int idx = first; idx < end; idx += step) {
        const int tile = offs + idx;
        if (tile < NMOD) mod_tile(p, tile, smem);
        else if (tile < NMOD + NW) {
            int wt = (tile - NMOD) * 2; const int l = wt / 4224; wt -= l * 4224;
            const float* src; int K, N, ldd; size_t dofs;
            if (wt < 1600) { src = p.w_in + (size_t)l * 1024 * 6400; K = 1024; N = 6400; ldd = LW1; dofs = WO_IN; }
            else if (wt < 1664) { wt -= 1600; src = p.w_a_out + (size_t)l * 256 * 1024; K = 256; N = 1024; ldd = LWM; dofs = WO_A; }
            else if (wt < 1728) { wt -= 1664; src = p.w_b_out + (size_t)l * 256 * 1024; K = 256; N = 1024; ldd = LWM; dofs = WO_A + 256; }
            else if (wt < 1792) { wt -= 1728; src = p.w_c_out + (size_t)l * 256 * 1024; K = 256; N = 1024; ldd = LWM; dofs = WO_A + 512; }
            else if (wt < 1920) { wt -= 1792; src = p.w_d_out + (size_t)l * 512 * 1024; K = 512; N = 1024; ldd = LWM; dofs = WO_A + 768; }
            else if (wt < 2176) { wt -= 1920; src = p.w_o + (size_t)l * 1024 * 1024; K = 1024; N = 1024; ldd = LW1; dofs = WO_O; }
            else if (wt < 3200) { wt -= 2176; src = p.w_ff1 + (size_t)l * 1024 * 4096; K = 1024; N = 4096; ldd = LW1; dofs = WO_F1; }
            else { wt -= 3200; src = p.w_ff2 + (size_t)l * 4096 * 1024; K = 4096; N = 1024; ldd = LW4; dofs = WO_F2; }
            wt_tile2(src, K, N, WT + (size_t)l * W_LAYER + dofs, ldd, wt, smem);
        } else if (tile < NMOD + NW + NC) {
            const int i = (tile - NMOD - NW) * 256 + t;
            const float* src = (i < 32768) ? p.cache_k + (size_t)i * 8 : p.cache_v + (size_t)(i - 32768) * 8;
            const float4 a = *(const float4*)src, b = *(const float4*)(src + 4);
            uint4 o; o.x = pack_bf16(a.x, a.y); o.y = pack_bf16(a.z, a.w); o.z = pack_bf16(b.x, b.y); o.w = pack_bf16(b.z, b.w);
            *(uint4*)(p.ws + OFF_CKV + (size_t)i * 16) = o;
        } else {
            float2* tab = (float2*)(p.ws + OFF_TAB);
            for (int i = t; i < 1024; i += 256) {
                const int pos = i >> 4, fi = i & 15;
                const float freq = exp2f(-(float)fi * (13.287712379549449f / 16.f));
                const float ang = (float)pos * freq;
                tab[i] = make_float2(__cosf(ang), __sinf(ang));
            }
        }
      }
    }
}

DEVINL void rowpass(const Params& p, int chunk, int mode, int lpost, int which_post, int hsel, int lh) {
    const int lane = tid() & 63, w = tid() >> 6;
    const float* mod = (const float*)(p.ws + OFF_MOD);
    const bf16_t* MF = (const bf16_t*)(p.ws + OFF_MF);
    bf16_t* H = (bf16_t*)(p.ws + OFF_H);
    const float* xin = chunk == 0 ? p.x_prompt : p.x_sample + (size_t)(chunk - 1) * CH * D;
    float* xres = p.out + (size_t)chunk * CH * D;
    const float* xsrc = mode == 0 ? xin : xres;
    const float* gpost = which_post == 1 ? p.g_post_mix + lpost * D : p.g_post_ffn + lpost * D;
    const float* gpre = hsel == 1 ? p.g_pre_mix + lh * D : p.g_pre_ffn + lh * D;
    for (int base = (blockIdx.x * 4 + w) * 4; base < CH; base += gridDim.x * 16) {
        const int cb = chunk == 0 ? 0 : 1 + (chunk - 1) * 2 + (base >> 12);
        float pg[16], hg[16], hs[16];
        if (mode == 1) {
            const float* gate = mod + ((size_t)lpost * 5 + cb) * 6144 + (which_post == 1 ? 2 : 5) * 1024;
            float4 gp[4], gt[4];
#pragma unroll
            for (int i = 0; i < 4; ++i) { const int c = i * 256 + lane * 4; gp[i] = *(const float4*)(gpost + c); gt[i] = *(const float4*)(gate + c); }
            SCHED_FENCE();
#pragma unroll
            for (int i = 0; i < 4; ++i) { pg[4 * i] = gp[i].x * gt[i].x; pg[4 * i + 1] = gp[i].y * gt[i].y; pg[4 * i + 2] = gp[i].z * gt[i].z; pg[4 * i + 3] = gp[i].w * gt[i].w; }
        }
        if (hsel) {
            const float* mb = mod + ((size_t)lh * 5 + cb) * 6144 + (hsel == 1 ? 0 : 3) * 1024;
            float4 g[4], sh[4], sc[4];
#pragma unroll
            for (int i = 0; i < 4; ++i) { const int c = i * 256 + lane * 4; g[i] = *(const float4*)(gpre + c); sh[i] = *(const float4*)(mb + c); sc[i] = *(const float4*)(mb + 1024 + c); }
            SCHED_FENCE();
#pragma unroll
            for (int i = 0; i < 4; ++i) {
                hg[4 * i] = g[i].x * (1.f + sc[i].x); hg[4 * i + 1] = g[i].y * (1.f + sc[i].y); hg[4 * i + 2] = g[i].z * (1.f + sc[i].z); hg[4 * i + 3] = g[i].w * (1.f + sc[i].w);
                hs[4 * i] = sh[i].x; hs[4 * i + 1] = sh[i].y; hs[4 * i + 2] = sh[i].z; hs[4 * i + 3] = sh[i].w;
            }
        }
#pragma unroll 1
        for (int pr = 0; pr < 2; ++pr) {
            const int row0 = base + pr * 2;
            float x[2][16], m[2][16];
#pragma unroll
            for (int r = 0; r < 2; ++r)
#pragma unroll
                for (int i = 0; i < 4; ++i) {
                    const size_t o = (size_t)(row0 + r) * D + i * 256 + lane * 4;
                    const float4 v = *(const float4*)(xsrc + o);
                    x[r][4 * i] = v.x; x[r][4 * i + 1] = v.y; x[r][4 * i + 2] = v.z; x[r][4 * i + 3] = v.w;
                    if (mode == 1) { const uint2 q = *(const uint2*)(MF + o); m[r][4 * i] = bf_lo(q.x); m[r][4 * i + 1] = bf_hi(q.x); m[r][4 * i + 2] = bf_lo(q.y); m[r][4 * i + 3] = bf_hi(q.y); }
                }
            SCHED_FENCE();
#pragma unroll
            for (int r = 0; r < 2; ++r) {
                if (mode == 1) {
                    float ss = 0.f;
#pragma unroll
                    for (int i = 0; i < 16; ++i) ss += m[r][i] * m[r][i];
                    ss = wave_sum(ss);
                    const float rs = rsqrtf(ss * (1.f / D) + EPS);
#pragma unroll
                    for (int i = 0; i < 16; ++i) x[r][i] += (m[r][i] * rs) * pg[i];
                }
#pragma unroll
                for (int i = 0; i < 4; ++i) *(float4*)(xres + (size_t)(row0 + r) * D + i * 256 + lane * 4) = make_float4(x[r][4 * i], x[r][4 * i + 1], x[r][4 * i + 2], x[r][4 * i + 3]);
                if (hsel) {
                    float ss = 0.f;
#pragma unroll
                    for (int i = 0; i < 16; ++i) ss += x[r][i] * x[r][i];
                    ss = wave_sum(ss);
                    const float rs = rsqrtf(ss * (1.f / D) + EPS);
#pragma unroll
                    for (int i = 0; i < 4; ++i) {
                        const float h0 = x[r][4 * i] * rs * hg[4 * i] + hs[4 * i], h1 = x[r][4 * i + 1] * rs * hg[4 * i + 1] + hs[4 * i + 1];
                        const float h2 = x[r][4 * i + 2] * rs * hg[4 * i + 2] + hs[4 * i + 2], h3 = x[r][4 * i + 3] * rs * hg[4 * i + 3] + hs[4 * i + 3];
                        *(uint2*)(H + (size_t)(row0 + r) * LDH + i * 256 + lane * 4) = make_uint2(pack_bf16(h0, h1), pack_bf16(h2, h3));
                    }
                }
            }
        }
    }
}

DEVINL void unpack8u(const uint4& u, float (&f)[8]) { unpack8(u, f); }
struct MergeHook {
    const bf16_t* zg;
    bool on;
    DEVINL void operator()(int k, f32x4 (&acc)[4][4]) const {
        if (!on || (k & 3) != 3 || k > 11) return;
        const int b = k >> 2;
        const bf16_t* z = zg + b * 1024;
        uint4 ga[4][2], gb[4][2];
#pragma unroll
        for (int mi = 0; mi < 4; ++mi)
#pragma unroll
            for (int q = 0; q < 2; ++q) { ga[mi][q] = *(const uint4*)(z + (size_t)mi * 16 * INW + q * 32); gb[mi][q] = *(const uint4*)(z + 1024 + (size_t)mi * 16 * INW + q * 32); }
        SCHED_FENCE();
#pragma unroll
        for (int mi = 0; mi < 4; ++mi)
#pragma unroll
            for (int q = 0; q < 2; ++q) {
                float a[8], bb[8]; unpack8(ga[mi][q], a); unpack8(gb[mi][q], bb);
#pragma unroll
                for (int e = 0; e < 8; ++e) acc[mi][2 * q + (e >> 2)][e & 3] *= (1.f + __expf(-bb[e])) * __builtin_amdgcn_rcpf(1.f + __expf(-a[e]));
            }
    }
};
struct GemmDesc { const bf16_t* A; const bf16_t* W; int lda, ldb, K, nN, epi, l, chunk; };
DEVINL void phase_gemm_any(const Params& p, const GemmDesc& g, char* smem) {
    const int lane = tid() & 63, w = tid() >> 6, wm = w >> 1, wn = w & 1, fr = lane & 15, fq = lane >> 4;
    bf16_t* Z = (bf16_t*)(p.ws + OFF_Z);
    bf16_t* MF = (bf16_t*)(p.ws + OFF_MF);
    bf16_t* HID = (bf16_t*)(p.ws + OFF_HID);
    bf16_t* MG = (bf16_t*)(p.ws + OFF_H);
    TileWalk tw; tw.init(g.nN);
    int pm, pn, pm2 = 0, pn2 = 0;
    bool have = tw.next(pm, pn), pre = false;
    for (; have; pm = pm2, pn = pn2) {
        const bool have2 = tw.next(pm2, pn2);
        f32x4 acc[4][4]; zero_acc(acc);
        const int row0 = pm * 128 + wm * 64 + fr, col0 = pn * 128 + wn * 64 + fq * 8;
        MergeHook hook; hook.on = (g.epi == 3); hook.zg = Z + (size_t)row0 * INW + Z_G + col0;
        gemm_loop_dma(g.A + (size_t)pm * 128 * g.lda, g.lda, g.W + (size_t)pn * 128 * g.ldb, g.ldb, g.K, smem, acc, hook,
                      have2 ? g.A + (size_t)pm2 * 128 * g.lda : nullptr, have2 ? g.W + (size_t)pn2 * 128 * g.ldb : nullptr, pre);
        pre = have2; have = have2;
        if (g.epi == 0) {
            const bool kv = (g.chunk == 0) && (pn == 16 || pn == 17);
            bf16_t* zo = Z + (size_t)row0 * INW + col0;
            asm volatile("" : "+v"(zo));
#pragma unroll
            for (int mi = 0; mi < 4; ++mi)
#pragma unroll
                for (int q = 0; q < 2; ++q) {
                    const f32x4 v0 = acc[mi][2 * q], v1 = acc[mi][2 * q + 1];
                    *(uint4*)(zo + (size_t)mi * 16 * INW + q * 32) = make_uint4(pack_bf16(v0[0], v0[1]), pack_bf16(v0[2], v0[3]), pack_bf16(v1[0], v1[1]), pack_bf16(v1[2], v1[3]));
                    if (kv) {
                        const int row = row0 + mi * 16, cl = wn * 64 + q * 32 + fq * 8;
                        float* dst = p.out + (pn == 16 ? OUT_K : OUT_V) + ((size_t)((row >> 8) * 2 + g.l) * 256 + (row & 255)) * 128 + cl;
                        *(f32x4*)dst = v0; *(f32x4*)(dst + 4) = v1;
                    }
                }
        } else if (g.epi == 1) {
            bf16_t* mo = MF + (size_t)row0 * D + col0;
            asm volatile("" : "+v"(mo));
#pragma unroll
            for (int mi = 0; mi < 4; ++mi)
#pragma unroll
                for (int q = 0; q < 2; ++q) {
                    const f32x4 v0 = acc[mi][2 * q], v1 = acc[mi][2 * q + 1];
                    *(uint4*)(mo + (size_t)mi * 16 * D + q * 32) = make_uint4(pack_bf16(v0[0], v0[1]), pack_bf16(v0[2], v0[3]), pack_bf16(v1[0], v1[1]), pack_bf16(v1[2], v1[3]));
                }
        } else if (g.epi == 2) {
            bf16_t* ho = HID + (size_t)row0 * LDHID + col0;
            asm volatile("" : "+v"(ho));
#pragma unroll
            for (int mi = 0; mi < 4; ++mi)
#pragma unroll
                for (int q = 0; q < 2; ++q) {
                    float r[8];
#pragma unroll
                    for (int e = 0; e < 8; ++e) { const float x = fmaxf(acc[mi][2 * q + (e >> 2)][e & 3], 0.f); r[e] = x * x; }
                    *(uint4*)(ho + (size_t)mi * 16 * LDHID + q * 32) = pack8(r);
                }
        } else {
            const bf16_t* z3 = hook.zg + 3 * 1024;
            bf16_t* mg = MG + (size_t)row0 * LDH + col0;
            uint4 g3[4][2];
#pragma unroll
            for (int mi = 0; mi < 4; ++mi)
#pragma unroll
                for (int q = 0; q < 2; ++q) g3[mi][q] = *(const uint4*)(z3 + (size_t)mi * 16 * INW + q * 32);
            SCHED_FENCE();
#pragma unroll
            for (int mi = 0; mi < 4; ++mi)
#pragma unroll
                for (int q = 0; q < 2; ++q) {
                    float gg[8], r[8]; unpack8(g3[mi][q], gg);
#pragma unroll
                    for (int e = 0; e < 8; ++e) r[e] = acc[mi][2 * q + (e >> 2)][e & 3] * sigmoidf_(gg[e]);
                    *(uint4*)(mg + (size_t)mi * 16 * LDH + q * 32) = pack8(r);
                }
        }
    }
}

struct AttTile { const bf16_t* kptr; const bf16_t* vptr; int stride, kstart; bool rope, maskf; };
DEVINL bool att_tile(int it, bool is_ctx, const bf16_t* Zs, const bf16_t* CKb, int q0, int kvh, AttTile& d) {
    d.rope = false; d.maskf = false;
    if (is_ctx) { d.kstart = it * 64; d.kptr = Zs + (size_t)d.kstart * INW + Z_K + kvh * 64; d.vptr = d.kptr + 128; d.stride = INW; return true; }
    if (it < 5) {
        d.kstart = (q0 & ~63) - 128 + it * 64; d.stride = INW; d.rope = true; d.maskf = true;
        if (d.kstart < 0 || d.kstart >= 4096) return false;
        d.kptr = Zs + (size_t)d.kstart * INW + Z_K + kvh * 64; d.vptr = d.kptr + 128; return true;
    }
    d.kstart = (it - 5) * 64; d.kptr = CKb + (size_t)d.kstart * 128 + kvh * 64; d.vptr = d.kptr + 262144; d.stride = 128; return true;
}
DEVINL void attn_unit(const Params& p, int chunk, int layer, int unit, char* smem) {
    const int t = tid(), lane = t & 63, w = t >> 6, fr = lane & 15, fq = lane >> 4;
    const bool is_ctx = (chunk == 0);
    int seq_base, q0, kvh, bseq = 0;
    if (is_ctx) { seq_base = (unit >> 4) * 256; q0 = ((unit >> 1) & 7) * 32; kvh = unit & 1; }
    else { const int sl = unit >> 8; seq_base = sl * 4096; q0 = ((unit >> 1) & 127) * 32; kvh = unit & 1; bseq = (chunk - 1) * 2 + sl; }
    const int head = kvh * 4 + w;
    const bf16_t* Zs = (const bf16_t*)(p.ws + OFF_Z) + (size_t)seq_base * INW;
    const bf16_t* CKb = (const bf16_t*)(p.ws + OFF_CKV) + (size_t)(bseq * 2 + layer) * 256 * 128;
    const float2* tab = (const float2*)(p.ws + OFF_TAB);
    bf16_t* ACT = (bf16_t*)(p.ws + OFF_ACT);
    char* Ks = smem;
    bf16_t* Vt = (bf16_t*)(smem + 8192);
    constexpr int VS = 68;

    bf16x8 qf[2][2];
#pragma unroll
    for (int qg = 0; qg < 2; ++qg)
#pragma unroll
        for (int dh = 0; dh < 2; ++dh) {
            const int pos = q0 + qg * 16 + fr;
            uint4 u = *(const uint4*)(Zs + (size_t)pos * INW + Z_Q + head * 64 + dh * 32 + fq * 8);
            if (!is_ctx) {
                uint4 pu; pu.x = __shfl_xor((int)u.x, 32); pu.y = __shfl_xor((int)u.y, 32); pu.z = __shfl_xor((int)u.z, 32); pu.w = __shfl_xor((int)u.w, 32);
                float x[8], y[8]; unpack8(u, x); unpack8(pu, y);
                const int pi = dh == 0 ? (pos >> 6) : (pos & 63);
                const float2* tp = tab + pi * 16 + (fq & 1) * 8;
                const float sgn = fq < 2 ? -1.f : 1.f;
#pragma unroll
                for (int e = 0; e < 8; ++e) { const float2 cs = tp[e]; x[e] = x[e] * cs.x + sgn * y[e] * cs.y; }
                u = pack8(x);
            }
            qf[qg][dh] = as_bf16x8(u);
        }
    f32x4 o[2][4];
#pragma unroll
    for (int i = 0; i < 2; ++i)
#pragma unroll
        for (int j = 0; j < 4; ++j) o[i][j] = (f32x4){0.f, 0.f, 0.f, 0.f};
    const float sk2 = p.sink[layer * 8 + head] * 1.4426950408889634f;
    float mrow[2], lsum[2];
#pragma unroll
    for (int i = 0; i < 2; ++i) { mrow[i] = sk2; lsum[i] = fq == 0 ? 1.f : 0.f; }
    const float sc2 = 0.125f * 1.4426950408889634f;

    const int ntiles = is_ctx ? 4 : 9;
    const int key = t >> 2, cp = t & 3, c = (cp & 1) + ((cp >> 1) << 2);
    const int vkp = t & 31, vc = t >> 5;
    AttTile cur; int it = 0;
    while (!att_tile(it, is_ctx, Zs, CKb, q0, kvh, cur)) ++it;
    u32x4 ku1, ku2, vu0, vu1; float2 cs[8];
#define ATT_LOAD(d) { const bf16_t* src = (d).kptr + (size_t)key * (d).stride + c * 8; ku1 = *(const u32x4*)src; ku2 = *(const u32x4*)(src + 16); \
        const bf16_t* vs = (d).vptr + (size_t)(2 * vkp) * (d).stride + vc * 8; vu0 = *(const u32x4*)vs; vu1 = *(const u32x4*)(vs + (d).stride); \
        if ((d).rope) { const int kpos = (d).kstart + key, pi = c < 4 ? (kpos >> 6) : (kpos & 63); const float2* tp = tab + pi * 16 + (c & 1) * 8; \
            _Pragma("unroll") for (int e = 0; e < 8; ++e) cs[e] = tp[e]; } }
    ATT_LOAD(cur);
    for (;;) {
        __syncthreads();
        {
            uint4 u1 = make_uint4(ku1[0], ku1[1], ku1[2], ku1[3]), u2 = make_uint4(ku2[0], ku2[1], ku2[2], ku2[3]);
            if (cur.rope) {
                float x1[8], x2[8], o1[8], o2[8]; unpack8(u1, x1); unpack8(u2, x2);
#pragma unroll
                for (int e = 0; e < 8; ++e) { o1[e] = x1[e] * cs[e].x - x2[e] * cs[e].y; o2[e] = x2[e] * cs[e].x + x1[e] * cs[e].y; }
                u1 = pack8(o1); u2 = pack8(o2);
            }
            *(uint4*)(Ks + key * 128 + ((c ^ (key & 7)) << 4)) = u1;
            *(uint4*)(Ks + key * 128 + (((c + 2) ^ (key & 7)) << 4)) = u2;
            {
                uint32_t* dst = (uint32_t*)(Vt + (vc * 8) * VS + 2 * vkp);
#pragma unroll
                for (int m = 0; m < 4; ++m) {
                    dst[(2 * m) * (VS / 2)] = (vu0[m] & 0xffffu) | (vu1[m] << 16);
                    dst[(2 * m + 1) * (VS / 2)] = (vu0[m] >> 16) | (vu1[m] & 0xffff0000u);
                }
            }
        }
        __syncthreads();
        AttTile nxt; int nit = it + 1; bool have = false;
        while (nit < ntiles) { if (att_tile(nit, is_ctx, Zs, CKb, q0, kvh, nxt)) { have = true; break; } ++nit; }
        if (have) ATT_LOAD(nxt);
        SCHED_FENCE();
        const int kstart = cur.kstart; const bool maskf = cur.maskf;
        {
            bf16x8 kf[4][2], vf[2][4];
#pragma unroll
            for (int kb = 0; kb < 4; ++kb)
#pragma unroll
                for (int dh = 0; dh < 2; ++dh) { const int row = kb * 16 + fr; kf[kb][dh] = *(const bf16x8*)(Ks + row * 128 + (((dh * 4 + fq) ^ (row & 7)) << 4)); }
#pragma unroll
            for (int hk = 0; hk < 2; ++hk)
#pragma unroll
                for (int di = 0; di < 4; ++di) {
                    const bf16_t* vp = Vt + (di * 16 + fr) * VS + hk * 32 + fq * 4;
                    const bf16x4 lo = *(const bf16x4*)vp, hi = *(const bf16x4*)(vp + 16);
                    vf[hk][di] = __builtin_shufflevector(lo, hi, 0, 1, 2, 3, 4, 5, 6, 7);
                }
#pragma unroll
            for (int qg = 0; qg < 2; ++qg) {
                f32x4 s[4];
#pragma unroll
                for (int kb = 0; kb < 4; ++kb) {
                    s[kb] = __builtin_amdgcn_mfma_f32_16x16x32_bf16(kf[kb][0], qf[qg][0], (f32x4){0.f, 0.f, 0.f, 0.f}, 0, 0, 0);
                    s[kb] = __builtin_amdgcn_mfma_f32_16x16x32_bf16(kf[kb][1], qf[qg][1], s[kb], 0, 0, 0);
                }
                const int qpos = q0 + qg * 16 + fr;
                float mx = -1e30f;
#pragma unroll
                for (int kb = 0; kb < 4; ++kb)
#pragma unroll
                    for (int j = 0; j < 4; ++j) {
                        float v = s[kb][j] * sc2;
                        if (maskf) { const int d = qpos - (kstart + kb * 16 + fq * 4 + j); if (d > 128 || d < -128) v = -1e30f; }
                        s[kb][j] = v; mx = fmaxf(mx, v);
                    }
                mx = fmaxf(mx, __shfl_xor(mx, 16)); mx = fmaxf(mx, __shfl_xor(mx, 32));
                const float mn = fmaxf(mrow[qg], mx), alpha = exp2f(mrow[qg] - mn);
                mrow[qg] = mn;
                float ps = 0.f;
#pragma unroll
                for (int kb = 0; kb < 4; ++kb)
#pragma unroll
                    for (int j = 0; j < 4; ++j) { const float pv = exp2f(s[kb][j] - mn); s[kb][j] = pv; ps += pv; }
                lsum[qg] = lsum[qg] * alpha + ps;
#pragma unroll
                for (int di = 0; di < 4; ++di) { o[qg][di][0] *= alpha; o[qg][di][1] *= alpha; o[qg][di][2] *= alpha; o[qg][di][3] *= alpha; }
#pragma unroll
                for (int hk = 0; hk < 2; ++hk) {
                    uint4 pu; pu.x = pack_bf16(s[2 * hk][0], s[2 * hk][1]); pu.y = pack_bf16(s[2 * hk][2], s[2 * hk][3]);
                    pu.z = pack_bf16(s[2 * hk + 1][0], s[2 * hk + 1][1]); pu.w = pack_bf16(s[2 * hk + 1][2], s[2 * hk + 1][3]);
                    const bf16x8 pf = as_bf16x8(pu);
#pragma unroll
                    for (int di = 0; di < 4; ++di) o[qg][di] = __builtin_amdgcn_mfma_f32_16x16x32_bf16(vf[hk][di], pf, o[qg][di], 0, 0, 0);
                }
            }
        }
        if (!have) break;
        cur = nxt; it = nit;
    }
#undef ATT_LOAD
#pragma unroll
    for (int qg = 0; qg < 2; ++qg) {
        float l = lsum[qg]; l += __shfl_xor(l, 16); l += __shfl_xor(l, 32);
        const float inv = 1.f / l;
        const int tok = seq_base + q0 + qg * 16 + fr;
#pragma unroll
        for (int di = 0; di < 4; ++di) {
            const f32x4 v = o[qg][di];
            *(uint2*)(ACT + (size_t)tok * ACTW + 768 + head * 64 + di * 16 + fq * 4) = make_uint2(pack_bf16(v[0] * inv, v[1] * inv), pack_bf16(v[2] * inv, v[3] * inv));
        }
    }
}

DEVINL void conva_tile(const Params& p, int chunk, int l, int tile, char* smem) {
    const int t = tid(), lane = t & 63, w = t >> 6;
    const int S = chunk == 0 ? 256 : 4096;
    const int tok0 = tile * 32, pos0 = tok0 % S, sb = tok0 - pos0;
    const bf16_t* Z = (const bf16_t*)(p.ws + OFF_Z);
    bf16_t* ACT = (bf16_t*)(p.ws + OFF_ACT);
    float* glu = (float*)smem;
    {
        const int chk = t & 31, r0 = t >> 5;
#pragma unroll
        for (int h = 0; h < 2; ++h) {
            uint4 a[4], b[4];
#pragma unroll
            for (int i = 0; i < 4; ++i) {
                const int r = r0 + 8 * (h * 4 + i), pos = pos0 - 15 + r, pc = min(max(pos, 0), S - 1);
                const bf16_t* src = Z + (size_t)(sb + pc) * INW + chk * 8;
                a[i] = *(const uint4*)(src + Z_AVAL); b[i] = *(const uint4*)(src + Z_AGATE);
            }
            SCHED_FENCE();
#pragma unroll
            for (int i = 0; i < 4; ++i) {
                const int r = r0 + 8 * (h * 4 + i), pos = pos0 - 15 + r;
                if (r < 62) {
                    const float keep = (pos >= 0 && pos < S) ? 1.f : 0.f;
                    float av[8], bv[8], g[8]; unpack8(a[i], av); unpack8(b[i], bv);
#pragma unroll
                    for (int e = 0; e < 8; ++e) g[e] = keep * av[e] * sigmoidf_(bv[e]);
                    float4* d = (float4*)(glu + r * 256 + chk * 8);
                    d[0] = make_float4(g[0], g[1], g[2], g[3]); d[1] = make_float4(g[4], g[5], g[6], g[7]);
                }
            }
        }
    }
    __syncthreads();
    {
        float wv[31];
#pragma unroll
        for (int k = 0; k < 31; ++k) wv[k] = p.w_conv_a[((size_t)l * 31 + k) * 256 + t];
        const float bias = p.b_conv_a[l * 256 + t];
        for (int i = 0; i < 32; ++i) {
            float s = bias;
#pragma unroll
            for (int k = 0; k < 31; ++k) s += wv[k] * glu[(i + k) * 256 + t];
            glu[i * 256 + t] = s;
        }
    }
    __syncthreads();
    {
        const float4 g = *(const float4*)(p.ln_g_a + l * 256 + lane * 4), b = *(const float4*)(p.ln_b_a + l * 256 + lane * 4);
#pragma unroll
        for (int i = 0; i < 8; ++i) {
            const int r = w * 8 + i;
            const float4 v = *(const float4*)(glu + r * 256 + lane * 4);
            const float mu = wave_sum(v.x + v.y + v.z + v.w) * (1.f / 256.f);
            const float d0 = v.x - mu, d1 = v.y - mu, d2 = v.z - mu, d3 = v.w - mu;
            const float var = wave_sum(d0 * d0 + d1 * d1 + d2 * d2 + d3 * d3) * (1.f / 256.f);
            const float rs = rsqrtf(var + EPS);
            float y0 = d0 * rs * g.x + b.x, y1 = d1 * rs * g.y + b.y, y2 = d2 * rs * g.z + b.z, y3 = d3 * rs * g.w + b.w;
            y0 *= sigmoidf_(y0); y1 *= sigmoidf_(y1); y2 *= sigmoidf_(y2); y3 *= sigmoidf_(y3);
            *(uint2*)(ACT + (size_t)(tok0 + r) * ACTW + 0 + lane * 4) = make_uint2(pack_bf16(y0, y1), pack_bf16(y2, y3));
        }
    }
}
DEVINL void pool_tile(const Params& p, int chunk, int l, int tile, char* smem) {
    const int t = tid();
    const int S = chunk == 0 ? 256 : 4096;
    const int tok0 = tile * 32, pos0 = tok0 % S, sb = tok0 - pos0;
    const bf16_t* Z = (const bf16_t*)(p.ws + OFF_Z);
    bf16_t* ACT = (bf16_t*)(p.ws + OFF_ACT);
    float* u = (float*)smem;
    {
        const int chk = t & 31, r0 = t >> 5;
        uint4 av[6];
#pragma unroll
        for (int i = 0; i < 6; ++i) { const int pos = pos0 - 8 + r0 + 8 * i, pc = min(max(pos, 0), S - 1); av[i] = *(const uint4*)(Z + (size_t)(sb + pc) * INW + Z_POOL + chk * 8); }
        SCHED_FENCE();
#pragma unroll
        for (int i = 0; i < 6; ++i) {
            const int r = r0 + 8 * i, pos = pos0 - 8 + r;
            float g[8]; unpack8(av[i], g);
            const float keep = (pos >= 0 && pos < S) ? 1.f : 0.f;
            float4* d = (float4*)(u + r * 256 + chk * 8);
            d[0] = make_float4(g[0] * keep, g[1] * keep, g[2] * keep, g[3] * keep); d[1] = make_float4(g[4] * keep, g[5] * keep, g[6] * keep, g[7] * keep);
        }
    }
    __syncthreads();
    const int gi = t >> 6, w2 = 1 << gi;
    for (int i = 0; i < 32; ++i) {
        const int pos = pos0 + i;
        float s = 0.f;
        for (int j = -w2; j < w2; ++j) s += u[(i + 8 + j) * 256 + t];
        const int lo = max(pos - w2, 0), hi = min(pos + w2, S);
        const float pooled = s / (float)(hi - lo) - u[(i + 8) * 256 + t];
        u[i * 256 + t] = pooled;
    }
    __syncthreads();
    float acc[32];
#pragma unroll
    for (int i = 0; i < 32; ++i) acc[i] = 0.f;
    const float* wp = p.w_pool + ((size_t)l * 4 + gi) * 4096 + (t & 63);
#pragma unroll 1
    for (int c0 = 0; c0 < 64; c0 += 16) {
        float wv[16];
#pragma unroll
        for (int c = 0; c < 16; ++c) wv[c] = wp[(c0 + c) * 64];
#pragma unroll
        for (int c = 0; c < 16; ++c) {
            const float* up = u + gi * 64 + c0 + c;
#pragma unroll
            for (int i = 0; i < 32; ++i) acc[i] += up[i * 256] * wv[c];
        }
    }
    const float ps = p.pool_scale[l * 256 + t];
#pragma unroll
    for (int i = 0; i < 32; ++i) {
        const float v = acc[i] * ps;
        ACT[(size_t)(tok0 + i) * ACTW + 256 + t] = (bf16_t)(pack_bf16(v, 0.f) & 0xffff);
    }
}
DEVINL void convc_tile(const Params& p, int chunk, int l, int tile) {
    const int t = tid();
    const int S = chunk == 0 ? 256 : 4096;
    const bf16_t* Z = (const bf16_t*)(p.ws + OFF_Z);
    bf16_t* ACT = (bf16_t*)(p.ws + OFF_ACT);
#pragma unroll 1
    for (int i = 0; i < 4; ++i) {
        const int item = i * 256 + t, chk = item & 31, tok = tile * 32 + (item >> 5), pos = tok % S;
        const bf16_t* zr = Z + (size_t)tok * INW + chk * 8;
        float uu[3][8];
#pragma unroll
        for (int j = 0; j < 3; ++j) {
            const int pp = pos + j - 1;
            if (pp >= 0 && pp < S) {
                const uint4 a = *(const uint4*)(zr + (j - 1) * INW + Z_SC), b = *(const uint4*)(zr + (j - 1) * INW + Z_SH);
                float av[8], bv[8]; unpack8(a, av); unpack8(b, bv);
#pragma unroll
                for (int e = 0; e < 8; ++e) uu[j][e] = av[e] * bv[e];
            } else {
#pragma unroll
                for (int e = 0; e < 8; ++e) uu[j][e] = 0.f;
            }
        }
        const uint4 sbv = *(const uint4*)(zr + Z_SB);
        float sbf[8], r[8]; unpack8(sbv, sbf);
        const float* wc = p.w_sc + (size_t)l * 768 + chk * 8;
#pragma unroll
        for (int e = 0; e < 8; ++e) r[e] = sbf[e] * (wc[e] * uu[0][e] + wc[256 + e] * uu[1][e] + wc[512 + e] * uu[2][e]);
        *(uint4*)(ACT + (size_t)tok * ACTW + 512 + chk * 8) = pack8(r);
    }
}
DEVINL void phase_branch(const Params& p, int chunk, int l, char* smem) {
    for (int tile = blockIdx.x; tile < 1280; tile += gridDim.x) {
        if (tile < 512) attn_unit(p, chunk, l, tile, smem);
        else if (tile < 768) conva_tile(p, chunk, l, tile - 512, smem);
        else if (tile < 1024) pool_tile(p, chunk, l, tile - 768, smem);
        else convc_tile(p, chunk, l, tile - 1024);
        __syncthreads();
    }
}

#define XB_TMO      128
#define XB_XCNT(j)  (256  + 64 * (j))
#define XB_XSUB(j)  (1280 + 64 * (j))
#define XB_XGEN(j)  (2304 + 64 * (j))
#define XB_TOP      3328
#define XB_TOPGEN   3392
#define XB_SPIN_CAP (1u << 20)
DEVINL unsigned xb_ld(unsigned* p) { return __hip_atomic_load(p, __ATOMIC_RELAXED, __HIP_MEMORY_SCOPE_AGENT); }
DEVINL unsigned xb_add(unsigned* p, unsigned v) { return __hip_atomic_fetch_add(p, v, __ATOMIC_RELAXED, __HIP_MEMORY_SCOPE_AGENT); }
DEVINL unsigned xb_xcc_id() { return (unsigned)__builtin_amdgcn_s_getreg((3 << 11) | 20) & 0xFu; }
#define XB_SPIN(cond, bar) do { unsigned _sp = 0; while (cond) { __builtin_amdgcn_s_sleep(1); \
    if ((++_sp & 255u) == 0u) { if (xb_ld(&(bar)[XB_TMO])) break; if (_sp > XB_SPIN_CAP) { atomicAdd(&(bar)[XB_TMO], 1u); break; } } } } while (0)
struct XcdBar { unsigned* bar; unsigned x, nloc, nx; };
DEVINL void xb_census(unsigned* bar, unsigned x, unsigned& nloc, unsigned& nx) {
    const unsigned G = gridDim.x;
    unsigned sum, cnt, mine, sp = 0u;
    for (;;) {
        sum = 0u; cnt = 0u; mine = 0u;
#pragma unroll
        for (unsigned j = 0; j < 16; ++j) { const unsigned c = xb_ld(&bar[XB_XCNT(j)]); sum += c; cnt += (c > 0u) ? 1u : 0u; mine = (j == x) ? c : mine; }
        if (sum == G) break;
        __builtin_amdgcn_s_sleep(1);
        if ((++sp & 255u) == 0u) { if (xb_ld(&bar[XB_TMO])) break; if (sp > XB_SPIN_CAP) { atomicAdd(&bar[XB_TMO], 1u); break; } }
    }
    nloc = mine > 0u ? mine : 1u; nx = cnt > 0u ? cnt : 1u;
}
DEVINL void gsync(XcdBar& b) {
    asm volatile("s_waitcnt vmcnt(0)" ::: "memory");
    __syncthreads();
    if (threadIdx.x == 0) {
        unsigned* bar = b.bar;
        __builtin_amdgcn_s_waitcnt(0);
        if (b.nloc == 0u) xb_census(bar, b.x, b.nloc, b.nx);
        const unsigned nloc = b.nloc, nx = b.nx;
        const unsigned old = xb_add(&bar[XB_XSUB(b.x)], 1u);
        const unsigned gen = old / nloc;
        if (old + 1u == (gen + 1u) * nloc) {
            __builtin_amdgcn_fence(__ATOMIC_RELEASE, "agent");
            asm volatile("s_waitcnt vmcnt(0)" ::: "memory");
            const unsigned og = xb_add(&bar[XB_TOP], 1u);
            const unsigned tg = og / nx;
            if (og + 1u == (tg + 1u) * nx) xb_add(&bar[XB_TOPGEN], 1u);
            else XB_SPIN(xb_ld(&bar[XB_TOPGEN]) == tg, bar);
            __builtin_amdgcn_fence(__ATOMIC_ACQUIRE, "agent");
            xb_add(&bar[XB_XGEN(b.x)], 1u);
            asm volatile("s_waitcnt vmcnt(0)" ::: "memory");
        } else {
            XB_SPIN(xb_ld(&bar[XB_XGEN(b.x)]) == gen, bar);
            __builtin_amdgcn_fence(__ATOMIC_ACQUIRE, "agent");
            asm volatile("s_waitcnt vmcnt(0)" ::: "memory");
        }
    }
    __syncthreads();
}
__global__ void __launch_bounds__(256, 2) mega(Params p) {
    __shared__ __attribute__((aligned(16))) char smem[65536];
    cg::grid_group grid = cg::this_grid();
    if (p.ws == nullptr) grid.sync();
    XcdBar xb; xb.bar = (unsigned*)(p.ws + OFF_BAR); xb.x = xb_xcc_id(); xb.nloc = 0u; xb.nx = 0u;
    if (threadIdx.x == 0) (void)xb_add(&xb.bar[XB_XCNT(xb.x)], 1u);
#pragma unroll 1
    for (int step = 0; step < NSTEPS; ++step) {
        int ph, ch = 0, l = 0;
        if (step == 0) ph = 8;
        else if (step == 1) ph = 9;
        else { const int s = step - 2; ch = s >> 4; const int r = s & 15; l = r >> 3; ph = r & 7; }
        const bf16_t* WT = (const bf16_t*)(p.ws + OFF_WT) + (size_t)l * W_LAYER;
        const bf16_t* H = (const bf16_t*)(p.ws + OFF_H);
        int kind = 0;
        GemmDesc g; g.A = H; g.W = WT; g.lda = LDH; g.ldb = LW1; g.K = D; g.nN = 8; g.epi = 1; g.l = l; g.chunk = ch;
        int rp_mode = 1, rp_which = 1, rp_hsel = 0, rp_lh = l;
        switch (ph) {
            case 8: kind = 3; break;
            case 9: kind = 1; rp_mode = 0; rp_hsel = 1; rp_lh = 0; break;
            case 0: g.W = WT + WO_IN; g.nN = 50; g.epi = 0; break;
            case 1: kind = 2; break;
            case 2: g.A = (const bf16_t*)(p.ws + OFF_ACT); g.lda = ACTW; g.W = WT + WO_A; g.ldb = LWM; g.K = 1280; g.epi = 3; break;
            case 3: g.W = WT + WO_O; break;
            case 4: kind = 1; rp_which = 1; rp_hsel = 2; break;
            case 5: g.W = WT + WO_F1; g.nN = 32; g.epi = 2; break;
            case 6: g.A = (const bf16_t*)(p.ws + OFF_HID); g.lda = LDHID; g.W = WT + WO_F2; g.ldb = LW4; g.K = DFF; break;
            default: kind = 1; rp_which = 2; rp_hsel = (l == 0) ? 1 : 0; rp_lh = 1; break;
        }
        if (kind == 0) phase_gemm_any(p, g, smem);
        else if (kind == 1) {
            const int nrep = (ph == 7 && l == 1 && ch < 2) ? 2 : 1;
#pragma unroll 1
            for (int rep = 0; rep < nrep; ++rep) {
                if (rep == 1) { ch += 1; rp_mode = 0; rp_which = 1; rp_hsel = 1; rp_lh = 0; }
                rowpass(p, ch, rp_mode, l, rp_which, rp_hsel, rp_lh);
            }
        }
        else if (kind == 2) phase_branch(p, ch, l, smem);
        else phase_prep(p, smem);
        if (step + 1 < NSTEPS) gsync(xb);
    }
}

extern "C" void kernel_launch(void* const* d_in, const int* in_sizes, int n_in, void* d_out, int out_size, void* d_ws, size_t ws_size, hipStream_t stream) {
    static int grid_blocks = 0;
    if (!grid_blocks) {
        int dev = 0, cus = 0, per_cu = 0;
        (void)hipGetDevice(&dev);
        (void)hipDeviceGetAttribute(&cus, hipDeviceAttributeMultiprocessorCount, dev);
        (void)hipOccupancyMaxActiveBlocksPerMultiprocessor(&per_cu, mega, 256, 0);
        if (per_cu > 2) per_cu = 2;
        if (per_cu < 1) per_cu = 1;
        grid_blocks = cus * per_cu;
    }
    Params p{};
    const float** pp = (const float**)&p;
    for (int i = 0; i < 28; ++i) pp[i] = (const float*)d_in[i];
    p.out = (float*)d_out;
    p.ws = (char*)d_ws;
    (void)hipMemsetAsync((char*)d_ws + OFF_BAR, 0, 16384, stream);
    void* args[] = {&p};
    hipError_t e = hipLaunchCooperativeKernel((void*)mega, dim3(grid_blocks), dim3(256), args, 0, stream);
    if (e != hipSuccess) fprintf(stderr, "cooperative launch failed: %s (grid %d)\n", hipGetErrorString(e), grid_blocks);
}
```
